# Optimizing an MI355X kernel written in HIP

```python
import jax, jax.numpy as jnp
from jax import lax
import numpy as np

D_MODEL = 1024
BATCH = 8
SEQ = 4096
DEPTH = 2

CONV_WIDTH = 512
CONV_K = 3
MLA_HEADS = 8
MLA_NOPE = 64
MLA_ROPE = 32
MLA_V = 64
MLA_Q_RANK = 256
MLA_KV_RANK = 128
ROPE_THETA = 10000.0
SB_HEADS = 8
SB_HEAD_DIM = 64
SB_WIDTH = SB_HEADS * SB_HEAD_DIM
Q_BLOCK = 128
N_BRANCHES = 3
OFF_CONV = 0
OFF_CQ = OFF_CONV + 3 * CONV_WIDTH
OFF_CKV = OFF_CQ + MLA_Q_RANK
OFF_KR = OFF_CKV + MLA_KV_RANK
OFF_SB = OFF_KR + MLA_ROPE
OFF_GATE = OFF_SB + 3 * SB_WIDTH
IN_COLS = OFF_GATE + N_BRANCHES * D_MODEL
N_GROUPS = 4
EXPERTS_PER_GROUP = 8
N_EXPERTS = N_GROUPS * EXPERTS_PER_GROUP
TOP_K_IN_GROUP = 2
D_EXPERT = 256
EPS = 1e-6

kernel_name = "hybrid_conv_mla_stickbreak_hiermoe"


def rms_norm(x, g):
    xf = x.astype(jnp.float32)
    y = xf * lax.rsqrt(jnp.mean(xf * xf, axis=-1, keepdims=True) + EPS)
    return (y * g.astype(jnp.float32)).astype(x.dtype)


def apply_rope(x, positions):
    half = x.shape[-1] // 2
    freqs = ROPE_THETA ** (-jnp.arange(half, dtype=jnp.float32) / half)
    ang = positions.astype(jnp.float32)[..., None] * freqs
    ang = ang.reshape(ang.shape[:2] + (1,) * (x.ndim - 3) + (half,))
    cos, sin = jnp.cos(ang), jnp.sin(ang)
    xf = x.astype(jnp.float32)
    x1, x2 = xf[..., :half], xf[..., half:]
    out = jnp.concatenate([x1 * cos - x2 * sin, x2 * cos + x1 * sin], axis=-1)
    return out.astype(x.dtype)


def short_conv_mixer(h_c, b_g, c_g, conv_w, w_out):
    u = c_g * h_c
    y = lax.conv_general_dilated(
        u, conv_w[:, None, :].astype(u.dtype), window_strides=(1,),
        padding=[(CONV_K - 1, 0)], dimension_numbers=("NWC", "WIO", "NWC"),
        feature_group_count=CONV_WIDTH)
    return (b_g * y) @ w_out


def mla_mixer(c_q, c_kv, k_rope, positions, q_norm, kv_norm, w_uq, w_ukv, w_out):
    B, S, _ = c_q.shape
    q = (rms_norm(c_q, q_norm) @ w_uq).reshape(B, S, MLA_HEADS, MLA_NOPE + MLA_ROPE)
    q_nope = q[..., :MLA_NOPE]
    q_rope = apply_rope(q[..., MLA_NOPE:], positions)
    kv = (rms_norm(c_kv, kv_norm) @ w_ukv).reshape(B, S, MLA_HEADS, MLA_NOPE + MLA_V)
    k_nope, v = kv[..., :MLA_NOPE], kv[..., MLA_NOPE:]
    k_rope = apply_rope(k_rope, positions)
    scale = (MLA_NOPE + MLA_ROPE) ** -0.5
    outs = []
    for i in range(S // Q_BLOCK):
        t0, kend = i * Q_BLOCK, (i + 1) * Q_BLOCK
        s = jnp.einsum("bqhd,bkhd->bhqk", q_nope[:, t0:kend], k_nope[:, :kend],
                       preferred_element_type=jnp.float32)
        s = s + jnp.einsum("bqhr,bkr->bhqk", q_rope[:, t0:kend], k_rope[:, :kend],
                           preferred_element_type=jnp.float32)
        mask = (t0 + jnp.arange(Q_BLOCK))[:, None] >= jnp.arange(kend)[None, :]
        s = jnp.where(mask, s * scale, -jnp.inf)
        p = jax.nn.softmax(s, axis=-1).astype(v.dtype)
        outs.append(jnp.einsum("bhqk,bkhd->bqhd", p, v[:, :kend]))
    o = jnp.concatenate(outs, axis=1).reshape(B, S, MLA_HEADS * MLA_V)
    return o @ w_out


def stick_breaking_mixer(q, k, v, w_out):
    B, S, _ = q.shape
    q = q.reshape(B, S, SB_HEADS, SB_HEAD_DIM)
    k = k.reshape(B, S, SB_HEADS, SB_HEAD_DIM)
    v = v.reshape(B, S, SB_HEADS, SB_HEAD_DIM)
    scale = SB_HEAD_DIM ** -0.5
    outs = []
    for i in range(S // Q_BLOCK):
        t0, kend = i * Q_BLOCK, (i + 1) * Q_BLOCK
        z = jnp.einsum("bqhd,bkhd->bhqk", q[:, t0:kend], k[:, :kend],
                       preferred_element_type=jnp.float32) * scale
        mask = (t0 + jnp.arange(Q_BLOCK))[:, None] > jnp.arange(kend)[None, :]
        log_1m = jnp.where(mask, jax.nn.log_sigmoid(-z), 0.0)
        suffix = lax.cumsum(log_1m, axis=3, reverse=True) - log_1m
        a = jnp.where(mask, jnp.exp(jax.nn.log_sigmoid(z) + suffix), 0.0)
        outs.append(jnp.einsum("bhqk,bkhd->bqhd", a.astype(v.dtype), v[:, :kend]))
    o = jnp.concatenate(outs, axis=1).reshape(B, S, SB_WIDTH)
    return o @ w_out


def hierarchical_moe(h, w_rg, b_rg, w_re, b_re, w_g, w_u, w_d):
    B, S, D = h.shape
    hf = h.reshape(B * S, D)
    g_prob = jax.nn.softmax((hf @ w_rg).astype(jnp.float32) + b_rg.astype(jnp.float32), axis=-1)
    g_w, g_idx = lax.top_k(g_prob, 1)
    e_logits = ((hf @ w_re).astype(jnp.float32) + b_re.astype(jnp.float32)).reshape(
        B * S, N_GROUPS, EXPERTS_PER_GROUP)
    e_sel = jnp.einsum("nge,ng->ne", e_logits,
                       jax.nn.one_hot(g_idx[:, 0], N_GROUPS, dtype=jnp.float32))
    e_w, e_idx = lax.top_k(jax.nn.softmax(e_sel, axis=-1), TOP_K_IN_GROUP)
    e_w = e_w / jnp.sum(e_w, axis=-1, keepdims=True)
    weights = g_w * e_w
    expert_id = g_idx * EXPERTS_PER_GROUP + e_idx
    combine = jnp.sum(jax.nn.one_hot(expert_id, N_EXPERTS, dtype=jnp.float32)
                      * weights[..., None], axis=1).astype(hf.dtype)
    out = jnp.zeros_like(hf)
    for e in range(N_EXPERTS):
        act = jax.nn.silu(hf @ w_g[e]) * (hf @ w_u[e])
        out = out + combine[:, e:e + 1] * (act @ w_d[e])
    return out.reshape(B, S, D)


def hybrid_layer(x, positions, attn_norm, w_in, b_gate, conv_w, w_out_conv, q_norm, kv_norm,
                 w_uq, w_ukv, w_out_mla, w_out_sb, w_o, ffn_norm, w_router_group,
                 b_router_group, w_router_expert, b_router_expert, w_exp_gate, w_exp_up,
                 w_exp_down):
    B, S, D = x.shape
    h = rms_norm(x, attn_norm)
    proj = h @ w_in
    h_c = proj[..., OFF_CONV:OFF_CONV + CONV_WIDTH]
    b_g = proj[..., OFF_CONV + CONV_WIDTH:OFF_CONV + 2 * CONV_WIDTH]
    c_g = proj[..., OFF_CONV + 2 * CONV_WIDTH:OFF_CQ]
    c_q = proj[..., OFF_CQ:OFF_CKV]
    c_kv = proj[..., OFF_CKV:OFF_KR]
    k_r = proj[..., OFF_KR:OFF_SB]
    q_sb = proj[..., OFF_SB:OFF_SB + SB_WIDTH]
    k_sb = proj[..., OFF_SB + SB_WIDTH:OFF_SB + 2 * SB_WIDTH]
    v_sb = proj[..., OFF_SB + 2 * SB_WIDTH:OFF_GATE]
    gates = jax.nn.sigmoid((proj[..., OFF_GATE:] + b_gate).astype(jnp.float32))
    gates = gates.astype(x.dtype).reshape(B, S, N_BRANCHES, D)

    y_a = short_conv_mixer(h_c, b_g, c_g, conv_w, w_out_conv)
    y_b = mla_mixer(c_q, c_kv, k_r, positions, q_norm, kv_norm, w_uq, w_ukv, w_out_mla)
    y_c = stick_breaking_mixer(q_sb, k_sb, v_sb, w_out_sb)
    merged = gates[:, :, 0] * y_a + gates[:, :, 1] * y_b + gates[:, :, 2] * y_c
    x = x + merged @ w_o

    h2 = rms_norm(x, ffn_norm)
    x = x + hierarchical_moe(h2, w_router_group, b_router_group, w_router_expert,
                             b_router_expert, w_exp_gate, w_exp_up, w_exp_down)
    return x


def setup_inputs(seed: int = 0) -> dict:
    key = jax.random.key(seed)
    ks = jax.random.split(key, 24)
    f32 = jnp.float32

    def nrm(k, shape, fan_in):
        return jax.random.normal(k, shape, f32) * (fan_in ** -0.5)

    def gain(k, shape):
        return 1.0 + 0.02 * jax.random.normal(k, shape, f32)

    x = jax.random.normal(ks[0], (BATCH, SEQ, D_MODEL), f32)
    offsets = jax.random.randint(ks[1], (BATCH, 1), 0, 4096, dtype=jnp.int32)
    positions = offsets + jnp.arange(SEQ, dtype=jnp.int32)[None, :]
    return {
        "x": x,
        "positions": positions,
        "attn_norm": gain(ks[2], (DEPTH, D_MODEL)),
        "w_in": nrm(ks[3], (DEPTH, D_MODEL, IN_COLS), D_MODEL),
        "b_gate": 0.02 * jax.random.normal(ks[4], (DEPTH, N_BRANCHES * D_MODEL), f32),
        "conv_w": nrm(ks[5], (DEPTH, CONV_K, CONV_WIDTH), CONV_K),
        "w_out_conv": nrm(ks[6], (DEPTH, CONV_WIDTH, D_MODEL), CONV_WIDTH),
        "q_norm": gain(ks[7], (DEPTH, MLA_Q_RANK)),
        "kv_norm": gain(ks[8], (DEPTH, MLA_KV_RANK)),
        "w_uq": nrm(ks[9], (DEPTH, MLA_Q_RANK, MLA_HEADS * (MLA_NOPE + MLA_ROPE)), MLA_Q_RANK),
        "w_ukv": nrm(ks[10], (DEPTH, MLA_KV_RANK, MLA_HEADS * (MLA_NOPE + MLA_V)), MLA_KV_RANK),
        "w_out_mla": nrm(ks[11], (DEPTH, MLA_HEADS * MLA_V, D_MODEL), MLA_HEADS * MLA_V),
        "w_out_sb": nrm(ks[12], (DEPTH, SB_WIDTH, D_MODEL), SB_WIDTH),
        "w_o": nrm(ks[13], (DEPTH, D_MODEL, D_MODEL), D_MODEL),
        "ffn_norm": gain(ks[14], (DEPTH, D_MODEL)),
        "w_router_group": nrm(ks[15], (DEPTH, D_MODEL, N_GROUPS), D_MODEL),
        "b_router_group": 0.01 * jax.random.normal(ks[16], (DEPTH, N_GROUPS), f32),
        "w_router_expert": nrm(ks[17], (DEPTH, D_MODEL, N_EXPERTS), D_MODEL),
        "b_router_expert": 0.01 * jax.random.normal(ks[18], (DEPTH, N_EXPERTS), f32),
        "w_exp_gate": nrm(ks[19], (DEPTH, N_EXPERTS, D_MODEL, D_EXPERT), D_MODEL),
        "w_exp_up": nrm(ks[20], (DEPTH, N_EXPERTS, D_MODEL, D_EXPERT), D_MODEL),
        "w_exp_down": nrm(ks[21], (DEPTH, N_EXPERTS, D_EXPERT, D_MODEL), D_EXPERT),
        "final_norm": gain(ks[22], (D_MODEL,)),
    }


def reference(x, positions, attn_norm, w_in, b_gate, conv_w, w_out_conv, q_norm, kv_norm,
              w_uq, w_ukv, w_out_mla, w_out_sb, w_o, ffn_norm, w_router_group,
              b_router_group, w_router_expert, b_router_expert, w_exp_gate, w_exp_up,
              w_exp_down, final_norm):
    for l in range(DEPTH):
        x = hybrid_layer(x, positions, attn_norm[l], w_in[l], b_gate[l], conv_w[l],
                         w_out_conv[l], q_norm[l], kv_norm[l], w_uq[l], w_ukv[l],
                         w_out_mla[l], w_out_sb[l], w_o[l], ffn_norm[l], w_router_group[l],
                         b_router_group[l], w_router_expert[l], b_router_expert[l],
                         w_exp_gate[l], w_exp_up[l], w_exp_down[l])
    return rms_norm(x, final_norm)
```

```cpp
#include <hip/hip_runtime.h>
#include <stdint.h>
#include <stdio.h>

#define DI __device__ __forceinline__
typedef unsigned short bf16;
typedef unsigned u32x4 __attribute__((ext_vector_type(4)));
typedef unsigned u32x2 __attribute__((ext_vector_type(2)));
typedef float f32x4 __attribute__((ext_vector_type(4)));
typedef float f32x2 __attribute__((ext_vector_type(2)));
typedef __bf16 bf16x2_t __attribute__((ext_vector_type(2)));

constexpr int D = 1024, NBATCH = 8, SEQ = 4096, M = NBATCH * SEQ, DEPTH = 2;
constexpr int CONVW = 512, QRANK = 256, KVRANK = 128, NH = 8;
constexpr int OFF_CQ = 1536, OFF_CKV = 1792, OFF_KR = 1920, OFF_SB = 1952, OFF_GATE = 3488, IN_COLS = 6560;
constexpr int NEXP = 32, NGRP = 4, EPG = 8, DEXP = 256;
constexpr int NA = 3584;
constexpr int MOE_ROWS = 73728;
constexpr float EPS = 1e-6f;
constexpr float LOG2E = 1.4426950408889634f;
constexpr float QSCALE_MLA = 0.10206207261596575f * LOG2E;
constexpr float QSCALE_SB = 0.125f * LOG2E;

constexpr size_t MiB = 1u << 20;
constexpr size_t WS_CTL = 0;
constexpr size_t WS_TOKSLOT = 1 * MiB;
constexpr size_t WS_TOKW = 1 * MiB + 512 * 1024;
constexpr size_t WS_LIST = 2 * MiB;
constexpr size_t WS_CS = 6 * MiB;
constexpr size_t WS_SSQ = 10 * MiB;
constexpr size_t WS_WA = 16 * MiB;
constexpr size_t WS_WG = 23 * MiB;
constexpr size_t WS_WUQ = 29 * MiB;
constexpr size_t WS_WUKV = 29 * MiB + 512 * 1024;
constexpr size_t WS_WOC = 30 * MiB, WS_WOM = 31 * MiB, WS_WOS = 32 * MiB;
constexpr size_t WS_WO = 33 * MiB;
constexpr size_t WS_WGU = 36 * MiB;
constexpr size_t WS_WD = 68 * MiB;
constexpr size_t WS_XN = 84 * MiB;
constexpr size_t WS_SBQ = 148 * MiB, WS_SBKT = 180 * MiB, WS_SBVT = 212 * MiB;
constexpr size_t WS_KT = 244 * MiB;
constexpr size_t WS_Q = 292 * MiB;
constexpr size_t WS_VT = 340 * MiB;
constexpr size_t WS_U = 372 * MiB, WS_BG = 404 * MiB;
constexpr size_t WS_CQ = 436 * MiB, WS_CKV = 452 * MiB;
constexpr size_t WS_ACONV = 460 * MiB;
constexpr size_t WS_OMLA = 372 * MiB, WS_OSB = 404 * MiB;
constexpr size_t WS_GSCR = 148 * MiB;
constexpr size_t WS_MERGED = 212 * MiB;
constexpr size_t WS_H2 = 148 * MiB;
constexpr size_t WS_ACT = 212 * MiB;
constexpr size_t WS_Y = 292 * MiB;
constexpr size_t WS_END = 492 * MiB;
constexpr int CW_CNT = 16384;

DI float bf2f(unsigned h) { return __uint_as_float(h << 16); }
DI unsigned pk2(float lo, float hi) { f32x2 v = {lo, hi}; bf16x2_t b = __builtin_convertvector(v, bf16x2_t); return __builtin_bit_cast(unsigned, b); }
DI u32x4 pk8(const float (&v)[8]) { u32x4 w; w.x = pk2(v[0], v[1]); w.y = pk2(v[2], v[3]); w.z = pk2(v[4], v[5]); w.w = pk2(v[6], v[7]); return w; }
DI void unpk8(u32x4 w, float (&v)[8]) { v[0] = bf2f(w.x & 0xffffu); v[1] = bf2f(w.x >> 16); v[2] = bf2f(w.y & 0xffffu); v[3] = bf2f(w.y >> 16);
    v[4] = bf2f(w.z & 0xffffu); v[5] = bf2f(w.z >> 16); v[6] = bf2f(w.w & 0xffffu); v[7] = bf2f(w.w >> 16); }
DI float wave_sum(float v) {
#pragma unroll
    for (int o = 1; o < 64; o <<= 1) v += __shfl_xor(v, o);
    return v;
}
template <int NCH> DI size_t kt_idx(int bh, int key, int chunk) { return ((((size_t)bh * (SEQ / 64) + (key >> 6)) * NCH + chunk) * 64 + (key & 63)) * 8; }
DI size_t vt_idx(int bh, int key, int d) { return ((((size_t)bh * (SEQ / 64) + (key >> 6)) * 8 + ((key & 63) >> 3)) * 64 + d) * 8 + (key & 7); }

DI bool moe_locate(const unsigned* cnt, int tile, int& e, int& i, int& rowbase) {
    int acc = 0;
    for (int k = 0; k < NEXP; ++k) { const int n = (int)((cnt[k * 64] + 255u) >> 8); if (tile < acc + n) { e = k; i = tile - acc; rowbase = acc * 256; return true; } acc += n; }
    return false;
}
DI int moe_base(const unsigned* cnt, int e) { int acc = 0; for (int k = 0; k < e; ++k) acc += (int)((cnt[k * 64] + 255u) >> 8); return acc * 256; }

struct WItem { const float* W; int ldw, K, src, perm; const float* gain; bf16* dst; int kb; };
struct LayerW { const float *w_in, *w_out_conv, *q_norm, *kv_norm, *w_uq, *w_ukv, *w_out_mla, *w_out_sb, *w_o, *w_g, *w_u, *w_d; };
constexpr int WI_A = (NA / 32) * 16, WI_G = 96 * 16, WI_UQ = 24 * 4, WI_UKV = 32 * 2, WI_OUT = 32 * 8, WI_O = 32 * 16, WI_GU = NEXP * 16 * 16, WI_D = NEXP * 32 * 4;
constexpr int WI_TOTAL = WI_A + WI_G + WI_UQ + WI_UKV + 3 * WI_OUT + WI_O + WI_GU + WI_D;
DI void wdecode(int it, const LayerW& L, unsigned char* ws, WItem& s) {
    s.perm = 0; s.gain = nullptr;
    if (it < WI_A) { const int nb = it >> 4; s.kb = it & 15; s.W = L.w_in; s.ldw = IN_COLS; s.K = 1024; s.dst = (bf16*)(ws + WS_WA) + (size_t)nb * 32 * 1024;
        if (nb < 32) { const int T = nb >> 3, w = nb & 7; s.src = (w < 4) ? 128 * T + 32 * w : 1024 + 128 * T + 32 * (w - 4); }
        else if (nb < 48) s.src = 512 + 32 * (nb - 32);
        else if (nb < 96) s.src = OFF_SB + 32 * (nb - 48);
        else if (nb < 104) s.src = OFF_CQ + 32 * (nb - 96);
        else if (nb < 108) s.src = OFF_CKV + 32 * (nb - 104);
        else if (nb == 108) { s.src = OFF_KR; s.perm = 1; }
        else s.src = -1;
        return; }
    it -= WI_A;
    if (it < WI_G) { const int nb = it >> 4; s.kb = it & 15; s.W = L.w_in; s.ldw = IN_COLS; s.K = 1024; s.src = OFF_GATE + 32 * nb; s.dst = (bf16*)(ws + WS_WG) + (size_t)nb * 32 * 1024; return; }
    it -= WI_G;
    if (it < WI_UQ) { const int nb = it >> 2; s.kb = it & 3; s.W = L.w_uq; s.ldw = 768; s.K = 256; s.gain = L.q_norm; const int h = nb / 3, part = nb % 3;
        s.src = h * 96 + part * 32; s.perm = (part == 2); s.dst = (bf16*)(ws + WS_WUQ) + (size_t)nb * 32 * 256; return; }
    it -= WI_UQ;
    if (it < WI_UKV) { const int nb = it >> 1; s.kb = it & 1; s.W = L.w_ukv; s.ldw = 1024; s.K = 128; s.gain = L.kv_norm;
        s.src = (nb < 16) ? (nb >> 1) * 128 + (nb & 1) * 32 : ((nb - 16) >> 1) * 128 + 64 + (nb & 1) * 32; s.dst = (bf16*)(ws + WS_WUKV) + (size_t)nb * 32 * 128; return; }
    it -= WI_UKV;
    for (int j = 0; j < 3; ++j) { if (it < WI_OUT) { const int nb = it >> 3; s.kb = it & 7; s.W = j == 0 ? L.w_out_conv : j == 1 ? L.w_out_mla : L.w_out_sb; s.ldw = 1024; s.K = 512; s.src = 32 * nb;
            s.dst = (bf16*)(ws + (j == 0 ? WS_WOC : j == 1 ? WS_WOM : WS_WOS)) + (size_t)nb * 32 * 512; return; } it -= WI_OUT; }
    if (it < WI_O) { const int nb = it >> 4; s.kb = it & 15; s.W = L.w_o; s.ldw = 1024; s.K = 1024; s.src = 32 * nb; s.dst = (bf16*)(ws + WS_WO) + (size_t)nb * 32 * 1024; return; }
    it -= WI_O;
    if (it < WI_GU) { const int e = it >> 8, r = it & 255, nb = r >> 4; s.kb = r & 15; const int pn = nb >> 3, w = nb & 7;
        s.W = (w < 4 ? L.w_g : L.w_u) + (size_t)e * 1024 * 256; s.ldw = 256; s.K = 1024; s.src = 128 * pn + 32 * (w & 3); s.dst = (bf16*)(ws + WS_WGU) + ((size_t)e * 512 + nb * 32) * 1024; return; }
    it -= WI_GU;
    { const int e = it >> 7, r = it & 127, nb = r >> 2; s.kb = r & 3; s.W = L.w_d + (size_t)e * 256 * 1024; s.ldw = 1024; s.K = 256; s.src = 32 * nb; s.dst = (bf16*)(ws + WS_WD) + ((size_t)e * 1024 + nb * 32) * 256; }
}
template <class FP> DI void tr_item(const WItem& s, FP scr, int lane) {
    const int k0 = 64 * s.kb, c = lane & 31, sc = s.perm ? ((c & 1) * 16 + (c >> 1)) : c;
#pragma unroll 8
    for (int i = 0; i < 32; ++i) { const int kk = 2 * i + (lane >> 5); float w = 0.f;
        if (s.src >= 0) { w = s.W[(size_t)(k0 + kk) * s.ldw + s.src + sc]; if (s.gain) w *= s.gain[k0 + kk]; }
        scr[kk * 33 + c] = w; }
    asm volatile("s_waitcnt lgkmcnt(0)" ::: "memory");
    const int c8 = lane & 7;
#pragma unroll
    for (int j = 0; j < 4; ++j) { const int n = (lane >> 3) + 8 * j; const auto* p = scr + (8 * c8) * 33 + n;
        u32x4 o; o.x = pk2(p[0 * 33], p[1 * 33]); o.y = pk2(p[2 * 33], p[3 * 33]); o.z = pk2(p[4 * 33], p[5 * 33]); o.w = pk2(p[6 * 33], p[7 * 33]);
        *(u32x4*)(s.dst + (size_t)n * s.K + k0 + 8 * c8) = o; }
    asm volatile("s_waitcnt lgkmcnt(0)" ::: "memory");
}
DI LayerW layer_w(const float* const* in, int l) {
    LayerW L; L.w_in = in[3] + (size_t)l * 1024 * IN_COLS; L.w_out_conv = in[6] + (size_t)l * 512 * 1024; L.q_norm = in[7] + l * 256; L.kv_norm = in[8] + l * 128;
    L.w_uq = in[9] + (size_t)l * 256 * 768; L.w_ukv = in[10] + (size_t)l * 128 * 1024; L.w_out_mla = in[11] + (size_t)l * 512 * 1024; L.w_out_sb = in[12] + (size_t)l * 512 * 1024;
    L.w_o = in[13] + (size_t)l * 1024 * 1024; L.w_g = in[19] + (size_t)l * NEXP * 1024 * 256; L.w_u = in[20] + (size_t)l * NEXP * 1024 * 256; L.w_d = in[21] + (size_t)l * NEXP * 256 * 1024; return L;
}

DI void rms_row(const float* xrow, const float* g, bf16* orow, float* fout, int lane) {
    const f32x4* xr = (const f32x4*)xrow + lane; const f32x4* gr = (const f32x4*)g + lane;
    f32x4 v[4]; float s = 0.f;
#pragma unroll
    for (int j = 0; j < 4; ++j) { v[j] = xr[64 * j]; s += (v[j].x * v[j].x + v[j].y * v[j].y) + (v[j].z * v[j].z + v[j].w * v[j].w); }
    const float rstd = 1.0f / sqrtf(wave_sum(s) * (1.f / D) + EPS);
#pragma unroll
    for (int j = 0; j < 4; ++j) { const f32x4 gg = gr[64 * j]; const f32x4 y = v[j] * rstd * gg;
        if (orow) { u32x2 o; o.x = pk2(y.x, y.y); o.y = pk2(y.z, y.w); ((u32x2*)orow)[lane + 64 * j] = o; }
        if (fout) ((f32x4*)fout)[lane + 64 * j] = y; }
}
DI void cs_row(const int* positions, float2* CS, int row, int lane) {
    if (lane < 16) { const float freq = powf(10000.0f, -(float)lane / 16.0f); const float ang = (float)positions[row] * freq; const double a = (double)ang;
        CS[(size_t)row * 16 + lane] = make_float2((float)cos(a), (float)sin(a)); }
}

struct EpiWinA {
    bf16 *U, *BG, *SBQ, *SBKT, *SBVT, *CQ, *CKV, *KT; float* SSQ; const float2* CS;
    DI bool is_pair(int pn) const { return pn < 4; }
    DI float rowctx(int) const { return 0.f; }
    DI void pair(int row, int col0, const float (&a)[8], const float (&b)[8], float) const {
        const int T = col0 >> 8, c = col0 & 255; float u[8];
#pragma unroll
        for (int j = 0; j < 8; ++j) u[j] = a[j] * b[j];
        *(u32x4*)(U + (size_t)row * 512 + 128 * T + c) = pk8(u);
    }
    DI void operator()(int row, int col0, const float (&v)[8], float) const {
        const int b = row / SEQ, t = row % SEQ;
        if (col0 < 1536) { *(u32x4*)(BG + (size_t)row * 512 + (col0 - 1024)) = pk8(v); }
        else if (col0 < 2048) { float q[8];
#pragma unroll
            for (int j = 0; j < 8; ++j) q[j] = v[j] * QSCALE_SB;
            *(u32x4*)(SBQ + (size_t)row * 512 + (col0 - 1536)) = pk8(q); }
        else if (col0 < 2560) { const int c = col0 - 2048, h = c >> 6, d = c & 63; *(u32x4*)(SBKT + kt_idx<8>(b * 8 + h, t, d >> 3)) = pk8(v); }
        else if (col0 < 3072) { const int c = col0 - 2560, h = c >> 6, d = c & 63;
#pragma unroll
            for (int j = 0; j < 8; ++j) SBVT[vt_idx(b * 8 + h, t, d + j)] = (bf16)(pk2(v[j], 0.f) & 0xffffu); }
        else if (col0 < 3328) { const int c = col0 - 3072; *(u32x4*)(CQ + (size_t)row * 256 + c) = pk8(v); float s = 0.f;
#pragma unroll
            for (int j = 0; j < 8; ++j) s += v[j] * v[j];
            SSQ[(size_t)row * 48 + (c >> 3)] = s; }
        else { const int c = col0 - 3328;
            if (c < 128) { *(u32x4*)(CKV + (size_t)row * 128 + c) = pk8(v); float s = 0.f;
#pragma unroll
                for (int j = 0; j < 8; ++j) s += v[j] * v[j];
                SSQ[(size_t)row * 48 + 32 + (c >> 3)] = s; }
            else if (c < 160) { const int i0 = (c - 128) >> 1; float r[8];
#pragma unroll
                for (int j = 0; j < 4; ++j) { const float2 cs = CS[(size_t)row * 16 + i0 + j]; const float x1 = v[2 * j], x2 = v[2 * j + 1]; r[2 * j] = x1 * cs.x - x2 * cs.y; r[2 * j + 1] = x2 * cs.x + x1 * cs.y; }
                const u32x4 w = pk8(r); const int chunk = 8 + ((c - 128) >> 3);
#pragma unroll
                for (int h = 0; h < NH; ++h) *(u32x4*)(KT + kt_idx<12>(b * 8 + h, t, chunk)) = w; }
        }
    }
};
struct EpiQ {
    bf16* Q; const float* SSQ; const float2* CS;
    DI bool is_pair(int) const { return false; }
    DI void pair(int, int, const float (&)[8], const float (&)[8], float) const {}
    DI float rowctx(int row) const { const f32x4* p = (const f32x4*)(SSQ + (size_t)row * 48); float s = 0.f;
#pragma unroll
        for (int j = 0; j < 8; ++j) { const f32x4 x = p[j]; s += (x.x + x.y) + (x.z + x.w); }
        return 1.0f / sqrtf(s * (1.f / 256.f) + EPS); }
    DI void operator()(int row, int col0, const float (&v)[8], float rstd) const {
        const int dd = col0 % 96; float r[8];
#pragma unroll
        for (int j = 0; j < 8; ++j) r[j] = v[j] * rstd;
        if (dd >= 64) { const int i0 = (dd - 64) >> 1;
#pragma unroll
            for (int j = 0; j < 4; ++j) { const float2 cs = CS[(size_t)row * 16 + i0 + j]; const float x1 = r[2 * j], x2 = r[2 * j + 1]; r[2 * j] = x1 * cs.x - x2 * cs.y; r[2 * j + 1] = x2 * cs.x + x1 * cs.y; } }
#pragma unroll
        for (int j = 0; j < 8; ++j) r[j] *= QSCALE_MLA;
        *(u32x4*)(Q + (size_t)row * 768 + col0) = pk8(r);
    }
};
struct EpiKV {
    bf16 *KT, *VT; const float* SSQ;
    DI bool is_pair(int) const { return false; }
    DI void pair(int, int, const float (&)[8], const float (&)[8], float) const {}
    DI float rowctx(int row) const { const f32x4* p = (const f32x4*)(SSQ + (size_t)row * 48 + 32); float s = 0.f;
#pragma unroll
        for (int j = 0; j < 4; ++j) { const f32x4 x = p[j]; s += (x.x + x.y) + (x.z + x.w); }
        return 1.0f / sqrtf(s * (1.f / 128.f) + EPS); }
    DI void operator()(int row, int col0, const float (&v)[8], float rstd) const {
        const int b = row / SEQ, t = row % SEQ; float r[8];
#pragma unroll
        for (int j = 0; j < 8; ++j) r[j] = v[j] * rstd;
        if (col0 < 512) { const int h = col0 >> 6, d = col0 & 63; *(u32x4*)(KT + kt_idx<12>(b * 8 + h, t, d >> 3)) = pk8(r); }
        else { const int c = col0 - 512, h = c >> 6, d = c & 63;
#pragma unroll
            for (int j = 0; j < 8; ++j) VT[vt_idx(b * 8 + h, t, d + j)] = (bf16)(pk2(r[j], 0.f) & 0xffffu); }
    }
};
struct EpiGate {
    bf16* GSCR; const float* bgate;
    DI bool is_pair(int) const { return false; }
    DI void pair(int, int, const float (&)[8], const float (&)[8], float) const {}
    DI float rowctx(int) const { return 0.f; }
    DI void operator()(int row, int col0, const float (&v)[8], float) const { float r[8];
#pragma unroll
        for (int j = 0; j < 8; ++j) r[j] = 1.0f / (1.0f + __expf(-(v[j] + bgate[col0 + j])));
        *(u32x4*)(GSCR + (size_t)row * 1024 + col0) = pk8(r); }
};
struct EpiY {
    const bf16* GSCR; bf16* MERGED; int first; int pad;
    DI bool is_pair(int) const { return false; }
    DI void pair(int, int, const float (&)[8], const float (&)[8], float) const {}
    DI float rowctx(int) const { return 0.f; }
    DI void operator()(int row, int col0, const float (&v)[8], float) const { float g[8], m[8];
        unpk8(*(const u32x4*)(GSCR + (size_t)row * 1024 + col0), g);
        if (first) {
#pragma unroll
            for (int j = 0; j < 8; ++j) m[j] = 0.f; }
        else unpk8(*(const u32x4*)(MERGED + (size_t)row * 1024 + col0), m);
#pragma unroll
        for (int j = 0; j < 8; ++j) m[j] += g[j] * v[j];
        *(u32x4*)(MERGED + (size_t)row * 1024 + col0) = pk8(m); }
};
struct EpiWo {
    const float* xin; float* XR;
    DI bool is_pair(int) const { return false; }
    DI void pair(int, int, const float (&)[8], const float (&)[8], float) const {}
    DI float rowctx(int) const { return 0.f; }
    DI void operator()(int row, int col0, const float (&v)[8], float) const {
        const f32x4 a = *(const f32x4*)(xin + (size_t)row * 1024 + col0), b = *(const f32x4*)(xin + (size_t)row * 1024 + col0 + 4);
        *(f32x4*)(XR + (size_t)row * 1024 + col0) = (f32x4){a.x + v[0], a.y + v[1], a.z + v[2], a.w + v[3]};
        *(f32x4*)(XR + (size_t)row * 1024 + col0 + 4) = (f32x4){b.x + v[4], b.y + v[5], b.z + v[6], b.w + v[7]}; }
};
struct EpiGU {
    bf16* ACT;
    DI bool is_pair(int) const { return true; }
    DI float rowctx(int) const { return 0.f; }
    DI void operator()(int, int, const float (&)[8], float) const {}
    DI void pair(int row, int col0, const float (&a)[8], const float (&b)[8], float) const { const int pn = col0 >> 8, c = col0 & 255; float r[8];
#pragma unroll
        for (int j = 0; j < 8; ++j) r[j] = a[j] / (1.0f + __expf(-a[j])) * b[j];
        *(u32x4*)(ACT + (size_t)row * 256 + 128 * pn + c) = pk8(r); }
};
struct EpiDown {
    bf16* Y;
    DI bool is_pair(int) const { return false; }
    DI void pair(int, int, const float (&)[8], const float (&)[8], float) const {}
    DI float rowctx(int) const { return 0.f; }
    DI void operator()(int row, int col0, const float (&v)[8], float) const { *(u32x4*)(Y + (size_t)row * 1024 + col0) = pk8(v); }
};

__global__ void __launch_bounds__(256) k_convert(LayerW L, unsigned char* ws) {
    __shared__ float scr[4][64 * 33];
    const int lane = threadIdx.x & 63, w = threadIdx.x >> 6;
    for (int it = blockIdx.x * 4 + w; it < WI_TOTAL; it += gridDim.x * 4) { WItem s; wdecode(it, L, ws, s); tr_item(s, &scr[w][0], lane); }
}
__global__ void __launch_bounds__(256) k_prep(const float* x, const int* positions, const float* g, unsigned char* ws) {
    const int lane = threadIdx.x & 63; const int row = blockIdx.x * 4 + (threadIdx.x >> 6);
    rms_row(x + (size_t)row * D, g, (bf16*)(ws + WS_XN) + (size_t)row * D, nullptr, lane);
    cs_row(positions, (float2*)(ws + WS_CS), row, lane);
}
struct DenseSrc { const bf16* A; const bf16* Bt; int lda; int pad;
    DI bool get(int r, const bf16*& a, const bf16*& bt, int& orow) const { a = A + (size_t)r * lda; bt = Bt; orow = r; return true; } };
struct MoeGUSrc { const bf16* H2; const bf16* Wgu; const unsigned* cnt; const int* LIST;
    DI bool get(int r, const bf16*& a, const bf16*& bt, int& orow) const { int e, i, rb; if (!moe_locate(cnt, r >> 8, e, i, rb)) return false; const int idx = i * 256 + (r & 255);
        if (idx >= (int)cnt[e * 64]) return false; a = H2 + (size_t)LIST[(size_t)e * M + idx] * 1024; bt = Wgu + (size_t)e * 512 * 1024; orow = r; return true; } };
struct MoeDownSrc { const bf16* ACT; const bf16* Wd; const unsigned* cnt;
    DI bool get(int r, const bf16*& a, const bf16*& bt, int& orow) const { int e, i, rb; if (!moe_locate(cnt, r >> 8, e, i, rb)) return false; const int idx = i * 256 + (r & 255);
        if (idx >= (int)cnt[e * 64]) return false; a = ACT + (size_t)r * 256; bt = Wd + (size_t)e * 1024 * 256; orow = r; return true; } };
DI float dot8(u32x4 a, u32x4 b) { float x[8], y[8]; unpk8(a, x); unpk8(b, y); float s = 0.f;
#pragma unroll
    for (int j = 0; j < 8; ++j) s += x[j] * y[j];
    return s; }
template <class Src, class Epi, bool PAIR> __global__ void __launch_bounds__(256) k_gemm_naive(Src SRC, Epi E, int K, int colbase) {
    const int r = blockIdx.x * 256 + threadIdx.x, cg = blockIdx.y;
    const bf16 *a, *bt; int orow; if (!SRC.get(r, a, bt, orow)) return;
    const int col0 = PAIR ? 256 * (cg >> 4) + 8 * (cg & 15) : colbase + 8 * cg;
    float acc[8], acc2[8];
#pragma unroll
    for (int j = 0; j < 8; ++j) { acc[j] = 0.f; acc2[j] = 0.f; }
    for (int k = 0; k < K; k += 8) { const u32x4 av = *(const u32x4*)(a + k);
#pragma unroll
        for (int j = 0; j < 8; ++j) { acc[j] += dot8(av, *(const u32x4*)(bt + (size_t)(col0 + j) * K + k)); if (PAIR) acc2[j] += dot8(av, *(const u32x4*)(bt + (size_t)(col0 + 128 + j) * K + k)); } }
    const float ctx = E.rowctx(orow);
    if (PAIR) E.pair(orow, col0, acc, acc2, ctx); else E(orow, col0, acc, ctx);
}
DI void conv_item(const bf16* U, const bf16* BG, const float* cw, bf16* ACONV, int row, int c8) {
    const int t = row % SEQ, c = c8 * 8; float u0[8], u1[8], u2[8], bg[8], r[8];
    unpk8(*(const u32x4*)(U + (size_t)row * 512 + c), u2);
    if (t >= 1) unpk8(*(const u32x4*)(U + (size_t)(row - 1) * 512 + c), u1); else {
#pragma unroll
        for (int j = 0; j < 8; ++j) u1[j] = 0.f; }
    if (t >= 2) unpk8(*(const u32x4*)(U + (size_t)(row - 2) * 512 + c), u0); else {
#pragma unroll
        for (int j = 0; j < 8; ++j) u0[j] = 0.f; }
    unpk8(*(const u32x4*)(BG + (size_t)row * 512 + c), bg);
#pragma unroll
    for (int j = 0; j < 8; ++j) r[j] = bg[j] * (cw[c + j] * u0[j] + cw[512 + c + j] * u1[j] + cw[1024 + c + j] * u2[j]);
    *(u32x4*)(ACONV + (size_t)row * 512 + c) = pk8(r);
}
__global__ void __launch_bounds__(256) k_conv(const bf16* U, const bf16* BG, const float* cw, bf16* ACONV) {
    const int id = blockIdx.x * 256 + threadIdx.x; conv_item(U, BG, cw, ACONV, id >> 6, id & 63);
}
__global__ void __launch_bounds__(64) k_mla_naive(const bf16* Q, const bf16* KT, const bf16* VT, bf16* O) {
    const int lane = threadIdx.x, qb = blockIdx.x & 63, bh = blockIdx.x >> 6, b = bh >> 3, h = bh & 7;
    const int q = qb * 64 + lane; const size_t row = (size_t)b * SEQ + q;
    float qv[96], acc[64];
#pragma unroll
    for (int c = 0; c < 12; ++c) { float t[8]; unpk8(*(const u32x4*)(Q + row * 768 + h * 96 + c * 8), t);
#pragma unroll
        for (int j = 0; j < 8; ++j) qv[c * 8 + j] = t[j]; }
#pragma unroll
    for (int d = 0; d < 64; ++d) acc[d] = 0.f;
    float m = -INFINITY, l = 0.f;
    for (int key = 0; key <= qb * 64 + 63; ++key) {
        float s = 0.f;
#pragma unroll
        for (int c = 0; c < 12; ++c) { float t[8]; unpk8(*(const u32x4*)(KT + kt_idx<12>(bh, key, c)), t);
#pragma unroll
            for (int j = 0; j < 8; ++j) s += qv[c * 8 + j] * t[j]; }
        if (key <= q) { const float mn = fmaxf(m, s), corr = exp2f(m - mn), p = exp2f(s - mn); l = l * corr + p; m = mn;
#pragma unroll
            for (int d = 0; d < 64; ++d) acc[d] = acc[d] * corr + p * bf2f(VT[vt_idx(bh, key, d)]); }
    }
    const float il = 1.0f / l;
#pragma unroll
    for (int c = 0; c < 8; ++c) { float t[8];
#pragma unroll
        for (int j = 0; j < 8; ++j) t[j] = acc[c * 8 + j] * il;
        *(u32x4*)(O + row * 512 + h * 64 + c * 8) = pk8(t); }
}
__global__ void __launch_bounds__(64) k_sb_naive(const bf16* Q, const bf16* KT, const bf16* VT, bf16* O) {
    const int lane = threadIdx.x, qb = blockIdx.x & 63, bh = blockIdx.x >> 6, b = bh >> 3, h = bh & 7;
    const int q = qb * 64 + lane; const size_t row = (size_t)b * SEQ + q;
    float qv[64], acc[64];
#pragma unroll
    for (int c = 0; c < 8; ++c) { float t[8]; unpk8(*(const u32x4*)(Q + row * 512 + h * 64 + c * 8), t);
#pragma unroll
        for (int j = 0; j < 8; ++j) qv[c * 8 + j] = t[j]; }
#pragma unroll
    for (int d = 0; d < 64; ++d) acc[d] = 0.f;
    float R = 0.f;
    for (int key = qb * 64 + 62; key >= 0; --key) {
        float z = 0.f;
#pragma unroll
        for (int c = 0; c < 8; ++c) { float t[8]; unpk8(*(const u32x4*)(KT + kt_idx<8>(bh, key, c)), t);
#pragma unroll
            for (int j = 0; j < 8; ++j) z += qv[c * 8 + j] * t[j]; }
        if (key < q) { const float L = -(fmaxf(z, 0.f) + log2f(1.0f + exp2f(-fabsf(z)))); const float a = exp2f(z + L + R); R += L;
#pragma unroll
            for (int d = 0; d < 64; ++d) acc[d] += a * bf2f(VT[vt_idx(bh, key, d)]); }
    }
#pragma unroll
    for (int c = 0; c < 8; ++c) { float t[8];
#pragma unroll
        for (int j = 0; j < 8; ++j) t[j] = acc[c * 8 + j];
        *(u32x4*)(O + row * 512 + h * 64 + c * 8) = pk8(t); }
}
__global__ void __launch_bounds__(256) k_t1_naive(const float* XR, const float* g, const float* wrg, const float* brg, const float* wre, const float* bre, unsigned char* ws, int layer) {
    const int lane = threadIdx.x & 63; const int row = blockIdx.x * 4 + (threadIdx.x >> 6);
    const f32x4* xr = (const f32x4*)(XR + (size_t)row * D) + lane; const f32x4* gr = (const f32x4*)g + lane;
    f32x4 v[4]; float s = 0.f;
#pragma unroll
    for (int j = 0; j < 4; ++j) { v[j] = xr[64 * j]; s += (v[j].x * v[j].x + v[j].y * v[j].y) + (v[j].z * v[j].z + v[j].w * v[j].w); }
    const float rstd = 1.0f / sqrtf(wave_sum(s) * (1.f / D) + EPS);
    bf16* orow = (bf16*)(ws + WS_H2) + (size_t)row * D;
#pragma unroll
    for (int j = 0; j < 4; ++j) { v[j] = v[j] * rstd * gr[64 * j]; u32x2 o; o.x = pk2(v[j].x, v[j].y); o.y = pk2(v[j].z, v[j].w); ((u32x2*)orow)[lane + 64 * j] = o; }
    float gl[4], el[32];
#pragma unroll
    for (int e = 0; e < 4; ++e) { float p = 0.f;
#pragma unroll
        for (int j = 0; j < 4; ++j) { const int k = 256 * j + 4 * lane; p += v[j].x * wrg[(k + 0) * 4 + e] + v[j].y * wrg[(k + 1) * 4 + e] + v[j].z * wrg[(k + 2) * 4 + e] + v[j].w * wrg[(k + 3) * 4 + e]; }
        gl[e] = wave_sum(p) + brg[e]; }
#pragma unroll
    for (int e = 0; e < 32; ++e) { float p = 0.f;
#pragma unroll
        for (int j = 0; j < 4; ++j) { const int k = 256 * j + 4 * lane; p += v[j].x * wre[(k + 0) * 32 + e] + v[j].y * wre[(k + 1) * 32 + e] + v[j].z * wre[(k + 2) * 32 + e] + v[j].w * wre[(k + 3) * 32 + e]; }
        el[e] = wave_sum(p) + bre[e]; }
    if (lane == 0) {
        int gi = 0; float gm = gl[0];
#pragma unroll
        for (int e = 1; e < 4; ++e) if (gl[e] > gm) { gm = gl[e]; gi = e; }
        float gs = 0.f;
#pragma unroll
        for (int e = 0; e < 4; ++e) gs += __expf(gl[e] - gm);
        const float gw = 1.0f / gs;
        float sel[8];
#pragma unroll
        for (int e = 0; e < 8; ++e) sel[e] = gi == 0 ? el[e] : gi == 1 ? el[8 + e] : gi == 2 ? el[16 + e] : el[24 + e];
        int i1 = 0; float m1 = sel[0];
#pragma unroll
        for (int e = 1; e < 8; ++e) if (sel[e] > m1) { m1 = sel[e]; i1 = e; }
        int i2 = -1; float m2 = -INFINITY;
#pragma unroll
        for (int e = 0; e < 8; ++e) if (e != i1 && sel[e] > m2) { m2 = sel[e]; i2 = e; }
        const float r = __expf(m2 - m1), w1 = gw / (1.0f + r), w2 = gw * r / (1.0f + r);
        const int e1 = gi * 8 + i1, e2 = gi * 8 + i2;
        unsigned* cnt = (unsigned*)(ws + WS_CTL) + CW_CNT + layer * 32 * 64;
        const int s1 = (int)atomicAdd(cnt + e1 * 64, 1u), s2 = (int)atomicAdd(cnt + e2 * 64, 1u);
        int* LIST = (int*)(ws + WS_LIST); LIST[(size_t)e1 * M + s1] = row; LIST[(size_t)e2 * M + s2] = row;
        ((int4*)(ws + WS_TOKSLOT))[row] = make_int4(e1, s1, e2, s2); ((float2*)(ws + WS_TOKW))[row] = make_float2(w1, w2);
    }
}
DI void t2_row(float* XRrow, const bf16* Y, const unsigned* cnt, int4 ts, float2 tw, const float* gnext, bf16* xnrow, int final_, int lane) {
    const size_t a1 = (size_t)moe_base(cnt, ts.x) + ts.y, a2 = (size_t)moe_base(cnt, ts.z) + ts.w;
    f32x4* xr = (f32x4*)XRrow + lane; const u32x2* y1 = (const u32x2*)(Y + a1 * 1024) + lane; const u32x2* y2 = (const u32x2*)(Y + a2 * 1024) + lane; const f32x4* gr = (const f32x4*)gnext + lane;
    f32x4 v[4]; float s = 0.f;
#pragma unroll
    for (int j = 0; j < 4; ++j) { v[j] = xr[64 * j]; const u32x2 p = y1[64 * j], q = y2[64 * j];
        v[j].x += tw.x * bf2f(p.x & 0xffffu) + tw.y * bf2f(q.x & 0xffffu); v[j].y += tw.x * bf2f(p.x >> 16) + tw.y * bf2f(q.x >> 16);
        v[j].z += tw.x * bf2f(p.y & 0xffffu) + tw.y * bf2f(q.y & 0xffffu); v[j].w += tw.x * bf2f(p.y >> 16) + tw.y * bf2f(q.y >> 16);
        s += (v[j].x * v[j].x + v[j].y * v[j].y) + (v[j].z * v[j].z + v[j].w * v[j].w); }
    const float rstd = 1.0f / sqrtf(wave_sum(s) * (1.f / D) + EPS);
#pragma unroll
    for (int j = 0; j < 4; ++j) { const f32x4 y = v[j] * rstd * gr[64 * j];
        if (final_) xr[64 * j] = y; else { xr[64 * j] = v[j]; u32x2 o; o.x = pk2(y.x, y.y); o.y = pk2(y.z, y.w); ((u32x2*)xnrow)[lane + 64 * j] = o; } }
}
__global__ void __launch_bounds__(256) k_t2(float* XR, const float* gnext, unsigned char* ws, int layer, int final_) {
    const int lane = threadIdx.x & 63; const int row = blockIdx.x * 4 + (threadIdx.x >> 6);
    const unsigned* cnt = (const unsigned*)(ws + WS_CTL) + CW_CNT + layer * 32 * 64;
    t2_row(XR + (size_t)row * D, (const bf16*)(ws + WS_Y), cnt, ((const int4*)(ws + WS_TOKSLOT))[row], ((const float2*)(ws + WS_TOKW))[row], gnext, (bf16*)(ws + WS_XN) + (size_t)row * D, final_, lane);
}

template <class T> static T* wsp(void* ws, size_t off) { return (T*)((unsigned char*)ws + off); }
extern "C" void kernel_launch(void* const* d_in, const int* in_sizes, int n_in, void* d_out, int out_size, void* d_ws, size_t ws_size, hipStream_t stream) {
    if (n_in != 23 || out_size != M * D || ws_size < WS_END) { fprintf(stderr, "kernel_launch: unexpected shapes (n_in %d out %d ws %zu)\n", n_in, out_size, ws_size); return; }
    const float* in[23]; for (int i = 0; i < 23; ++i) in[i] = (const float*)d_in[i];
    unsigned char* ws = (unsigned char*)d_ws; float* XR = (float*)d_out;
    (void)hipMemsetAsync(ws + WS_CTL, 0, 1 * MiB, stream);
    bf16 *XN = wsp<bf16>(ws, WS_XN), *SBQ = wsp<bf16>(ws, WS_SBQ), *SBKT = wsp<bf16>(ws, WS_SBKT), *SBVT = wsp<bf16>(ws, WS_SBVT), *KT = wsp<bf16>(ws, WS_KT), *Qb = wsp<bf16>(ws, WS_Q), *VT = wsp<bf16>(ws, WS_VT);
    bf16 *U = wsp<bf16>(ws, WS_U), *BG = wsp<bf16>(ws, WS_BG), *CQ = wsp<bf16>(ws, WS_CQ), *CKV = wsp<bf16>(ws, WS_CKV), *ACONV = wsp<bf16>(ws, WS_ACONV), *OMLA = wsp<bf16>(ws, WS_OMLA), *OSB = wsp<bf16>(ws, WS_OSB);
    bf16 *GSCR = wsp<bf16>(ws, WS_GSCR), *MERGED = wsp<bf16>(ws, WS_MERGED), *H2 = wsp<bf16>(ws, WS_H2), *ACT = wsp<bf16>(ws, WS_ACT), *Y = wsp<bf16>(ws, WS_Y);
    float* SSQ = wsp<float>(ws, WS_SSQ); float2* CS = wsp<float2>(ws, WS_CS);
    k_prep<<<M / 4, 256, 0, stream>>>(in[0], (const int*)d_in[1], in[2], ws);
    for (int l = 0; l < DEPTH; ++l) {
        LayerW L; { L.w_in = in[3] + (size_t)l * 1024 * IN_COLS; L.w_out_conv = in[6] + (size_t)l * 512 * 1024; L.q_norm = in[7] + l * 256; L.kv_norm = in[8] + l * 128;
            L.w_uq = in[9] + (size_t)l * 256 * 768; L.w_ukv = in[10] + (size_t)l * 128 * 1024; L.w_out_mla = in[11] + (size_t)l * 512 * 1024; L.w_out_sb = in[12] + (size_t)l * 512 * 1024;
            L.w_o = in[13] + (size_t)l * 1024 * 1024; L.w_g = in[19] + (size_t)l * NEXP * 1024 * 256; L.w_u = in[20] + (size_t)l * NEXP * 1024 * 256; L.w_d = in[21] + (size_t)l * NEXP * 256 * 1024; }
        k_convert<<<1024, 256, 0, stream>>>(L, ws);
        EpiWinA e1{U, BG, SBQ, SBKT, SBVT, CQ, CKV, KT, SSQ, CS};
        DenseSrc sa{XN, wsp<bf16>(ws, WS_WA), 1024, 0};
        k_gemm_naive<DenseSrc, EpiWinA, true><<<dim3(M / 256, 64), 256, 0, stream>>>(sa, e1, 1024, 0);
        k_gemm_naive<DenseSrc, EpiWinA, false><<<dim3(M / 256, (NA - 1024) / 8), 256, 0, stream>>>(sa, e1, 1024, 1024);
        k_gemm_naive<DenseSrc, EpiQ, false><<<dim3(M / 256, 768 / 8), 256, 0, stream>>>(DenseSrc{CQ, wsp<bf16>(ws, WS_WUQ), 256, 0}, EpiQ{Qb, SSQ, CS}, 256, 0);
        k_gemm_naive<DenseSrc, EpiKV, false><<<dim3(M / 256, 1024 / 8), 256, 0, stream>>>(DenseSrc{CKV, wsp<bf16>(ws, WS_WUKV), 128, 0}, EpiKV{KT, VT, SSQ}, 128, 0);
        k_conv<<<M * 64 / 256, 256, 0, stream>>>(U, BG, in[5] + (size_t)l * 3 * 512, ACONV);
        k_mla_naive<<<64 * 64, 64, 0, stream>>>(Qb, KT, VT, OMLA);
        k_sb_naive<<<64 * 64, 64, 0, stream>>>(SBQ, SBKT, SBVT, OSB);
        for (int br = 0; br < 3; ++br) {
            k_gemm_naive<DenseSrc, EpiGate, false><<<dim3(M / 256, 1024 / 8), 256, 0, stream>>>(DenseSrc{XN, wsp<bf16>(ws, WS_WG) + (size_t)br * 1024 * 1024, 1024, 0}, EpiGate{GSCR, in[4] + (size_t)l * 3072 + br * 1024}, 1024, 0);
            const bf16* Abr = br == 0 ? ACONV : br == 1 ? OMLA : OSB; const size_t wo = br == 0 ? WS_WOC : br == 1 ? WS_WOM : WS_WOS;
            k_gemm_naive<DenseSrc, EpiY, false><<<dim3(M / 256, 1024 / 8), 256, 0, stream>>>(DenseSrc{Abr, wsp<bf16>(ws, wo), 512, 0}, EpiY{GSCR, MERGED, br == 0, 0}, 512, 0);
        }
        k_gemm_naive<DenseSrc, EpiWo, false><<<dim3(M / 256, 1024 / 8), 256, 0, stream>>>(DenseSrc{MERGED, wsp<bf16>(ws, WS_WO), 1024, 0}, EpiWo{l == 0 ? in[0] : XR, XR}, 1024, 0);
        k_t1_naive<<<M / 4, 256, 0, stream>>>(XR, in[14] + l * 1024, in[15] + (size_t)l * 1024 * 4, in[16] + l * 4, in[17] + (size_t)l * 1024 * 32, in[18] + l * 32, ws, l);
        const unsigned* cnt = wsp<unsigned>(ws, WS_CTL) + CW_CNT + l * 32 * 64;
        k_gemm_naive<MoeGUSrc, EpiGU, true><<<dim3(MOE_ROWS / 256, 32), 256, 0, stream>>>(MoeGUSrc{H2, wsp<bf16>(ws, WS_WGU), cnt, wsp<int>(ws, WS_LIST)}, EpiGU{ACT}, 1024, 0);
        k_gemm_naive<MoeDownSrc, EpiDown, false><<<dim3(MOE_ROWS / 256, 1024 / 8), 256, 0, stream>>>(MoeDownSrc{ACT, wsp<bf16>(ws, WS_WD), cnt}, EpiDown{Y}, 256, 0);
        k_t2<<<M / 4, 256, 0, stream>>>(XR, l + 1 < DEPTH ? in[2] + (l + 1) * 1024 : in[22], ws, l, l + 1 == DEPTH);
    }
}
```

```cpp
#ifndef MK_MODE
#define MK_MODE 0
#endif
#define ATTN_PHASE_BODY
#include <hip/hip_runtime.h>
#include <stdint.h>
#include <stdio.h>

#define DI __device__ __forceinline__
typedef unsigned short bf16;
typedef unsigned u32x4 __attribute__((ext_vector_type(4)));
typedef unsigned u32x2 __attribute__((ext_vector_type(2)));
typedef float f32x4 __attribute__((ext_vector_type(4)));
typedef float f32x2 __attribute__((ext_vector_type(2)));
typedef __bf16 bf16x2_t __attribute__((ext_vector_type(2)));

constexpr int D = 1024, NBATCH = 8, SEQ = 4096, M = NBATCH * SEQ, DEPTH = 2;
constexpr int CONVW = 512, QRANK = 256, KVRANK = 128, NH = 8;
constexpr int OFF_CQ = 1536, OFF_CKV = 1792, OFF_KR = 1920, OFF_SB = 1952, OFF_GATE = 3488, IN_COLS = 6560;
constexpr int NEXP = 32, NGRP = 4, EPG = 8, DEXP = 256;
constexpr int NA = 3584;
constexpr int MOE_ROWS = 73728;
constexpr float EPS = 1e-6f;
constexpr float LOG2E = 1.4426950408889634f;
constexpr float QSCALE_MLA = 0.10206207261596575f * LOG2E;
constexpr float QSCALE_SB = 0.125f * LOG2E;

constexpr size_t MiB = 1u << 20;
constexpr size_t WS_CTL = 0;
constexpr size_t WS_TOKSLOT = 1 * MiB;
constexpr size_t WS_TOKW = 1 * MiB + 512 * 1024;
constexpr size_t WS_LIST = 2 * MiB;
constexpr size_t WS_CS = 6 * MiB;
constexpr size_t WS_SSQ = 10 * MiB;
constexpr size_t WS_WA = 16 * MiB;
constexpr size_t WS_WG = 23 * MiB;
constexpr size_t WS_WUQ = 29 * MiB;
constexpr size_t WS_WUKV = 29 * MiB + 512 * 1024;
constexpr size_t WS_WOC = 30 * MiB, WS_WOM = 31 * MiB, WS_WOS = 32 * MiB;
constexpr size_t WS_WO = 33 * MiB;
constexpr size_t WS_WGU = 36 * MiB;
constexpr size_t WS_WD = 68 * MiB;
constexpr size_t WS_XN = 84 * MiB;
constexpr size_t WS_SBQ = 148 * MiB, WS_SBKT = 180 * MiB, WS_SBVT = 212 * MiB;
constexpr size_t WS_KT = 244 * MiB;
constexpr size_t WS_Q = 292 * MiB;
constexpr size_t WS_VT = 340 * MiB;
constexpr size_t WS_U = 372 * MiB, WS_BG = 404 * MiB;
constexpr size_t WS_CQ = 436 * MiB, WS_CKV = 452 * MiB;
constexpr size_t WS_ACONV = 460 * MiB;
constexpr size_t WS_OMLA = 372 * MiB, WS_OSB = 404 * MiB;
constexpr size_t WS_GSCR = 148 * MiB;
constexpr size_t WS_MERGED = 212 * MiB;
constexpr size_t WS_H2 = 148 * MiB;
constexpr size_t WS_ACT = 212 * MiB;
constexpr size_t WS_Y = 292 * MiB;
constexpr size_t WS_END = 492 * MiB;
constexpr int CW_CNT = 32768;

DI float bf2f(unsigned h) { return __uint_as_float(h << 16); }
DI unsigned pk2(float lo, float hi) { f32x2 v = {lo, hi}; bf16x2_t b = __builtin_convertvector(v, bf16x2_t); return __builtin_bit_cast(unsigned, b); }
DI u32x4 pk8(const float (&v)[8]) { u32x4 w; w.x = pk2(v[0], v[1]); w.y = pk2(v[2], v[3]); w.z = pk2(v[4], v[5]); w.w = pk2(v[6], v[7]); return w; }
DI void unpk8(u32x4 w, float (&v)[8]) { v[0] = bf2f(w.x & 0xffffu); v[1] = bf2f(w.x >> 16); v[2] = bf2f(w.y & 0xffffu); v[3] = bf2f(w.y >> 16);
    v[4] = bf2f(w.z & 0xffffu); v[5] = bf2f(w.z >> 16); v[6] = bf2f(w.w & 0xffffu); v[7] = bf2f(w.w >> 16); }
DI int lane_id() { int l = (int)__builtin_amdgcn_mbcnt_hi(~0u, __builtin_amdgcn_mbcnt_lo(~0u, 0u)); asm volatile("" : "+v"(l)); return l; }
DI float shfl_xor_l(float v, int o, int lane) { return __int_as_float(__builtin_amdgcn_ds_bpermute((lane ^ o) << 2, __float_as_int(v))); }
DI float wave_sum(float v) { const int l = lane_id();
#pragma unroll
    for (int o = 1; o < 64; o <<= 1) v += shfl_xor_l(v, o, l);
    return v;
}
template <int NCH> DI size_t kt_idx(int bh, int key, int chunk) { return ((((size_t)bh * (SEQ / 64) + (key >> 6)) * NCH + chunk) * 64 + (key & 63)) * 8; }
DI size_t vt_idx(int bh, int key, int d) { return ((((size_t)bh * (SEQ / 64) + (key >> 6)) * 8 + ((key & 63) >> 3)) * 64 + d) * 8 + (key & 7); }

DI bool moe_locate(const unsigned* cnt, int tile, int& e, int& i, int& rowbase) {
    int acc = 0;
    for (int k = 0; k < NEXP; ++k) { const int n = (int)((cnt[k * 64] + 255u) >> 8); if (tile < acc + n) { e = k; i = tile - acc; rowbase = acc * 256; return true; } acc += n; }
    return false;
}
DI int moe_base(const unsigned* cnt, int e) { int acc = 0; for (int k = 0; k < e; ++k) acc += (int)((cnt[k * 64] + 255u) >> 8); return acc * 256; }

struct WItem { const float* W; int ldw, K, src, perm; const float* gain; bf16* dst; int kb; };
constexpr int WI_A = (NA / 32) * 16, WI_G = 96 * 16, WI_UQ = 24 * 4, WI_UKV = 32 * 2, WI_OUT = 32 * 8, WI_O = 32 * 16, WI_GU = NEXP * 16 * 16, WI_D = NEXP * 32 * 4;
constexpr int WI_TOTAL = WI_A + WI_G + WI_UQ + WI_UKV + 3 * WI_OUT + WI_O + WI_GU + WI_D;
DI void wdecode(int it, const float* const* in, int l, unsigned char* ws, WItem& s) {
    const float* w_in = in[3] + (size_t)l * 1024 * IN_COLS;
    s.perm = 0; s.gain = nullptr;
    if (it < WI_A) { const int nb = it >> 4; s.kb = it & 15; s.W = w_in; s.ldw = IN_COLS; s.K = 1024; s.dst = (bf16*)(ws + WS_WA) + (size_t)nb * 32 * 1024;
        if (nb < 32) { const int T = nb >> 3, w = nb & 7; s.src = (w < 4) ? 128 * T + 32 * w : 1024 + 128 * T + 32 * (w - 4); }
        else if (nb < 48) s.src = 512 + 32 * (nb - 32);
        else if (nb < 96) s.src = OFF_SB + 32 * (nb - 48);
        else if (nb < 104) s.src = OFF_CQ + 32 * (nb - 96);
        else if (nb < 108) s.src = OFF_CKV + 32 * (nb - 104);
        else if (nb == 108) { s.src = OFF_KR; s.perm = 1; }
        else s.src = -1;
        return; }
    it -= WI_A;
    if (it < WI_G) { const int nb = it >> 4; s.kb = it & 15; s.W = w_in; s.ldw = IN_COLS; s.K = 1024; s.src = OFF_GATE + 32 * nb; s.dst = (bf16*)(ws + WS_WG) + (size_t)nb * 32 * 1024; return; }
    it -= WI_G;
    if (it < WI_UQ) { const int nb = it >> 2; s.kb = it & 3; s.W = in[9] + (size_t)l * 256 * 768; s.ldw = 768; s.K = 256; s.gain = in[7] + l * 256; const int h = nb / 3, part = nb % 3;
        s.src = h * 96 + part * 32; s.perm = (part == 2); s.dst = (bf16*)(ws + WS_WUQ) + (size_t)nb * 32 * 256; return; }
    it -= WI_UQ;
    if (it < WI_UKV) { const int nb = it >> 1; s.kb = it & 1; s.W = in[10] + (size_t)l * 128 * 1024; s.ldw = 1024; s.K = 128; s.gain = in[8] + l * 128;
        s.src = (nb < 16) ? (nb >> 1) * 128 + (nb & 1) * 32 : ((nb - 16) >> 1) * 128 + 64 + (nb & 1) * 32; s.dst = (bf16*)(ws + WS_WUKV) + (size_t)nb * 32 * 128; return; }
    it -= WI_UKV;
    for (int j = 0; j < 3; ++j) { if (it < WI_OUT) { const int nb = it >> 3; s.kb = it & 7; s.W = (j == 0 ? in[6] : j == 1 ? in[11] : in[12]) + (size_t)l * 512 * 1024; s.ldw = 1024; s.K = 512; s.src = 32 * nb;
            s.dst = (bf16*)(ws + (j == 0 ? WS_WOC : j == 1 ? WS_WOM : WS_WOS)) + (size_t)nb * 32 * 512; return; } it -= WI_OUT; }
    if (it < WI_O) { const int nb = it >> 4; s.kb = it & 15; s.W = in[13] + (size_t)l * 1024 * 1024; s.ldw = 1024; s.K = 1024; s.src = 32 * nb; s.dst = (bf16*)(ws + WS_WO) + (size_t)nb * 32 * 1024; return; }
    it -= WI_O;
    if (it < WI_GU) { const int e = it >> 8, r = it & 255, nb = r >> 4; s.kb = r & 15; const int pn = nb >> 3, w = nb & 7;
        s.W = (w < 4 ? in[19] : in[20]) + ((size_t)l * NEXP + e) * 1024 * 256; s.ldw = 256; s.K = 1024; s.src = 128 * pn + 32 * (w & 3); s.dst = (bf16*)(ws + WS_WGU) + ((size_t)e * 512 + nb * 32) * 1024; return; }
    it -= WI_GU;
    { const int e = it >> 7, r = it & 127, nb = r >> 2; s.kb = r & 3; s.W = in[21] + ((size_t)l * NEXP + e) * 256 * 1024; s.ldw = 1024; s.K = 256; s.src = 32 * nb; s.dst = (bf16*)(ws + WS_WD) + ((size_t)e * 1024 + nb * 32) * 256; }
}
template <class FP> DI void tr_item(const WItem& s, FP scr, int lane) {
    const int k0 = 64 * s.kb, c = lane & 31, sc = s.perm ? ((c & 1) * 16 + (c >> 1)) : c;
#pragma unroll 8
    for (int i = 0; i < 32; ++i) { const int kk = 2 * i + (lane >> 5); float w = 0.f;
        if (s.src >= 0) { w = s.W[(size_t)(k0 + kk) * s.ldw + s.src + sc]; if (s.gain) w *= s.gain[k0 + kk]; }
        scr[kk * 33 + c] = w; }
    asm volatile("s_waitcnt lgkmcnt(0)" ::: "memory");
    const int c8 = lane & 7;
#pragma unroll
    for (int j = 0; j < 4; ++j) { const int n = (lane >> 3) + 8 * j; const auto* p = scr + (8 * c8) * 33 + n;
        u32x4 o; o.x = pk2(p[0 * 33], p[1 * 33]); o.y = pk2(p[2 * 33], p[3 * 33]); o.z = pk2(p[4 * 33], p[5 * 33]); o.w = pk2(p[6 * 33], p[7 * 33]);
        *(u32x4*)(s.dst + (size_t)n * s.K + k0 + 8 * c8) = o; }
    asm volatile("s_waitcnt lgkmcnt(0)" ::: "memory");
}
DI void rms_row(const float* xrow, const float* g, bf16* orow, float* fout, int lane) {
    const f32x4* xr = (const f32x4*)xrow + lane; const f32x4* gr = (const f32x4*)g + lane;
    f32x4 v[4]; float s = 0.f;
#pragma unroll
    for (int j = 0; j < 4; ++j) { v[j] = xr[64 * j]; s += (v[j].x * v[j].x + v[j].y * v[j].y) + (v[j].z * v[j].z + v[j].w * v[j].w); }
    const float rstd = 1.0f / sqrtf(wave_sum(s) * (1.f / D) + EPS);
#pragma unroll
    for (int j = 0; j < 4; ++j) { const f32x4 gg = gr[64 * j]; const f32x4 y = v[j] * rstd * gg;
        if (orow) { u32x2 o; o.x = pk2(y.x, y.y); o.y = pk2(y.z, y.w); ((u32x2*)orow)[lane + 64 * j] = o; }
        if (fout) ((f32x4*)fout)[lane + 64 * j] = y; }
}
DI void cs_row(const int* positions, float2* CS, int row, int lane) {
    if (lane < 16) { const float freq = powf(10000.0f, -(float)lane / 16.0f); const float ang = (float)positions[row] * freq; const double a = (double)ang;
        CS[(size_t)row * 16 + lane] = make_float2((float)cos(a), (float)sin(a)); }
}

struct EpiWinA {
    bf16 *U, *BG, *SBQ, *SBKT, *SBVT, *CQ, *CKV, *KT; float* SSQ; const float2* CS;
    DI bool is_pair(int pn) const { return pn < 4; }
    DI float rowctx(int) const { return 0.f; }
    DI void pair(int row, int col0, const float (&a)[8], const float (&b)[8], float) const {
        const int T = col0 >> 8, c = col0 & 255; float u[8];
#pragma unroll
        for (int j = 0; j < 8; ++j) u[j] = a[j] * b[j];
        *(u32x4*)(U + (size_t)row * 512 + 128 * T + c) = pk8(u);
    }
    static constexpr bool ROWSTAT = true;
    DI bool wants_stat(int pn) const { return pn >= 12; }
    DI void rowstat(int row, int pn, int wc, float tot) const { SSQ[(size_t)row * 8 + (pn == 12 ? 0 : 4) + wc] = tot; }
    DI float operator()(int row, int col0, const float (&v)[8], float) const {
        const int b = row / SEQ, t = row % SEQ; float ret = 0.f;
        if (col0 < 1536) { *(u32x4*)(BG + (size_t)row * 512 + (col0 - 1024)) = pk8(v); }
        else if (col0 < 2048) { float q[8];
#pragma unroll
            for (int j = 0; j < 8; ++j) q[j] = v[j] * QSCALE_SB;
            *(u32x4*)(SBQ + (size_t)row * 512 + (col0 - 1536)) = pk8(q); }
        else if (col0 < 2560) { const int c = col0 - 2048, h = c >> 6, d = c & 63; *(u32x4*)(SBKT + kt_idx<8>(b * 8 + h, t, d >> 3)) = pk8(v); }
        else if (col0 < 3072) { const int c = col0 - 2560, h = c >> 6, d = c & 63;
#pragma unroll
            for (int j = 0; j < 8; ++j) SBVT[vt_idx(b * 8 + h, t, d + j)] = (bf16)(pk2(v[j], 0.f) & 0xffffu); }
        else if (col0 < 3328) { const int c = col0 - 3072; *(u32x4*)(CQ + (size_t)row * 256 + c) = pk8(v); float s = 0.f;
#pragma unroll
            for (int j = 0; j < 8; ++j) s += v[j] * v[j];
            ret = s; }
        else { const int c = col0 - 3328;
            if (c < 128) { *(u32x4*)(CKV + (size_t)row * 128 + c) = pk8(v); float s = 0.f;
#pragma unroll
                for (int j = 0; j < 8; ++j) s += v[j] * v[j];
                ret = s; }
            else if (c < 160) { const int i0 = (c - 128) >> 1; float r[8];
#pragma unroll
                for (int j = 0; j < 4; ++j) { const float2 cs = CS[(size_t)row * 16 + i0 + j]; const float x1 = v[2 * j], x2 = v[2 * j + 1]; r[2 * j] = x1 * cs.x - x2 * cs.y; r[2 * j + 1] = x2 * cs.x + x1 * cs.y; }
                const u32x4 w = pk8(r); const int chunk = 8 + ((c - 128) >> 3);
#pragma unroll
                for (int h = 0; h < NH; ++h) *(u32x4*)(KT + kt_idx<12>(b * 8 + h, t, chunk)) = w; }
        }
        return ret;
    }
};
struct EpiQ {
    bf16* Q; const float* SSQ; const float2* CS;
    DI bool is_pair(int) const { return false; }
    DI void pair(int, int, const float (&)[8], const float (&)[8], float) const {}
    static constexpr bool ROWSTAT = false;
    DI bool wants_stat(int) const { return false; }
    DI void rowstat(int, int, int, float) const {}
    DI float rowctx(int row) const { const f32x4 x = *(const f32x4*)(SSQ + (size_t)row * 8); return 1.0f / sqrtf(((x.x + x.y) + (x.z + x.w)) * (1.f / 256.f) + EPS); }
    DI float operator()(int row, int col0, const float (&v)[8], float rstd) const {
        const int dd = col0 % 96; float r[8];
#pragma unroll
        for (int j = 0; j < 8; ++j) r[j] = v[j] * rstd;
        if (dd >= 64) { const int i0 = (dd - 64) >> 1;
#pragma unroll
            for (int j = 0; j < 4; ++j) { const float2 cs = CS[(size_t)row * 16 + i0 + j]; const float x1 = r[2 * j], x2 = r[2 * j + 1]; r[2 * j] = x1 * cs.x - x2 * cs.y; r[2 * j + 1] = x2 * cs.x + x1 * cs.y; } }
#pragma unroll
        for (int j = 0; j < 8; ++j) r[j] *= QSCALE_MLA;
        *(u32x4*)(Q + (size_t)row * 768 + col0) = pk8(r); return 0.f;
    }
};
struct EpiKV {
    bf16 *KT, *VT; const float* SSQ;
    DI bool is_pair(int) const { return false; }
    DI void pair(int, int, const float (&)[8], const float (&)[8], float) const {}
    static constexpr bool ROWSTAT = false;
    DI bool wants_stat(int) const { return false; }
    DI void rowstat(int, int, int, float) const {}
    DI float rowctx(int row) const { const f32x4 x = *(const f32x4*)(SSQ + (size_t)row * 8 + 4); return 1.0f / sqrtf(((x.x + x.y) + (x.z + x.w)) * (1.f / 128.f) + EPS); }
    DI float operator()(int row, int col0, const float (&v)[8], float rstd) const {
        const int b = row / SEQ, t = row % SEQ; float r[8];
#pragma unroll
        for (int j = 0; j < 8; ++j) r[j] = v[j] * rstd;
        if (col0 < 512) { const int h = col0 >> 6, d = col0 & 63; *(u32x4*)(KT + kt_idx<12>(b * 8 + h, t, d >> 3)) = pk8(r); }
        else { const int c = col0 - 512, h = c >> 6, d = c & 63;
#pragma unroll
            for (int j = 0; j < 8; ++j) VT[vt_idx(b * 8 + h, t, d + j)] = (bf16)(pk2(r[j], 0.f) & 0xffffu); }
        return 0.f;
    }
};
struct EpiGate {
    bf16* GSCR; const float* bgate;
    DI bool is_pair(int) const { return false; }
    DI void pair(int, int, const float (&)[8], const float (&)[8], float) const {}
    DI float rowctx(int) const { return 0.f; }
    static constexpr bool ROWSTAT = false;
    DI bool wants_stat(int) const { return false; }
    DI void rowstat(int, int, int, float) const {}
    DI float operator()(int row, int col0, const float (&v)[8], float) const { float r[8];
#pragma unroll
        for (int j = 0; j < 8; ++j) r[j] = 1.0f / (1.0f + __expf(-(v[j] + bgate[col0 + j])));
        *(u32x4*)(GSCR + (size_t)row * 1024 + col0) = pk8(r); return 0.f; }
};
struct EpiY {
    const bf16* GSCR; bf16* MERGED; int first; int pad;
    DI bool is_pair(int) const { return false; }
    DI void pair(int, int, const float (&)[8], const float (&)[8], float) const {}
    DI float rowctx(int) const { return 0.f; }
    static constexpr bool ROWSTAT = false;
    DI bool wants_stat(int) const { return false; }
    DI void rowstat(int, int, int, float) const {}
    DI float operator()(int row, int col0, const float (&v)[8], float) const { float g[8], m[8];
        unpk8(*(const u32x4*)(GSCR + (size_t)row * 1024 + col0), g);
        if (first) {
#pragma unroll
            for (int j = 0; j < 8; ++j) m[j] = 0.f; }
        else unpk8(*(const u32x4*)(MERGED + (size_t)row * 1024 + col0), m);
#pragma unroll
        for (int j = 0; j < 8; ++j) m[j] += g[j] * v[j];
        *(u32x4*)(MERGED + (size_t)row * 1024 + col0) = pk8(m); return 0.f; }
};
struct EpiWo {
    const float* xin; float* XR;
    DI bool is_pair(int) const { return false; }
    DI void pair(int, int, const float (&)[8], const float (&)[8], float) const {}
    DI float rowctx(int) const { return 0.f; }
    static constexpr bool ROWSTAT = false;
    DI bool wants_stat(int) const { return false; }
    DI void rowstat(int, int, int, float) const {}
    DI float operator()(int row, int col0, const float (&v)[8], float) const {
        const f32x4 a = *(const f32x4*)(xin + (size_t)row * 1024 + col0), b = *(const f32x4*)(xin + (size_t)row * 1024 + col0 + 4);
        *(f32x4*)(XR + (size_t)row * 1024 + col0) = (f32x4){a.x + v[0], a.y + v[1], a.z + v[2], a.w + v[3]};
        *(f32x4*)(XR + (size_t)row * 1024 + col0 + 4) = (f32x4){b.x + v[4], b.y + v[5], b.z + v[6], b.w + v[7]}; return 0.f; }
};
struct EpiGU {
    bf16* ACT;
    DI bool is_pair(int) const { return true; }
    DI float rowctx(int) const { return 0.f; }
    static constexpr bool ROWSTAT = false;
    DI bool wants_stat(int) const { return false; }
    DI void rowstat(int, int, int, float) const {}
    DI float operator()(int, int, const float (&)[8], float) const { return 0.f; }
    DI void pair(int row, int col0, const float (&a)[8], const float (&b)[8], float) const { const int pn = col0 >> 8, c = col0 & 255; float r[8];
#pragma unroll
        for (int j = 0; j < 8; ++j) r[j] = a[j] / (1.0f + __expf(-a[j])) * b[j];
        *(u32x4*)(ACT + (size_t)row * 256 + 128 * pn + c) = pk8(r); }
};
struct EpiDown {
    bf16* Y;
    DI bool is_pair(int) const { return false; }
    DI void pair(int, int, const float (&)[8], const float (&)[8], float) const {}
    DI float rowctx(int) const { return 0.f; }
    static constexpr bool ROWSTAT = false;
    DI bool wants_stat(int) const { return false; }
    DI void rowstat(int, int, int, float) const {}
    DI float operator()(int row, int col0, const float (&v)[8], float) const { *(u32x4*)(Y + (size_t)row * 1024 + col0) = pk8(v); return 0.f; }
};

DI void conv_item(const bf16* U, const bf16* BG, const float* cw, bf16* ACONV, int row, int c8) {
    const int t = row % SEQ, c = c8 * 8; float u0[8], u1[8], u2[8], bg[8], r[8];
    unpk8(*(const u32x4*)(U + (size_t)row * 512 + c), u2);
    if (t >= 1) unpk8(*(const u32x4*)(U + (size_t)(row - 1) * 512 + c), u1); else {
#pragma unroll
        for (int j = 0; j < 8; ++j) u1[j] = 0.f; }
    if (t >= 2) unpk8(*(const u32x4*)(U + (size_t)(row - 2) * 512 + c), u0); else {
#pragma unroll
        for (int j = 0; j < 8; ++j) u0[j] = 0.f; }
    unpk8(*(const u32x4*)(BG + (size_t)row * 512 + c), bg);
#pragma unroll
    for (int j = 0; j < 8; ++j) r[j] = bg[j] * (cw[c + j] * u0[j] + cw[512 + c + j] * u1[j] + cw[1024 + c + j] * u2[j]);
    *(u32x4*)(ACONV + (size_t)row * 512 + c) = pk8(r);
}
__global__ void __launch_bounds__(64) k_mla_naive(const bf16* Q, const bf16* KT, const bf16* VT, bf16* O) {
    const int lane = threadIdx.x, qb = blockIdx.x & 63, bh = blockIdx.x >> 6, b = bh >> 3, h = bh & 7;
    const int q = qb * 64 + lane; const size_t row = (size_t)b * SEQ + q;
    float qv[96], acc[64];
#pragma unroll
    for (int c = 0; c < 12; ++c) { float t[8]; unpk8(*(const u32x4*)(Q + row * 768 + h * 96 + c * 8), t);
#pragma unroll
        for (int j = 0; j < 8; ++j) qv[c * 8 + j] = t[j]; }
#pragma unroll
    for (int d = 0; d < 64; ++d) acc[d] = 0.f;
    float m = -INFINITY, l = 0.f;
    for (int key = 0; key <= qb * 64 + 63; ++key) {
        float s = 0.f;
#pragma unroll
        for (int c = 0; c < 12; ++c) { float t[8]; unpk8(*(const u32x4*)(KT + kt_idx<12>(bh, key, c)), t);
#pragma unroll
            for (int j = 0; j < 8; ++j) s += qv[c * 8 + j] * t[j]; }
        if (key <= q) { const float mn = fmaxf(m, s), corr = exp2f(m - mn), p = exp2f(s - mn); l = l * corr + p; m = mn;
#pragma unroll
            for (int d = 0; d < 64; ++d) acc[d] = acc[d] * corr + p * bf2f(VT[vt_idx(bh, key, d)]); }
    }
    const float il = 1.0f / l;
#pragma unroll
    for (int c = 0; c < 8; ++c) { float t[8];
#pragma unroll
        for (int j = 0; j < 8; ++j) t[j] = acc[c * 8 + j] * il;
        *(u32x4*)(O + row * 512 + h * 64 + c * 8) = pk8(t); }
}
__global__ void __launch_bounds__(64) k_sb_naive(const bf16* Q, const bf16* KT, const bf16* VT, bf16* O) {
    const int lane = threadIdx.x, qb = blockIdx.x & 63, bh = blockIdx.x >> 6, b = bh >> 3, h = bh & 7;
    const int q = qb * 64 + lane; const size_t row = (size_t)b * SEQ + q;
    float qv[64], acc[64];
#pragma unroll
    for (int c = 0; c < 8; ++c) { float t[8]; unpk8(*(const u32x4*)(Q + row * 512 + h * 64 + c * 8), t);
#pragma unroll
        for (int j = 0; j < 8; ++j) qv[c * 8 + j] = t[j]; }
#pragma unroll
    for (int d = 0; d < 64; ++d) acc[d] = 0.f;
    float R = 0.f;
    for (int key = qb * 64 + 62; key >= 0; --key) {
        float z = 0.f;
#pragma unroll
        for (int c = 0; c < 8; ++c) { float t[8]; unpk8(*(const u32x4*)(KT + kt_idx<8>(bh, key, c)), t);
#pragma unroll
            for (int j = 0; j < 8; ++j) z += qv[c * 8 + j] * t[j]; }
        if (key < q) { const float L = -(fmaxf(z, 0.f) + log2f(1.0f + exp2f(-fabsf(z)))); const float a = exp2f(z + L + R); R += L;
#pragma unroll
            for (int d = 0; d < 64; ++d) acc[d] += a * bf2f(VT[vt_idx(bh, key, d)]); }
    }
#pragma unroll
    for (int c = 0; c < 8; ++c) { float t[8];
#pragma unroll
        for (int j = 0; j < 8; ++j) t[j] = acc[c * 8 + j];
        *(u32x4*)(O + row * 512 + h * 64 + c * 8) = pk8(t); }
}
DI void t2_row(float* XRrow, const bf16* Y, const unsigned* cnt, int4 ts, float2 tw, const float* gnext, bf16* xnrow, int final_, int lane) {
    const size_t a1 = (size_t)moe_base(cnt, ts.x) + ts.y, a2 = (size_t)moe_base(cnt, ts.z) + ts.w;
    f32x4* xr = (f32x4*)XRrow + lane; const u32x2* y1 = (const u32x2*)(Y + a1 * 1024) + lane; const u32x2* y2 = (const u32x2*)(Y + a2 * 1024) + lane; const f32x4* gr = (const f32x4*)gnext + lane;
    f32x4 v[4]; float s = 0.f;
#pragma unroll
    for (int j = 0; j < 4; ++j) { v[j] = xr[64 * j]; const u32x2 p = y1[64 * j], q = y2[64 * j];
        v[j].x += tw.x * bf2f(p.x & 0xffffu) + tw.y * bf2f(q.x & 0xffffu); v[j].y += tw.x * bf2f(p.x >> 16) + tw.y * bf2f(q.x >> 16);
        v[j].z += tw.x * bf2f(p.y & 0xffffu) + tw.y * bf2f(q.y & 0xffffu); v[j].w += tw.x * bf2f(p.y >> 16) + tw.y * bf2f(q.y >> 16);
        s += (v[j].x * v[j].x + v[j].y * v[j].y) + (v[j].z * v[j].z + v[j].w * v[j].w); }
    const float rstd = 1.0f / sqrtf(wave_sum(s) * (1.f / D) + EPS);
#pragma unroll
    for (int j = 0; j < 4; ++j) { const f32x4 y = v[j] * rstd * gr[64 * j];
        if (final_) xr[64 * j] = y; else { xr[64 * j] = v[j]; u32x2 o; o.x = pk2(y.x, y.y); o.y = pk2(y.z, y.w); ((u32x2*)xnrow)[lane + 64 * j] = o; } }
}
#define LAS __attribute__((address_space(3)))
namespace pg8 {
typedef short bf16x8 __attribute__((ext_vector_type(8)));
constexpr int BM = 256, BK = 64, HALF = 128, HTB = HALF * BK * 2, STAGE_BYTES = 8 * HTB, NXCD = 8, WGM = 8;
DI int lds_byte(int r, int c) { const int st = (r >> 4) * 2 + (c >> 5), rr = r & 15, cc = c & 31, ob = rr * 64 + cc * 2; return st * 1024 + (ob ^ (((ob >> 9) & 1) << 5)); }
DI void stage_rc(int b, int& R, int& C) { const int st = b / 1024, sb = b % 1024, swz = sb ^ (((sb >> 9) & 1) << 5); R = (st >> 1) * 16 + swz / 64; C = (st & 1) * 32 + (swz % 64) / 2; }
DI int perm32(int rho) { const int n = rho >> 4, i = rho & 15; return 8 * (i >> 2) + 4 * n + (i & 3); }
struct Unit { const char* a; const char* b; const int* gl; int row0, col0, pn, nvalid; };
struct DenseOrder {
    const char *A, *B; int nM, nN, nwg, G, c, K;
    DI void init(const void* A_, const void* B_, int Mrows, int N, int K_, int G_, int c_) { A = (const char*)A_; B = (const char*)B_; nM = Mrows / BM; nN = N / BM; nwg = nM * nN; G = G_; c = c_; K = K_; }
    DI bool next(int i, Unit& u) const {
        const long L = (long)i * G + c; if (L >= nwg) return false;
        int wgid = (int)L; { const int q = nwg / NXCD, r = nwg % NXCD, xcd = wgid % NXCD, off = wgid / NXCD; wgid = (xcd < r ? xcd * (q + 1) : r * (q + 1) + (xcd - r) * q) + off; }
        const int nig = WGM * nN, gid = wgid / nig, fm = gid * WGM, gsz = (nM - fm) < WGM ? (nM - fm) : WGM;
        const int pm = fm + ((wgid % nig) % gsz), pn = (wgid % nig) / gsz;
        u.a = A + (size_t)pm * BM * K * 2; u.b = B + (size_t)pn * BM * K * 2; u.gl = nullptr; u.row0 = pm * BM; u.col0 = pn * BM; u.pn = pn; u.nvalid = 256; return true;
    }
};
template <bool GATHER> struct GroupedOrder {
    const unsigned* cnt; const char* A; const char* B; const int* LIST; int K, NCT, brows, G, c;
    DI bool next(int i, Unit& u) const {
        const int L = i * G + c, rt = L / NCT, pn = L % NCT; int e, ti, rb; if (!moe_locate(cnt, rt, e, ti, rb)) return false;
        u.row0 = rt * BM; u.col0 = pn * BM; u.pn = pn; u.b = B + ((size_t)e * brows + pn * BM) * K * 2;
        if (GATHER) { u.a = A; u.gl = LIST + (size_t)e * M + ti * BM; const int rem = (int)cnt[e * 64] - ti * BM; u.nvalid = rem < BM ? rem : BM; }
        else { u.a = A + (size_t)rt * BM * K * 2; u.gl = nullptr; u.nvalid = 256; }
        return true;
    }
};
template <class E> struct EpiAdapt {
    E e;
    DI void operator()(const f32x4 (&acc)[2][2][4][2], const Unit& u, int wr, int wc, int fr, int fq) const {
        const bool pr = e.is_pair(u.pn);
#pragma unroll
        for (int ai = 0; ai < 2; ++ai)
#pragma unroll
            for (int m = 0; m < 4; ++m) {
                int row = u.row0 + ai * HALF + wr * 64 + m * 16 + fr; asm volatile("" : "+v"(row));
                const float ctx = e.rowctx(row);
                if (pr) { float a[8], b[8];
#pragma unroll
                    for (int j = 0; j < 4; ++j) { a[j] = acc[ai][0][m][0][j]; a[4 + j] = acc[ai][0][m][1][j]; b[j] = acc[ai][1][m][0][j]; b[4 + j] = acc[ai][1][m][1][j]; }
                    e.pair(row, u.col0 + wc * 32 + 8 * fq, a, b, ctx); }
                else { float part = 0.f;
#pragma unroll
                    for (int bj = 0; bj < 2; ++bj) { float v[8];
#pragma unroll
                        for (int j = 0; j < 4; ++j) { v[j] = acc[ai][bj][m][0][j]; v[4 + j] = acc[ai][bj][m][1][j]; }
                        part += e(row, u.col0 + bj * HALF + wc * 32 + 8 * fq, v, ctx); }
                    if (E::ROWSTAT && e.wants_stat(u.pn)) { const int ln = fr | (fq << 4); part += shfl_xor_l(part, 16, ln); part += shfl_xor_l(part, 32, ln); if (fq == 0) e.rowstat(row, u.pn, wc, part); } }
                asm volatile("" ::: "memory");
            }
    }
};
template <class Epi, class Sched, bool GATHER>
DI void gemm_phase(LAS unsigned char* lds, const int wid_in, const int K, const Sched& S, const Epi& E) {
    int wid = wid_in; asm volatile("" : "+s"(wid));
    const int lane = lane_id(), tid = wid * 64 + lane, wr = wid >> 2, wc = wid & 3, fr = lane & 15, fq = lane >> 4;
    const int nt = K / BK;
    int RA[2], CA[2]; unsigned voffB[2];
#pragma unroll
    for (int i = 0; i < 2; ++i) { int R, C; stage_rc(tid * 16 + i * 8192, R, C); RA[i] = R; CA[i] = C; const int Rb = (R & ~31) + perm32(R & 31); voffB[i] = (unsigned)(Rb * K + C) * 2u; }
    const size_t kstep = (size_t)(BK * 2), hstep = (size_t)HALF * K * 2;
    const unsigned ldsw = (unsigned)wid * 1024u;
    const int aoff = lds_byte(wr * 64 + fr, fq * 8), boff = lds_byte(wc * 32 + fr, fq * 8);
#define PG8_SA(b, h) (((b) * 2 + (h)) * HTB)
#define PG8_SB(b, h) ((4 + (b) * 2 + (h)) * HTB)
#define PG8_STAGE_B(bufoff, gbase) do { _Pragma("unroll") for (int _i = 0; _i < 2; ++_i) { unsigned _o = voffB[_i]; asm volatile("" : "+v"(_o));   \
        __builtin_amdgcn_global_load_lds((const unsigned*)((const char*)(gbase) + _o), (LAS unsigned*)(lds + (bufoff) + ldsw + _i * 8192), 16, 0, 0); } } while (0)
#define PG8_STAGE_A(bufoff, gbase, vo, h) do { _Pragma("unroll") for (int _i = 0; _i < 2; ++_i) { unsigned _o = (vo)[GATHER ? (h) : 0][_i]; asm volatile("" : "+v"(_o)); \
        __builtin_amdgcn_global_load_lds((const unsigned*)((const char*)(gbase) + (GATHER ? (size_t)0 : (size_t)(h) * hstep) + _o), (LAS unsigned*)(lds + (bufoff) + ldsw + _i * 8192), 16, 0, 0); } } while (0)
#define PG8_SETVO(vo, u) do { _Pragma("unroll") for (int _h = 0; _h < (GATHER ? 2 : 1); ++_h) _Pragma("unroll") for (int _i = 0; _i < 2; ++_i) { const int _r = _h * HALF + RA[_i]; \
        if (GATHER) { const int _tok = (_r < (u).nvalid) ? (u).gl[_r] : 0; vo[_h][_i] = (unsigned)(_tok * K + CA[_i]) * 2u; } else vo[_h][_i] = (unsigned)(_r * K + CA[_i]) * 2u; } } while (0)
#define PG8_LDA(dst, b, h) do { _Pragma("unroll") for (int m = 0; m < 4; ++m) _Pragma("unroll") for (int k = 0; k < 2; ++k) dst[m][k] = *(const LAS bf16x8*)(lds + PG8_SA(b, h) + aoff + m * 2048 + k * 1024); } while (0)
#define PG8_LDB(dst, b, h) do { _Pragma("unroll") for (int n = 0; n < 2; ++n) _Pragma("unroll") for (int k = 0; k < 2; ++k) dst[n][k] = *(const LAS bf16x8*)(lds + PG8_SB(b, h) + boff + n * 2048 + k * 1024); } while (0)
#define PG8_MMA(ai, bj, At, Bt) do { __builtin_amdgcn_s_setprio(1); _Pragma("unroll") for (int m = 0; m < 4; ++m) _Pragma("unroll") for (int n = 0; n < 2; ++n) _Pragma("unroll") for (int k = 0; k < 2; ++k) \
        acc[ai][bj][m][n] = __builtin_amdgcn_mfma_f32_16x16x32_bf16(Bt[n][k], At[m][k], acc[ai][bj][m][n], 0, 0, 0); __builtin_amdgcn_s_setprio(0); } while (0)
#define PG8_WAIT_V(n) asm volatile("s_waitcnt vmcnt(" #n ")" ::: "memory")
#define PG8_WAIT_L(n) asm volatile("s_waitcnt lgkmcnt(" #n ")" ::: "memory")
#define PG8_BAR __builtin_amdgcn_s_barrier()
#define PG8_SCHED __builtin_amdgcn_sched_barrier(0)
    Unit cur, nxt; int ui = 0;
    if (!S.next(0, cur)) return;
    f32x4 acc[2][2][4][2];
#pragma unroll
    for (int a = 0; a < 2; ++a)
#pragma unroll
        for (int b = 0; b < 2; ++b)
#pragma unroll
            for (int m = 0; m < 4; ++m)
#pragma unroll
                for (int n = 0; n < 2; ++n) acc[a][b][m][n] = (f32x4){0.f, 0.f, 0.f, 0.f};
    bf16x8 At[4][2], B0[2][2], B1[2][2];
    unsigned voffA[GATHER ? 2 : 1][2], voffN[GATHER ? 2 : 1][2];
    PG8_SETVO(voffA, cur);
    const char* cA = cur.a; const char* cB = cur.b;
    PG8_STAGE_B(PG8_SB(0, 0), cB); PG8_STAGE_B(PG8_SB(0, 1), cB + hstep); PG8_STAGE_A(PG8_SA(0, 0), cA, voffA, 0); PG8_STAGE_A(PG8_SA(0, 1), cA, voffA, 1);
    if (wr == 1) PG8_BAR;
    PG8_WAIT_V(2); PG8_BAR;
    PG8_STAGE_B(PG8_SB(1, 0), cB + kstep); PG8_STAGE_A(PG8_SA(1, 0), cA + kstep, voffA, 0); PG8_STAGE_B(PG8_SB(1, 1), cB + hstep + kstep);
    PG8_WAIT_V(6); PG8_BAR;
    for (;;) {
        const bool has_next = S.next(ui + 1, nxt);
        const char* nA = has_next ? nxt.a : cA; const char* nB = has_next ? nxt.b : cB;
        if (GATHER) { if (has_next) { PG8_SETVO(voffN, nxt); } else {
#pragma unroll
            for (int h = 0; h < (GATHER ? 2 : 1); ++h)
#pragma unroll
                for (int i = 0; i < 2; ++i) voffN[h][i] = voffA[h][i]; } }
        for (int t = 0; t < nt; t += 2) {
            const bool last = (t == nt - 2);
            const char* a1 = cA + (size_t)(t + 1) * kstep;
            const char* a2 = last ? nA : cA + (size_t)(t + 2) * kstep; const char* b2 = last ? nB : cB + (size_t)(t + 2) * kstep;
            const char* a3 = a2 + kstep; const char* b3 = b2 + kstep;
            unsigned v2[GATHER ? 2 : 1][2];
#pragma unroll
            for (int h = 0; h < (GATHER ? 2 : 1); ++h)
#pragma unroll
                for (int i = 0; i < 2; ++i) v2[h][i] = (GATHER && last) ? voffN[h][i] : voffA[h][i];
            PG8_LDB(B0, 0, 0); PG8_LDB(B1, 0, 1); PG8_SCHED; PG8_LDA(At, 0, 0); PG8_STAGE_A(PG8_SA(1, 1), a1, voffA, 1);
            PG8_WAIT_V(8); PG8_WAIT_L(0); PG8_BAR; PG8_MMA(0, 0, At, B0); PG8_MMA(0, 1, At, B1); PG8_BAR; PG8_SCHED;
            PG8_LDA(At, 0, 1); PG8_STAGE_B(PG8_SB(0, 0), b2); PG8_STAGE_B(PG8_SB(0, 1), b2 + hstep); PG8_STAGE_A(PG8_SA(0, 0), a2, v2, 0);
            PG8_WAIT_V(8); PG8_WAIT_L(0); PG8_BAR; PG8_MMA(1, 0, At, B0); PG8_MMA(1, 1, At, B1); PG8_BAR; PG8_SCHED;
            PG8_LDB(B0, 1, 0); PG8_LDB(B1, 1, 1); PG8_SCHED; PG8_LDA(At, 1, 0); PG8_STAGE_A(PG8_SA(0, 1), a2, v2, 1);
            PG8_WAIT_V(8); PG8_WAIT_L(0); PG8_BAR; PG8_MMA(0, 0, At, B0); PG8_MMA(0, 1, At, B1); PG8_BAR; PG8_SCHED;
            PG8_LDA(At, 1, 1); PG8_STAGE_B(PG8_SB(1, 0), b3); PG8_STAGE_B(PG8_SB(1, 1), b3 + hstep); PG8_STAGE_A(PG8_SA(1, 0), a3, v2, 0);
            PG8_WAIT_V(8); PG8_WAIT_L(0); PG8_BAR; PG8_MMA(1, 0, At, B0); PG8_MMA(1, 1, At, B1); PG8_BAR; PG8_SCHED;
        }
        if (wr == 0) PG8_BAR;
        E(acc, cur, wr, wc, fr, fq);
        if (!has_next) break;
#pragma unroll
        for (int a = 0; a < 2; ++a)
#pragma unroll
            for (int b = 0; b < 2; ++b)
#pragma unroll
                for (int m = 0; m < 4; ++m)
#pragma unroll
                    for (int n = 0; n < 2; ++n) acc[a][b][m][n] = (f32x4){0.f, 0.f, 0.f, 0.f};
        cur = nxt; cA = nA; cB = nB; ++ui;
        if (GATHER) {
#pragma unroll
        for (int h = 0; h < (GATHER ? 2 : 1); ++h)
#pragma unroll
            for (int i = 0; i < 2; ++i) voffA[h][i] = voffN[h][i]; }
        if (wr == 1) PG8_BAR;
    }
    PG8_WAIT_V(0);
    PG8_BAR;
#undef PG8_SA
#undef PG8_SB
#undef PG8_STAGE_A
#undef PG8_STAGE_B
#undef PG8_SETVO
#undef PG8_LDA
#undef PG8_LDB
#undef PG8_MMA
#undef PG8_WAIT_V
#undef PG8_WAIT_L
#undef PG8_BAR
#undef PG8_SCHED
}
}

#define XB_TMO      128
#define XB_XCNT(j)  (256  + 64 * (j))
#define XB_XSUB(j)  (1280 + 64 * (j))
#define XB_XGEN(j)  (2304 + 64 * (j))
#define XB_TOP      3328
#define XB_TOPGEN   3392
#define XCD_BAR_WORDS 3456
#define XB_SPIN_CAP (1u << 18)

__device__ __forceinline__ unsigned xb_ld(unsigned* p)              { return __hip_atomic_load(p, __ATOMIC_RELAXED, __HIP_MEMORY_SCOPE_AGENT); }
__device__ __forceinline__ unsigned xb_add(unsigned* p, unsigned v) { return __hip_atomic_fetch_add(p, v, __ATOMIC_RELAXED, __HIP_MEMORY_SCOPE_AGENT); }
__device__ __forceinline__ unsigned xb_xcc_id() { return (unsigned)__builtin_amdgcn_s_getreg((3 << 11) | 20) & 0xFu; }
#define XB_SPIN(cond, bar) do { unsigned _sp = 0; while (cond) { __builtin_amdgcn_s_sleep(1); \
    if ((++_sp & 255u) == 0u) { if (xb_ld(&(bar)[XB_TMO])) break; if (_sp > XB_SPIN_CAP) { atomicAdd(&(bar)[XB_TMO], 1u); break; } } } } while (0)

struct XcdBarrier {
    unsigned* bar; unsigned x;
    volatile LAS unsigned* st;
    int wave;
};

__device__ __forceinline__ XcdBarrier xcd_barrier_post(unsigned* bar, volatile LAS unsigned* st) {
    XcdBarrier b; b.bar = bar; b.x = xb_xcc_id(); b.st = st;
    if (threadIdx.x == 0) (void)xb_add(&bar[XB_XCNT(b.x)], 1u);
    return b;
}
__device__ __forceinline__ void xcd_barrier_complete(unsigned* bar, unsigned x, unsigned& nloc, unsigned& nx) {
    const unsigned G = gridDim.x * gridDim.y * gridDim.z;
    unsigned sum, cnt, mine, sp = 0u;
    for (;;) {
        sum = 0u; cnt = 0u; mine = 0u;
#pragma unroll
        for (unsigned j = 0; j < 16; ++j) { const unsigned c = xb_ld(&bar[XB_XCNT(j)]); sum += c; cnt += (c > 0u) ? 1u : 0u; mine = (j == x) ? c : mine; }
        if (sum == G) break;
        __builtin_amdgcn_s_sleep(1);
        if ((++sp & 255u) == 0u) { if (xb_ld(&bar[XB_TMO])) break; if (sp > XB_SPIN_CAP) { atomicAdd(&bar[XB_TMO], 1u); break; } }
    }
    nloc = mine > 0u ? mine : 1u; nx = cnt > 0u ? cnt : 1u;
}

__device__ __forceinline__ void xcd_barrier(const XcdBarrier& b) {
    asm volatile("s_waitcnt vmcnt(0)" ::: "memory");
    __syncthreads();
    if (b.wave == 0 && lane_id() == 0) {
        unsigned* bar = b.bar;
        __builtin_amdgcn_s_waitcnt(0);
        unsigned nloc = b.st[0], nx = b.st[1];
        if (nloc == 0u) { xcd_barrier_complete(bar, b.x, nloc, nx); b.st[0] = nloc; b.st[1] = nx; }
        const unsigned old = xb_add(&bar[XB_XSUB(b.x)], 1u);
        const unsigned gen = old / nloc;
        if (old + 1u == (gen + 1u) * nloc) {
            __builtin_amdgcn_fence(__ATOMIC_RELEASE, "agent");
            asm volatile("s_waitcnt vmcnt(0)" ::: "memory");
            const unsigned og = xb_add(&bar[XB_TOP], 1u);
            const unsigned tg = og / nx;
            if (og + 1u == (tg + 1u) * nx) xb_add(&bar[XB_TOPGEN], 1u);
            else XB_SPIN(xb_ld(&bar[XB_TOPGEN]) == tg, bar);
            __builtin_amdgcn_fence(__ATOMIC_ACQUIRE, "agent");
            xb_add(&bar[XB_XGEN(b.x)], 1u);
            asm volatile("s_waitcnt vmcnt(0)" ::: "memory");
        } else {
            XB_SPIN(xb_ld(&bar[XB_XGEN(b.x)]) == gen, bar);
            __builtin_amdgcn_fence(__ATOMIC_ACQUIRE, "agent");
            asm volatile("s_waitcnt vmcnt(0)" ::: "memory");
        }
    }
    __syncthreads();
}

constexpr int NWAVES = 8, RING_BYTES = 131072, LDSCTL_OFF = RING_BYTES, MISC_OFF = LDSCTL_OFF + 320, LDS_BYTES = 147456;
constexpr int CW_BAR = 4096;
constexpr int NPHASE = 1 + 9 * DEPTH;
struct Args { const float* in[23]; float* out; unsigned char* ws; int ph_lo, ph_hi, li, pad; };

DI void t1_row(const float* XRrow, const float* g, const float* wrg, const float* brg, const float* wre, const float* bre, unsigned char* ws, int layer, int row, int lane) {
    const f32x4* xr = (const f32x4*)XRrow + lane; const f32x4* gr = (const f32x4*)g + lane;
    f32x4 v[4]; float s = 0.f;
#pragma unroll
    for (int j = 0; j < 4; ++j) { v[j] = xr[64 * j]; s += (v[j].x * v[j].x + v[j].y * v[j].y) + (v[j].z * v[j].z + v[j].w * v[j].w); }
    const float rstd = 1.0f / sqrtf(wave_sum(s) * (1.f / D) + EPS);
    bf16* orow = (bf16*)(ws + WS_H2) + (size_t)row * D;
#pragma unroll
    for (int j = 0; j < 4; ++j) { v[j] = v[j] * rstd * gr[64 * j]; u32x2 o; o.x = pk2(v[j].x, v[j].y); o.y = pk2(v[j].z, v[j].w); ((u32x2*)orow)[lane + 64 * j] = o; }
    float mine = 0.f;
#pragma unroll 1
    for (int e = 0; e < 36; ++e) {
        const float* w = e < 32 ? wre + e : wrg + (e - 32); const int ld = e < 32 ? 32 : 4; float p = 0.f;
#pragma unroll
        for (int j = 0; j < 4; ++j) { const int k = 256 * j + 4 * lane; p += v[j].x * w[(k + 0) * ld] + v[j].y * w[(k + 1) * ld] + v[j].z * w[(k + 2) * ld] + v[j].w * w[(k + 3) * ld]; }
        const float tot = wave_sum(p) + (e < 32 ? bre[e] : brg[e - 32]);
        if (lane == e) mine = tot;
    }
    float gl[4];
#pragma unroll
    for (int e = 0; e < 4; ++e) gl[e] = __int_as_float(__builtin_amdgcn_readlane(__float_as_int(mine), 32 + e));
    int gi = 0; float gm = gl[0];
#pragma unroll
    for (int e = 1; e < 4; ++e) if (gl[e] > gm) { gm = gl[e]; gi = e; }
    float sel[8];
#pragma unroll
    for (int e = 0; e < 8; ++e) sel[e] = __int_as_float(__builtin_amdgcn_readlane(__float_as_int(mine), gi * 8 + e));
    if (lane == 0) {
        float gs = 0.f;
#pragma unroll
        for (int e = 0; e < 4; ++e) gs += __expf(gl[e] - gm);
        const float gw = 1.0f / gs;
        int i1 = 0; float m1 = sel[0];
#pragma unroll
        for (int e = 1; e < 8; ++e) if (sel[e] > m1) { m1 = sel[e]; i1 = e; }
        int i2 = -1; float m2 = -INFINITY;
#pragma unroll
        for (int e = 0; e < 8; ++e) if (e != i1 && sel[e] > m2) { m2 = sel[e]; i2 = e; }
        const float r = __expf(m2 - m1), w1 = gw / (1.0f + r), w2 = gw * r / (1.0f + r);
        const int e1 = gi * 8 + i1, e2 = gi * 8 + i2;
        unsigned* cnt = (unsigned*)(ws + WS_CTL) + CW_CNT + layer * 32 * 64;
        const int s1 = (int)atomicAdd(cnt + e1 * 64, 1u), s2 = (int)atomicAdd(cnt + e2 * 64, 1u);
        int* LIST = (int*)(ws + WS_LIST); LIST[(size_t)e1 * M + s1] = row; LIST[(size_t)e2 * M + s2] = row;
        ((int4*)(ws + WS_TOKSLOT))[row] = make_int4(e1, s1, e2, s2); ((float2*)(ws + WS_TOKW))[row] = make_float2(w1, w2);
    }
}

__global__ void __launch_bounds__(NWAVES * 64, 2) mk_fwd(Args args) {
    extern __shared__ __attribute__((aligned(16))) unsigned char lds_raw[];
    LAS unsigned char* lds = (LAS unsigned char*)lds_raw;
    const int wave = __builtin_amdgcn_readfirstlane(threadIdx.x >> 6);
    const int G = gridDim.x; const int bx = blockIdx.x; const int vcu = (G % 8 == 0) ? (bx % 8) * (G / 8) + bx / 8 : bx;
    unsigned char* ws = args.ws; const float* const* in = args.in; float* XR = args.out;
    for (int u = threadIdx.x; u < (LDS_BYTES - LDSCTL_OFF) / 4; u += NWAVES * 64) ((LAS unsigned*)(lds + LDSCTL_OFF))[u] = 0u;
    __syncthreads();
    const int lo = args.ph_lo, hi = args.ph_hi;
    unsigned* ctl = (unsigned*)(ws + WS_CTL);
    XcdBarrier bar; bar.bar = ctl + CW_BAR + args.li * XCD_BAR_WORDS; bar.x = 0; bar.st = nullptr;
    if (hi - lo > 1) bar = xcd_barrier_post(ctl + CW_BAR + args.li * XCD_BAR_WORDS, (volatile LAS unsigned*)(lds + MISC_OFF) + 8);
    bar.wave = wave;
#define IN(k) (lo <= (k) && (k) < hi)
#define SEAM(k) do { if (IN(k) && IN((k) + 1)) xcd_barrier(bar); } while (0)
    bf16 *XN = (bf16*)(ws + WS_XN), *SBQ = (bf16*)(ws + WS_SBQ), *SBKT = (bf16*)(ws + WS_SBKT), *SBVT = (bf16*)(ws + WS_SBVT), *KT = (bf16*)(ws + WS_KT), *Qb = (bf16*)(ws + WS_Q), *VT = (bf16*)(ws + WS_VT);
    bf16 *U = (bf16*)(ws + WS_U), *BG = (bf16*)(ws + WS_BG), *CQ = (bf16*)(ws + WS_CQ), *CKV = (bf16*)(ws + WS_CKV), *ACONV = (bf16*)(ws + WS_ACONV), *OMLA = (bf16*)(ws + WS_OMLA), *OSB = (bf16*)(ws + WS_OSB);
    bf16 *GSCR = (bf16*)(ws + WS_GSCR), *MERGED = (bf16*)(ws + WS_MERGED), *H2 = (bf16*)(ws + WS_H2), *ACT = (bf16*)(ws + WS_ACT), *Y = (bf16*)(ws + WS_Y);
    float* SSQ = (float*)(ws + WS_SSQ); float2* CS = (float2*)(ws + WS_CS);
    const int gw = vcu * NWAVES + wave, NGW = G * NWAVES;
    LAS float* scr = (LAS float*)(lds + wave * 16384);

    if (IN(0)) { const int lane = lane_id();
        for (int it = gw; it < WI_TOTAL; it += NGW) { WItem s; wdecode(it, in, 0, ws, s); tr_item(s, scr, lane); }
        for (int row = gw; row < M; row += NGW) { rms_row(in[0] + (size_t)row * D, in[2], XN + (size_t)row * D, nullptr, lane); cs_row((const int*)in[1], CS, row, lane); }
    }
    SEAM(0);
    for (int l = 0; l < DEPTH; ++l) {
        const int pb = 1 + 9 * l;
        if (IN(pb + 0)) {
            pg8::DenseOrder S; S.init(XN, ws + WS_WA, M, NA, 1024, G, bx);
            pg8::EpiAdapt<EpiWinA> E{EpiWinA{U, BG, SBQ, SBKT, SBVT, CQ, CKV, KT, SSQ, CS}};
            pg8::gemm_phase<pg8::EpiAdapt<EpiWinA>, pg8::DenseOrder, false>(lds, wave, 1024, S, E);
        }
        SEAM(pb + 0);
        if (IN(pb + 1)) {
            { pg8::DenseOrder S; S.init(CQ, ws + WS_WUQ, M, 768, 256, G, bx); pg8::EpiAdapt<EpiQ> E{EpiQ{Qb, SSQ, CS}};
              pg8::gemm_phase<pg8::EpiAdapt<EpiQ>, pg8::DenseOrder, false>(lds, wave, 256, S, E); }
            { pg8::DenseOrder S; S.init(CKV, ws + WS_WUKV, M, 1024, 128, G, bx); pg8::EpiAdapt<EpiKV> E{EpiKV{KT, VT, SSQ}};
              pg8::gemm_phase<pg8::EpiAdapt<EpiKV>, pg8::DenseOrder, false>(lds, wave, 128, S, E); }
            const float* cw = in[5] + (size_t)l * 3 * 512; const int tid = wave * 64 + lane_id();
            for (int id = vcu * (NWAVES * 64) + tid; id < M * 64; id += G * NWAVES * 64) conv_item(U, BG, cw, ACONV, id >> 6, id & 63);
        }
        SEAM(pb + 1);
        if (IN(pb + 2)) {
            ATTN_PHASE_BODY
        }
        SEAM(pb + 2);
        if (IN(pb + 3)) {
            for (int br = 0; br < 3; ++br) {
                { pg8::DenseOrder S; S.init(XN, ws + WS_WG + (size_t)br * 1024 * 1024 * 2, M, 1024, 1024, G, bx); pg8::EpiAdapt<EpiGate> E{EpiGate{GSCR, in[4] + (size_t)l * 3072 + br * 1024}};
                  pg8::gemm_phase<pg8::EpiAdapt<EpiGate>, pg8::DenseOrder, false>(lds, wave, 1024, S, E); }
                { const bf16* Abr = br == 0 ? ACONV : br == 1 ? OMLA : OSB; const size_t wo = br == 0 ? WS_WOC : br == 1 ? WS_WOM : WS_WOS;
                  pg8::DenseOrder S; S.init(Abr, ws + wo, M, 1024, 512, G, bx); pg8::EpiAdapt<EpiY> E{EpiY{GSCR, MERGED, br == 0, 0}};
                  pg8::gemm_phase<pg8::EpiAdapt<EpiY>, pg8::DenseOrder, false>(lds, wave, 512, S, E); }
            }
        }
        SEAM(pb + 3);
        if (IN(pb + 4)) {
            pg8::DenseOrder S; S.init(MERGED, ws + WS_WO, M, 1024, 1024, G, bx); pg8::EpiAdapt<EpiWo> E{EpiWo{l == 0 ? in[0] : XR, XR}};
            pg8::gemm_phase<pg8::EpiAdapt<EpiWo>, pg8::DenseOrder, false>(lds, wave, 1024, S, E);
        }
        SEAM(pb + 4);
        if (IN(pb + 5)) { const int lane = lane_id();
            for (int row = gw; row < M; row += NGW)
                t1_row(XR + (size_t)row * D, in[14] + l * 1024, in[15] + (size_t)l * 1024 * 4, in[16] + l * 4, in[17] + (size_t)l * 1024 * 32, in[18] + l * 32, ws, l, row, lane);
        }
        SEAM(pb + 5);
        const unsigned* cnt = ctl + CW_CNT + l * 32 * 64;
        if (IN(pb + 6)) {
            pg8::GroupedOrder<true> S{cnt, (const char*)H2, (const char*)(ws + WS_WGU), (const int*)(ws + WS_LIST), 1024, 2, 512, G, bx};
            pg8::EpiAdapt<EpiGU> E{EpiGU{ACT}};
            pg8::gemm_phase<pg8::EpiAdapt<EpiGU>, pg8::GroupedOrder<true>, true>(lds, wave, 1024, S, E);
        }
        SEAM(pb + 6);
        if (IN(pb + 7)) {
            pg8::GroupedOrder<false> S{cnt, (const char*)ACT, (const char*)(ws + WS_WD), nullptr, 256, 4, 1024, G, bx};
            pg8::EpiAdapt<EpiDown> E{EpiDown{Y}};
            pg8::gemm_phase<pg8::EpiAdapt<EpiDown>, pg8::GroupedOrder<false>, false>(lds, wave, 256, S, E);
        }
        SEAM(pb + 7);
        if (IN(pb + 8)) { const int lane = lane_id();
            const bool fin = (l + 1 == DEPTH); const float* gnext = fin ? in[22] : in[2] + (l + 1) * 1024;
            for (int row = gw; row < M; row += NGW)
                t2_row(XR + (size_t)row * D, Y, cnt, ((const int4*)(ws + WS_TOKSLOT))[row], ((const float2*)(ws + WS_TOKW))[row], gnext, XN + (size_t)row * D, fin, lane);
            if (!fin) { for (int it = gw; it < WI_TOTAL; it += NGW) { WItem s; wdecode(it, in, l + 1, ws, s); tr_item(s, scr, lane); } }
        }
        SEAM(pb + 8);
    }
#undef IN
#undef SEAM
}
template <class T> static T* wsp(void* ws, size_t off) { return (T*)((unsigned char*)ws + off); }
static void launch_mk(Args a, int lo, int hi, int li, int grid, hipStream_t s) { a.ph_lo = lo; a.ph_hi = hi; a.li = li; a.pad = 0; hipLaunchKernelGGL(mk_fwd, dim3(grid), dim3(NWAVES * 64), LDS_BYTES, s, a); }
extern "C" void kernel_launch(void* const* d_in, const int* in_sizes, int n_in, void* d_out, int out_size, void* d_ws, size_t ws_size, hipStream_t stream) {
    static int grid = 0;
    if (grid == 0) {
        if (n_in != 23 || out_size != M * D || ws_size < WS_END) { fprintf(stderr, "kernel_launch: unexpected shapes (n_in %d out %d ws %zu)\n", n_in, out_size, ws_size); grid = -1; return; }
        int dev = 0, cus = 0;
        if (hipGetDevice(&dev) != hipSuccess || hipDeviceGetAttribute(&cus, hipDeviceAttributeMultiprocessorCount, dev) != hipSuccess) { grid = -1; return; }
        if (hipFuncSetAttribute((const void*)mk_fwd, hipFuncAttributeMaxDynamicSharedMemorySize, LDS_BYTES) != hipSuccess) { fprintf(stderr, "kernel_launch: hipFuncSetAttribute failed\n"); grid = -1; return; }
        int per_cu = 0; (void)hipOccupancyMaxActiveBlocksPerMultiprocessor(&per_cu, (const void*)mk_fwd, NWAVES * 64, LDS_BYTES); (void)hipGetLastError();
        grid = cus;
    }
    if (grid < 0) return;
    unsigned char* ws = (unsigned char*)d_ws;
    (void)hipMemsetAsync(ws + WS_CTL, 0, 1 * MiB, stream);
    Args a{}; for (int i = 0; i < 23; ++i) a.in[i] = (const float*)d_in[i]; a.out = (float*)d_out; a.ws = ws;
#if MK_MODE == 0
    launch_mk(a, 0, 1, 0, grid, stream);
    for (int l = 0; l < DEPTH; ++l) { const int pb = 1 + 9 * l;
        launch_mk(a, pb, pb + 1, 0, grid, stream); launch_mk(a, pb + 1, pb + 2, 0, grid, stream);
        k_mla_naive<<<64 * 64, 64, 0, stream>>>(wsp<bf16>(ws, WS_Q), wsp<bf16>(ws, WS_KT), wsp<bf16>(ws, WS_VT), wsp<bf16>(ws, WS_OMLA));
        k_sb_naive<<<64 * 64, 64, 0, stream>>>(wsp<bf16>(ws, WS_SBQ), wsp<bf16>(ws, WS_SBKT), wsp<bf16>(ws, WS_SBVT), wsp<bf16>(ws, WS_OSB));
        for (int k = 3; k < 9; ++k) launch_mk(a, pb + k, pb + k + 1, 0, grid, stream);
    }
#else
    launch_mk(a, 0, NPHASE, 0, grid, stream);
#endif
}
```

```cpp
#define ATTN_PHASE_BODY { if (wave >= 4) __builtin_amdgcn_s_setprio(1);     \
    for (int u = gw; u < 2048; u += NGW) for (int i = 0; i < 2; ++i) { const int bh = u >> 5, a = u & 31; mla_wave_unit(Qb, KT, VT, OMLA, bh, i == 0 ? 63 - a : a); } \
      \
      \
    { LAS int* ctr_ = (LAS int*)(lds + LDSCTL_OFF + 4096) + 2 * l; \
      for (;;) { int t_ = 0; if (lane_id() == 0) t_ = __atomic_fetch_add(ctr_, 1, __ATOMIC_RELAXED); t_ = __builtin_amdgcn_readfirstlane(t_); \
        const int k_ = vcu + t_ * G; \
        if (k_ < WI_LATE) { WItem s; wdecode(wi_late(k_), in, l, ws, s); tr_item(s, scr, lane_id()); } \
        else if (k_ < WI_LATE + 48) wr_item(in[15] + (size_t)l * 1024 * 4, in[17] + (size_t)l * 1024 * 32, (bf16*)(ws + WS_WR), k_ - WI_LATE, lane_id()); \
        else break; } \
      for (;;) { int t_ = 0; if (lane_id() == 0) t_ = __atomic_fetch_add(ctr_ + 1, 1, __ATOMIC_RELAXED); t_ = __builtin_amdgcn_readfirstlane(t_); \
        if (t_ >= 16) break; \
        const int u = vcu * 16 + t_; sb_wave_unit(SBQ, SBKT, SBVT, OSB, u >> 6, u & 63); } } \
    __builtin_amdgcn_s_setprio(0); }
#include <hip/hip_runtime.h>
#include <stdint.h>
#include <stdio.h>

#define DI __device__ __forceinline__
typedef unsigned short bf16;
typedef unsigned u32x4 __attribute__((ext_vector_type(4)));
typedef unsigned u32x2 __attribute__((ext_vector_type(2)));
typedef float f32x4 __attribute__((ext_vector_type(4)));
typedef float f32x2 __attribute__((ext_vector_type(2)));
typedef __bf16 bf16x2_t __attribute__((ext_vector_type(2)));

constexpr int D = 1024, NBATCH = 8, SEQ = 4096, M = NBATCH * SEQ, DEPTH = 2;
constexpr int CONVW = 512, QRANK = 256, KVRANK = 128, NH = 8;
constexpr int OFF_CQ = 1536, OFF_CKV = 1792, OFF_KR = 1920, OFF_SB = 1952, OFF_GATE = 3488, IN_COLS = 6560;
constexpr int NEXP = 32, NGRP = 4, EPG = 8, DEXP = 256;
constexpr int NA = 3584;
constexpr int MOE_ROWS = 73728;
constexpr float EPS = 1e-6f;
constexpr int XRP = 2048;
constexpr float LOG2E = 1.4426950408889634f;
constexpr float QSCALE_MLA = 0.10206207261596575f * LOG2E;
constexpr float QSCALE_SB = 0.125f * LOG2E;

constexpr size_t MiB = 1u << 20;
constexpr size_t WS_CTL = 0;
constexpr size_t WS_TOKSLOT = 1 * MiB;
constexpr size_t WS_TOKW = 1 * MiB + 512 * 1024;
constexpr size_t WS_LIST = 2 * MiB;
constexpr size_t WS_CS = 6 * MiB;
constexpr size_t WS_SSQ = 10 * MiB;
constexpr size_t WS_SSQ2 = 12 * MiB;
constexpr size_t WS_GB = 14 * MiB;
constexpr size_t WS_WA = 16 * MiB;
constexpr size_t WS_WG = 23 * MiB;
constexpr size_t WS_WUQ = 29 * MiB;
constexpr size_t WS_WUKV = 29 * MiB + 512 * 1024;
constexpr size_t WS_WOC = 30 * MiB, WS_WOM = 31 * MiB, WS_WOS = 32 * MiB;
constexpr size_t WS_WO = 33 * MiB;
constexpr size_t WS_WR = 35 * MiB;
constexpr size_t WS_WGU = 36 * MiB;
constexpr size_t WS_WD = 68 * MiB;
constexpr size_t WS_XN8 = 84 * MiB;
constexpr size_t WS_XN = 116 * MiB;
constexpr size_t WS_ACONV = 116 * MiB;
constexpr size_t WS_SBQ = 180 * MiB, WS_SBKT = 212 * MiB, WS_SBVT = 244 * MiB;
constexpr size_t WS_KT = 276 * MiB;
constexpr size_t WS_Q = 324 * MiB;
constexpr size_t WS_VT = 372 * MiB;
constexpr size_t WS_U = 404 * MiB, WS_BG = 436 * MiB;
constexpr size_t WS_CQ = 468 * MiB, WS_CKV = 484 * MiB;
constexpr size_t WS_OMLA = 436 * MiB, WS_OSB = 468 * MiB;
constexpr size_t WS_GATES = 180 * MiB;
constexpr size_t WS_MERGED = 372 * MiB;
constexpr size_t WS_H2 = 180 * MiB;
constexpr size_t WS_ACT = 244 * MiB;
constexpr size_t WS_Y = 280 * MiB;
constexpr size_t WS_END = 500 * MiB;
constexpr int CW_CNT = 32768;

DI float bf2f(unsigned h) { return __uint_as_float(h << 16); }
DI unsigned pk2(float lo, float hi) { f32x2 v = {lo, hi}; bf16x2_t b = __builtin_convertvector(v, bf16x2_t); return __builtin_bit_cast(unsigned, b); }
DI u32x4 pk8(const float (&v)[8]) { u32x4 w; w.x = pk2(v[0], v[1]); w.y = pk2(v[2], v[3]); w.z = pk2(v[4], v[5]); w.w = pk2(v[6], v[7]); return w; }
DI void unpk8(u32x4 w, float (&v)[8]) { v[0] = bf2f(w.x & 0xffffu); v[1] = bf2f(w.x >> 16); v[2] = bf2f(w.y & 0xffffu); v[3] = bf2f(w.y >> 16);
    v[4] = bf2f(w.z & 0xffffu); v[5] = bf2f(w.z >> 16); v[6] = bf2f(w.w & 0xffffu); v[7] = bf2f(w.w >> 16); }
DI int lane_id() { int l; asm volatile("v_mbcnt_lo_u32_b32 %0, -1, 0\n\tv_mbcnt_hi_u32_b32 %0, -1, %0" : "=v"(l)); return l; }
DI float shfl_xor_l(float v, int o, int lane) { return __int_as_float(__builtin_amdgcn_ds_bpermute((lane ^ o) << 2, __float_as_int(v))); }
DI float wave_sum(float v) { const int l = lane_id();
#pragma unroll
    for (int o = 1; o < 64; o <<= 1) v += shfl_xor_l(v, o, l);
    return v;
}
DI size_t vt8_idx(int bh, int key, int d) { const int k = key & 63, k5 = k & 31, hi = (k5 >> 2) & 1, sl = (k >> 5) * 16 + (k5 & 3) + 4 * (k5 >> 3);
    return (((((size_t)bh * (SEQ / 64) + (key >> 6)) * 2 + (d >> 5)) * 32 + (d & 31)) * 2 + hi) * 32 + sl; }
DI size_t kt8_idx(int bh, int key, int d) { return ((((size_t)bh * (SEQ / 64) + (key >> 6)) * 3 + (d >> 5)) * 64 + (key & 63)) * 32 + (d & 31); }
template <int NCH> DI size_t kt_idx(int bh, int key, int chunk) { return ((((size_t)bh * (SEQ / 64) + (key >> 6)) * NCH + chunk) * 64 + (key & 63)) * 8; }
DI size_t vt_idx(int bh, int key, int d) {
    const int k = key & 63;
    return ((size_t)bh * (SEQ / 64) + (key >> 6)) * 4096 + (size_t)((((((k >> 5) * 2 + ((k >> 4) & 1)) * 2 + (d >> 5)) * 32 + (d & 31)) * 2 + ((k >> 2) & 1)) * 8 + ((k >> 3) & 1) * 4 + (k & 3));
}

DI bool moe_locate(const unsigned* cnt, int tile, int& e, int& i, int& rowbase) {
    int acc = 0;
    for (int k = 0; k < NEXP; ++k) { const int n = (int)((cnt[k * 64] + 255u) >> 8); if (tile < acc + n) { e = k; i = tile - acc; rowbase = acc * 256; return true; } acc += n; }
    return false;
}
DI int moe_base(const unsigned* cnt, int e) { int acc = 0; for (int k = 0; k < e; ++k) acc += (int)((cnt[k * 64] + 255u) >> 8); return acc * 256; }

struct WItem { const float* W; int ldw, K, src, perm; const float* gain; bf16* dst; int kb; int f8; };
constexpr unsigned PH1_F8MASK = 0x3fc0u;
constexpr int WI_A = (NA / 32) * 16, WI_G = 96 * 16, WI_UQ = 24 * 4, WI_UKV = 32 * 2, WI_OUT = 32 * 8, WI_O = 32 * 16, WI_GU = NEXP * 16 * 16, WI_D = NEXP * 32 * 4;
constexpr int WI_TOTAL = WI_A + WI_G + WI_UQ + WI_UKV + 3 * WI_OUT + WI_O + WI_GU + WI_D;
constexpr int WI_EARLY = WI_A + WI_UQ + WI_UKV, WI_LATE = WI_TOTAL - WI_EARLY;
DI int wi_early(int k) { return k < WI_A ? k : k + WI_G; }
DI int wi_late(int k) { return k < WI_G ? WI_A + k : k + WI_A + WI_UQ + WI_UKV; }
DI void wdecode(int it, const float* const* in, int l, unsigned char* ws, WItem& s) {
    const float* w_in = in[3] + (size_t)l * 1024 * IN_COLS;
    s.perm = 0; s.gain = nullptr; s.f8 = 0;
    if (it < WI_A) { const int nb = it >> 4; s.kb = it & 15; s.W = w_in; s.ldw = IN_COLS; s.K = 1024; s.dst = (bf16*)(ws + WS_WA) + (size_t)nb * 32 * 1024;
        if ((PH1_F8MASK >> (nb >> 3)) & 1u) { s.f8 = 1; s.dst = (bf16*)(ws + WS_WA + (size_t)(nb >> 3) * 524288 + (size_t)(nb & 7) * 32 * 1024); }
        if (nb < 32) { const int T = nb >> 3, w = nb & 7; s.src = (w < 4) ? 128 * T + 32 * w : 1024 + 128 * T + 32 * (w - 4); }
        else if (nb < 48) s.src = 512 + 32 * (nb - 32);
        else if (nb < 96) s.src = OFF_SB + 32 * (nb - 48);
        else if (nb < 104) s.src = OFF_CQ + 32 * (nb - 96);
        else if (nb < 108) s.src = OFF_CKV + 32 * (nb - 104);
        else if (nb == 108) { s.src = OFF_KR; s.perm = 1; }
        else s.src = -1;
        return; }
    it -= WI_A;
    if (it < WI_G) { const int nb = it >> 4; s.kb = it & 15; s.W = w_in; s.ldw = IN_COLS; s.K = 1024; s.src = OFF_GATE + 32 * nb; s.f8 = 1; s.dst = (bf16*)(ws + WS_WG + (size_t)nb * 32 * 1024); return; }
    it -= WI_G;
    if (it < WI_UQ) { const int nb = it >> 2; s.kb = it & 3; s.W = in[9] + (size_t)l * 256 * 768; s.ldw = 768; s.K = 256; s.gain = in[7] + l * 256; const int h = nb / 3, part = nb % 3;
        s.src = h * 96 + part * 32; s.perm = (part == 2); s.dst = (bf16*)(ws + WS_WUQ) + (size_t)nb * 32 * 256; return; }
    it -= WI_UQ;
    if (it < WI_UKV) { const int nb = it >> 1; s.kb = it & 1; s.W = in[10] + (size_t)l * 128 * 1024; s.ldw = 1024; s.K = 128; s.gain = in[8] + l * 128;
        s.src = (nb < 16) ? (nb >> 1) * 128 + (nb & 1) * 32 : ((nb - 16) >> 1) * 128 + 64 + (nb & 1) * 32; s.dst = (bf16*)(ws + WS_WUKV) + (size_t)nb * 32 * 128; return; }
    it -= WI_UKV;
    for (int j = 0; j < 3; ++j) { if (it < WI_OUT) { const int nb = it >> 3; s.kb = it & 7; s.W = (j == 0 ? in[6] : j == 1 ? in[11] : in[12]) + (size_t)l * 512 * 1024; s.ldw = 1024; s.K = 512; s.src = 32 * nb; s.f8 = 2;
            s.dst = (bf16*)(ws + (j == 0 ? WS_WOC : j == 1 ? WS_WOM : WS_WOS)) + (size_t)nb * 32 * 512;
            if (j) { s.f8 = 1; s.dst = (bf16*)(ws + (j == 1 ? WS_WOM : WS_WOS) + (size_t)nb * 32 * 512); }
            return; } it -= WI_OUT; }
    if (it < WI_O) { const int nb = it >> 4; s.kb = it & 15; s.W = in[13] + (size_t)l * 1024 * 1024; s.ldw = 1024; s.K = 1024; s.src = 32 * nb; s.dst = (bf16*)(ws + WS_WO) + (size_t)nb * 32 * 1024; return; }
    it -= WI_O;
    if (it < WI_GU) { const int e = it >> 8, r = it & 255, nb = r >> 4; s.kb = r & 15; const int pn = nb >> 3, w = nb & 7;
        s.W = (w < 4 ? in[19] : in[20]) + ((size_t)l * NEXP + e) * 1024 * 256; s.ldw = 256; s.K = 1024; s.src = 128 * pn + 32 * (w & 3); s.f8 = 1; s.dst = (bf16*)(ws + WS_WGU + ((size_t)e * 512 + nb * 32) * 1024); return; }
    it -= WI_GU;
    { const int e = it >> 7, r = it & 127, nb = r >> 2; s.kb = r & 3; s.W = in[21] + ((size_t)l * NEXP + e) * 256 * 1024; s.ldw = 1024; s.K = 256; s.src = 32 * nb; s.dst = (bf16*)(ws + WS_WD) + ((size_t)e * 1024 + nb * 32) * 256; }
}
DI void wr_item(const float* wrg, const float* wre, bf16* WR, int r, int lane) {
    const int tile = r >> 4, g4 = (r & 15) >> 2, j = r & 3; const float* W = tile == 0 ? wrg + j : wre + 8 * g4 + (tile == 2 ? 4 : 0) + j; const int ld = tile == 0 ? 4 : 32;
    for (int k = lane; k < 1024; k += 64) WR[(size_t)r * 1024 + k] = (bf16)(pk2(W[(size_t)k * ld], 0.f) & 0xffffu);
}
template <class FP> DI void tr_item(const WItem& s, FP scr, int lane) {
    const int k0 = 64 * s.kb, c4 = (lane & 7) * 4;
    f32x4 w[8];
#pragma unroll
    for (int i = 0; i < 8; ++i) { const int kk = 8 * i + (lane >> 3);
        w[i] = (s.src >= 0) ? *(const f32x4*)(s.W + (size_t)(k0 + kk) * s.ldw + s.src + c4) : (f32x4){0.f, 0.f, 0.f, 0.f}; }
#pragma unroll
    for (int i = 0; i < 8; ++i) { const int kk = 8 * i + (lane >> 3); f32x4 x = w[i]; if (s.gain) x = x * s.gain[k0 + kk];
#pragma unroll
        for (int e = 0; e < 4; ++e) { const int sc = c4 + e, c = s.perm ? ((sc & 15) * 2 + (sc >> 4)) : sc; scr[kk * 33 + c] = x[e]; } }
    asm volatile("s_waitcnt lgkmcnt(0)" ::: "memory");
    if (s.f8 == 1) {
        const int n = lane >> 1, kh = lane & 1; unsigned w[8];
#pragma unroll
        for (int q = 0; q < 8; ++q) { const auto* p = scr + (kh * 32 + 4 * q) * 33 + n; unsigned x = 0u;
            x = __builtin_amdgcn_cvt_pk_fp8_f32(p[0] * 64.0f, p[33] * 64.0f, x, false); x = __builtin_amdgcn_cvt_pk_fp8_f32(p[66] * 64.0f, p[99] * 64.0f, x, true); w[q] = x; }
        unsigned char* d = (unsigned char*)s.dst + (size_t)n * s.K + k0 + kh * 32;
        *(u32x4*)d = (u32x4){w[0], w[1], w[2], w[3]}; *(u32x4*)(d + 16) = (u32x4){w[4], w[5], w[6], w[7]};
        asm volatile("s_waitcnt lgkmcnt(0)" ::: "memory"); return;
    }
    const int c8 = lane & 7; const float sc = s.f8 == 2 ? 1.0f / 255.0f : 1.0f;
#pragma unroll
    for (int j = 0; j < 4; ++j) { const int n = (lane >> 3) + 8 * j; const auto* p = scr + (8 * c8) * 33 + n;
        u32x4 o; o.x = pk2(p[0 * 33] * sc, p[1 * 33] * sc); o.y = pk2(p[2 * 33] * sc, p[3 * 33] * sc); o.z = pk2(p[4 * 33] * sc, p[5 * 33] * sc); o.w = pk2(p[6 * 33] * sc, p[7 * 33] * sc);
        *(u32x4*)(s.dst + (size_t)n * s.K + k0 + 8 * c8) = o; }
    asm volatile("s_waitcnt lgkmcnt(0)" ::: "memory");
}
DI void rms_row(const float* xrow, const float* g, bf16* orow, float* fout, int lane) {
    const f32x4* xr = (const f32x4*)xrow + lane; const f32x4* gr = (const f32x4*)g + lane;
    f32x4 v[4]; float s = 0.f;
#pragma unroll
    for (int j = 0; j < 4; ++j) { v[j] = xr[64 * j]; s += (v[j].x * v[j].x + v[j].y * v[j].y) + (v[j].z * v[j].z + v[j].w * v[j].w); }
    const float rstd = 1.0f / sqrtf(wave_sum(s) * (1.f / D) + EPS);
#pragma unroll
    for (int j = 0; j < 4; ++j) { const f32x4 gg = gr[64 * j]; const f32x4 y = v[j] * rstd * gg;
        if (orow) { u32x2 o; o.x = pk2(y.x, y.y); o.y = pk2(y.z, y.w); ((u32x2*)orow)[lane + 64 * j] = o; }
        if (fout) ((f32x4*)fout)[lane + 64 * j] = y; }
}
DI unsigned pk4_fp8(f32x4 y) { unsigned w = 0u; w = __builtin_amdgcn_cvt_pk_fp8_f32(y.x, y.y, w, false); w = __builtin_amdgcn_cvt_pk_fp8_f32(y.z, y.w, w, true); return w; }
template <int NR> DI void rms_rowsN(const float* x, const float* g, bf16* out, unsigned char* out8, int row0, int lane) {
    f32x4 v[NR][4];
#pragma unroll
    for (int i = 0; i < NR; ++i)
#pragma unroll
        for (int j = 0; j < 4; ++j) v[i][j] = ((const f32x4*)(x + (size_t)(row0 + i) * D))[lane + 64 * j];
    f32x4 gg[4];
#pragma unroll
    for (int j = 0; j < 4; ++j) gg[j] = ((const f32x4*)g)[lane + 64 * j];
#pragma unroll
    for (int i = 0; i < NR; ++i) { float s = 0.f;
#pragma unroll
        for (int j = 0; j < 4; ++j) s += (v[i][j].x * v[i][j].x + v[i][j].y * v[i][j].y) + (v[i][j].z * v[i][j].z + v[i][j].w * v[i][j].w);
        const float rstd = 1.0f / sqrtf(wave_sum(s) * (1.f / D) + EPS);
#pragma unroll
        for (int j = 0; j < 4; ++j) { const f32x4 y = v[i][j] * rstd * gg[j]; u32x2 o; o.x = pk2(y.x, y.y); o.y = pk2(y.z, y.w); ((u32x2*)(out + (size_t)(row0 + i) * D))[lane + 64 * j] = o;
            ((unsigned*)(out8 + (size_t)(row0 + i) * D))[lane + 64 * j] = pk4_fp8(y); } }
}
DI void cs_rows4(const int* positions, float2* CS, int row0, int lane) {
    const int row = row0 + (lane >> 4), i = lane & 15; const float freq = powf(10000.0f, -(float)i / 16.0f); const float ang = (float)positions[row] * freq; const double a = (double)ang;
    CS[(size_t)row * 16 + i] = make_float2((float)cos(a), (float)sin(a));
}

struct EpiWinA {
    static constexpr int TAIL = 8;
    bf16 *U, *BG, *SBQ, *SBKT, *SBVT, *CQ, *CKV, *KT; float* SSQ; const float2* CS;
    DI bool is_pair(int pn) const { return pn < 4; }
    DI float rowctx(int) const { return 0.f; }
    DI void pair(int row, int col0, const float (&a)[8], const float (&b)[8], float) const {
        const int T = col0 >> 8, c = col0 & 255; float u[8];
        const float sc = ((PH1_F8MASK >> T) & 1u) ? 1.0f / 4096.0f : 1.0f;
#pragma unroll
        for (int j = 0; j < 8; ++j) u[j] = a[j] * b[j] * sc;
        *(u32x4*)(U + (size_t)row * 512 + 128 * T + c) = pk8(u);
    }
    struct Pre {}; DI Pre pre(int, int, int) const { return Pre{}; }
    static constexpr bool ROWSTAT = true;
    DI bool wants_stat(int pn) const { return pn >= 12; }
    DI void rowstat(int row, int pn, int wc, float tot) const { SSQ[(size_t)row * 8 + (pn == 12 ? 0 : 4) + wc] = tot; }
    DI float operator()(int row, int col0, const float (&v_)[8], float, int, const Pre&) const {
        const int b = row / SEQ, t = row % SEQ; float ret = 0.f; float v[8]; const float sc = ((PH1_F8MASK >> (col0 >> 8)) & 1u) ? 1.0f / 64.0f : 1.0f;
#pragma unroll
        for (int j = 0; j < 8; ++j) v[j] = v_[j] * sc;
        if (col0 < 1536) { *(u32x4*)(BG + (size_t)row * 512 + (col0 - 1024)) = pk8(v); }
        else if (col0 < 2048) { float q[8];
#pragma unroll
            for (int j = 0; j < 8; ++j) q[j] = v[j] * QSCALE_SB;
            *(u32x4*)(SBQ + (size_t)row * 512 + (col0 - 1536)) = pk8(q); }
        else if (col0 < 2560) { const int c = col0 - 2048, h = c >> 6, d = c & 63; *(u32x4*)(SBKT + kt_idx<8>(b * 8 + h, t, d >> 3)) = pk8(v); }
        else if (col0 < 3072) { const int c = col0 - 2560, h = c >> 6, d = c & 63;
#pragma unroll
            for (int j = 0; j < 8; ++j) SBVT[vt_idx(b * 8 + h, t, d + j)] = (bf16)(pk2(v[j], 0.f) & 0xffffu); }
        else if (col0 < 3328) { const int c = col0 - 3072; *(u32x4*)(CQ + (size_t)row * 256 + c) = pk8(v); float s = 0.f;
#pragma unroll
            for (int j = 0; j < 8; ++j) s += v[j] * v[j];
            ret = s; }
        else { const int c = col0 - 3328;
            if (c < 128) { *(u32x4*)(CKV + (size_t)row * 128 + c) = pk8(v); float s = 0.f;
#pragma unroll
                for (int j = 0; j < 8; ++j) s += v[j] * v[j];
                ret = s; }
            else if (c < 160) { const int i0 = (c - 128) >> 1; float r[8];
#pragma unroll
                for (int j = 0; j < 4; ++j) { const float2 cs = CS[(size_t)row * 16 + i0 + j]; const float x1 = v[2 * j], x2 = v[2 * j + 1]; r[2 * j] = x1 * cs.x - x2 * cs.y; r[2 * j + 1] = x2 * cs.x + x1 * cs.y; }
                u32x2 w; w.x = pk4_fp8((f32x4){r[0], r[1], r[2], r[3]}); w.y = pk4_fp8((f32x4){r[4], r[5], r[6], r[7]});
#pragma unroll
                for (int h = 0; h < NH; ++h) *(u32x2*)((unsigned char*)KT + kt8_idx(b * 8 + h, t, 64 + (c - 128))) = w; }
        }
        return ret;
    }
};
struct EpiQ {
    static constexpr int TAIL = 16;
    bf16* Q; const float* SSQ; const float2* CS;
    DI bool is_pair(int) const { return false; }
    DI void pair(int, int, const float (&)[8], const float (&)[8], float) const {}
    static constexpr bool ROWSTAT = false;
    DI bool wants_stat(int) const { return false; }
    DI void rowstat(int, int, int, float) const {}
    DI float rowctx(int row) const { const f32x4 x = *(const f32x4*)(SSQ + (size_t)row * 8); return 1.0f / sqrtf(((x.x + x.y) + (x.z + x.w)) * (1.f / 256.f) + EPS); }
    struct Pre { float2 cs[4]; };
    DI Pre pre(int row, int col0, int) const { Pre p; const int dd = col0 % 96; if (dd >= 64) { const int i0 = (dd - 64) >> 1;
#pragma unroll
            for (int j = 0; j < 4; ++j) p.cs[j] = CS[(size_t)row * 16 + i0 + j]; } else {
#pragma unroll
            for (int j = 0; j < 4; ++j) p.cs[j] = make_float2(1.f, 0.f); }
        return p; }
    DI float operator()(int row, int col0, const float (&v)[8], float rstd, int, const Pre& P) const {
        const int dd = col0 % 96; float r[8];
#pragma unroll
        for (int j = 0; j < 8; ++j) r[j] = v[j] * rstd;
        if (dd >= 64) {
#pragma unroll
            for (int j = 0; j < 4; ++j) { const float2 cs = P.cs[j]; const float x1 = r[2 * j], x2 = r[2 * j + 1]; r[2 * j] = x1 * cs.x - x2 * cs.y; r[2 * j + 1] = x2 * cs.x + x1 * cs.y; } }
#pragma unroll
        for (int j = 0; j < 8; ++j) r[j] *= QSCALE_MLA;
        { u32x2 w; w.x = pk4_fp8((f32x4){r[0], r[1], r[2], r[3]}); w.y = pk4_fp8((f32x4){r[4], r[5], r[6], r[7]}); *(u32x2*)((unsigned char*)Q + (size_t)row * 768 + col0) = w; }
        return 0.f;
    }
};
struct EpiKV {
    static constexpr int TAIL = 16;
    bf16 *KT, *VT; const float* SSQ;
    DI bool is_pair(int) const { return false; }
    DI void pair(int, int, const float (&)[8], const float (&)[8], float) const {}
    static constexpr bool ROWSTAT = false;
    DI bool wants_stat(int) const { return false; }
    DI void rowstat(int, int, int, float) const {}
    DI float rowctx(int row) const { const f32x4 x = *(const f32x4*)(SSQ + (size_t)row * 8 + 4); return 1.0f / sqrtf(((x.x + x.y) + (x.z + x.w)) * (1.f / 128.f) + EPS); }
    struct Pre {}; DI Pre pre(int, int, int) const { return Pre{}; }
    DI float operator()(int row, int col0, const float (&v)[8], float rstd, int, const Pre&) const {
        const int b = row / SEQ, t = row % SEQ; float r[8];
#pragma unroll
        for (int j = 0; j < 8; ++j) r[j] = v[j] * rstd;
        if (col0 < 512) { const int h = col0 >> 6, d = col0 & 63; u32x2 w; w.x = pk4_fp8((f32x4){r[0], r[1], r[2], r[3]}); w.y = pk4_fp8((f32x4){r[4], r[5], r[6], r[7]});
            *(u32x2*)((unsigned char*)KT + kt8_idx(b * 8 + h, t, d)) = w; }
        else { const int c = col0 - 512, h = c >> 6, d = c & 63; const unsigned w0 = pk4_fp8((f32x4){r[0], r[1], r[2], r[3]}), w1 = pk4_fp8((f32x4){r[4], r[5], r[6], r[7]});
#pragma unroll
            for (int j = 0; j < 8; ++j) ((unsigned char*)VT)[vt8_idx(b * 8 + h, t, d + j)] = (unsigned char)(((j < 4 ? w0 : w1) >> (8 * (j & 3))) & 0xffu); }
        return 0.f;
    }
};
struct EpiGate8 {
    static constexpr int TAIL = 16;
    unsigned char* GATES; const float* bgate;
    DI bool is_pair(int) const { return false; }
    DI void pair(int, int, const float (&)[8], const float (&)[8], float) const {}
    DI float rowctx(int) const { return 0.f; }
    static constexpr bool ROWSTAT = false;
    DI bool wants_stat(int) const { return false; }
    DI void rowstat(int, int, int, float) const {}
    struct Pre {}; DI Pre pre(int, int, int) const { return Pre{}; }
    DI float operator()(int row, int col0, const float (&v)[8], float, int br, const Pre&) const {
        float r[8]; const float* bg = bgate + br * 1024 + col0;
#pragma unroll
        for (int j = 0; j < 8; ++j) r[j] = __builtin_amdgcn_rcpf(__builtin_amdgcn_exp2f(__builtin_fmaf(v[j], -1.4426950408889634f / 64.0f, bg[j])) + 1.0f / 255.0f);
        u32x2 w; w.x = __builtin_amdgcn_cvt_pk_u8_f32(r[0], 0, 0u); w.x = __builtin_amdgcn_cvt_pk_u8_f32(r[1], 1, w.x); w.x = __builtin_amdgcn_cvt_pk_u8_f32(r[2], 2, w.x); w.x = __builtin_amdgcn_cvt_pk_u8_f32(r[3], 3, w.x);
        w.y = __builtin_amdgcn_cvt_pk_u8_f32(r[4], 0, 0u); w.y = __builtin_amdgcn_cvt_pk_u8_f32(r[5], 1, w.y); w.y = __builtin_amdgcn_cvt_pk_u8_f32(r[6], 2, w.y); w.y = __builtin_amdgcn_cvt_pk_u8_f32(r[7], 3, w.y);
        *(u32x2*)(GATES + (size_t)row * 3072 + br * 1024 + col0) = w; return 0.f; }
};
template <bool F8> struct EpiY3 {
    static constexpr int TAIL = 16;
    const unsigned char* GATES; bf16* MERGED;
    DI bool is_pair(int) const { return false; }
    DI void pair(int, int, const float (&)[8], const float (&)[8], float) const {}
    DI float rowctx(int) const { return 0.f; }
    static constexpr bool ROWSTAT = false;
    DI bool wants_stat(int) const { return false; }
    DI void rowstat(int, int, int, float) const {}
    struct Pre { u32x2 g; u32x4 m; };
    DI Pre pre(int row, int col0, int br) const { Pre p; p.g = *(const u32x2*)(GATES + (size_t)row * 3072 + br * 1024 + col0); p.m = (u32x4){0u, 0u, 0u, 0u};
        if (br) p.m = *(const u32x4*)(MERGED + (size_t)row * 1024 + col0); return p; }
    DI float operator()(int row, int col0, const float (&v)[8], float, int, const Pre& P) const {
        float g[8], m[8]; unpk8(P.m, m);
#pragma unroll
        for (int j = 0; j < 4; ++j) { g[j] = (float)((P.g.x >> (8 * j)) & 0xffu); g[4 + j] = (float)((P.g.y >> (8 * j)) & 0xffu); }
#pragma unroll
        for (int j = 0; j < 8; ++j) m[j] += g[j] * (F8 ? v[j] * (1.0f / (1024.0f * 255.0f)) : v[j]);
        *(u32x4*)(MERGED + (size_t)row * 1024 + col0) = pk8(m); return 0.f; }
};
struct EpiWo {
    static constexpr int TAIL = 16;
    const float* xin; bf16* XRB; float* SSQ2;
    DI bool is_pair(int) const { return false; }
    DI void pair(int, int, const float (&)[8], const float (&)[8], float) const {}
    DI float rowctx(int) const { return 0.f; }
    static constexpr bool ROWSTAT = true;
    DI bool wants_stat(int) const { return true; }
    DI void rowstat(int row, int pn, int wc, float tot) const { SSQ2[(size_t)row * 16 + pn * 4 + wc] = tot; }
    struct Pre { f32x4 a, b; };
    DI Pre pre(int row, int col0, int) const { Pre p;
        if (xin) { p.a = *(const f32x4*)(xin + (size_t)row * 1024 + col0); p.b = *(const f32x4*)(xin + (size_t)row * 1024 + col0 + 4); }
        else { float t[8]; unpk8(*(const u32x4*)(XRB + (size_t)row * XRP + col0), t); p.a = (f32x4){t[0], t[1], t[2], t[3]}; p.b = (f32x4){t[4], t[5], t[6], t[7]}; }
        return p; }
    DI float operator()(int row, int col0, const float (&v)[8], float, int, const Pre& P) const {
        const float r[8] = {P.a.x + v[0], P.a.y + v[1], P.a.z + v[2], P.a.w + v[3], P.b.x + v[4], P.b.y + v[5], P.b.z + v[6], P.b.w + v[7]};
        *(u32x4*)(XRB + (size_t)row * XRP + col0) = pk8(r); float q = 0.f;
#pragma unroll
        for (int j = 0; j < 8; ++j) q += r[j] * r[j];
        return q; }
};
struct EpiGU {
    static constexpr int TAIL = 8;
    bf16* ACT;
    DI bool is_pair(int) const { return true; }
    DI float rowctx(int) const { return 0.f; }
    static constexpr bool ROWSTAT = false;
    DI bool wants_stat(int) const { return false; }
    DI void rowstat(int, int, int, float) const {}
    struct Pre {}; DI Pre pre(int, int, int) const { return Pre{}; }
    DI float operator()(int, int, const float (&)[8], float, int, const Pre&) const { return 0.f; }
    DI void pair(int row, int col0, const float (&a)[8], const float (&b)[8], float) const { const int pn = col0 >> 8, c = col0 & 255; float r[8];
#pragma unroll
        for (int j = 0; j < 8; ++j) { const float g = a[j] * (1.0f / 64.0f), u = b[j] * (1.0f / 64.0f); r[j] = g / (1.0f + __expf(-g)) * u; }
        *(u32x4*)(ACT + (size_t)row * 256 + 128 * pn + c) = pk8(r); }
};
struct EpiDown {
    static constexpr int TAIL = 16;
    bf16* Y;
    DI bool is_pair(int) const { return false; }
    DI void pair(int, int, const float (&)[8], const float (&)[8], float) const {}
    DI float rowctx(int) const { return 0.f; }
    static constexpr bool ROWSTAT = false;
    DI bool wants_stat(int) const { return false; }
    DI void rowstat(int, int, int, float) const {}
    struct Pre {}; DI Pre pre(int, int, int) const { return Pre{}; }
    DI float operator()(int row, int col0, const float (&v)[8], float, int, const Pre&) const { *(u32x4*)(Y + (size_t)row * 1024 + col0) = pk8(v); return 0.f; }
};

DI void conv_item(const bf16* U, const bf16* BG, const float* cw, bf16* ACONV, int row, int c8) {
    const int t = row % SEQ, c = c8 * 8; float u0[8], u1[8], u2[8], bg[8], r[8];
    unpk8(*(const u32x4*)(U + (size_t)row * 512 + c), u2);
    if (t >= 1) unpk8(*(const u32x4*)(U + (size_t)(row - 1) * 512 + c), u1); else {
#pragma unroll
        for (int j = 0; j < 8; ++j) u1[j] = 0.f; }
    if (t >= 2) unpk8(*(const u32x4*)(U + (size_t)(row - 2) * 512 + c), u0); else {
#pragma unroll
        for (int j = 0; j < 8; ++j) u0[j] = 0.f; }
    unpk8(*(const u32x4*)(BG + (size_t)row * 512 + c), bg);
#pragma unroll
    for (int j = 0; j < 8; ++j) r[j] = bg[j] * (cw[c + j] * u0[j] + cw[512 + c + j] * u1[j] + cw[1024 + c + j] * u2[j]);
    *(u32x4*)(ACONV + (size_t)row * 512 + c) = pk8(r);
}
DI void conv_items4(const bf16* U, const bf16* BG, const float* cw, bf16* ACONV, int row0, int rstep, int c8) {
    const int c = c8 * 8; u32x4 r2[4], r1[4], r0[4], rb[4];
#pragma unroll
    for (int k = 0; k < 4; ++k) { const int row = row0 + k * rstep, t = row % SEQ;
        r2[k] = *(const u32x4*)(U + (size_t)row * 512 + c); r1[k] = (t >= 1) ? *(const u32x4*)(U + (size_t)(row - 1) * 512 + c) : (u32x4){0u, 0u, 0u, 0u};
        r0[k] = (t >= 2) ? *(const u32x4*)(U + (size_t)(row - 2) * 512 + c) : (u32x4){0u, 0u, 0u, 0u}; rb[k] = *(const u32x4*)(BG + (size_t)row * 512 + c); }
    float w0[8], w1[8], w2[8];
#pragma unroll
    for (int j = 0; j < 8; ++j) { w0[j] = cw[c + j]; w1[j] = cw[512 + c + j]; w2[j] = cw[1024 + c + j]; }
#pragma unroll
    for (int k = 0; k < 4; ++k) { float u0[8], u1[8], u2[8], bg[8], r[8]; unpk8(r0[k], u0); unpk8(r1[k], u1); unpk8(r2[k], u2); unpk8(rb[k], bg);
#pragma unroll
        for (int j = 0; j < 8; ++j) r[j] = bg[j] * (w0[j] * u0[j] + w1[j] * u1[j] + w2[j] * u2[j]);
        *(u32x4*)(ACONV + (size_t)(row0 + k * rstep) * 512 + c) = pk8(r); }
}
DI int moe_base_lanes(const unsigned* cnt, int lane) {
    int v = lane < NEXP ? (int)((cnt[lane * 64] + 255u) >> 8) * 256 : 0; const int own = v;
#pragma unroll
    for (int d = 1; d < 32; d <<= 1) { const int t = __builtin_amdgcn_ds_bpermute((lane - d) << 2, v); if ((lane & 31) >= d) v += t; }
    return v - own;
}
DI void t2_rows4(float* OUT, bf16* XRB, const bf16* Y, int baseL, const int4* TS, const float2* TW, const float* gnext, bf16* XN, unsigned char* XN8, int final_, int row0, int lane) {
    int4 ts[4]; float2 tw[4];
#pragma unroll
    for (int i = 0; i < 4; ++i) { ts[i] = TS[row0 + i]; tw[i] = TW[row0 + i]; }
    f32x4 v[4][4]; u32x2 p[4][4], q[4][4], xb[4][4];
#pragma unroll
    for (int i = 0; i < 4; ++i) {
        const size_t a1 = (size_t)__builtin_amdgcn_readlane(baseL, __builtin_amdgcn_readfirstlane(ts[i].x)) + ts[i].y, a2 = (size_t)__builtin_amdgcn_readlane(baseL, __builtin_amdgcn_readfirstlane(ts[i].z)) + ts[i].w;
        const u32x2* xr = (const u32x2*)(XRB + (size_t)(row0 + i) * XRP) + lane; const u32x2* y1 = (const u32x2*)(Y + a1 * 1024) + lane; const u32x2* y2 = (const u32x2*)(Y + a2 * 1024) + lane;
#pragma unroll
        for (int j = 0; j < 4; ++j) { xb[i][j] = xr[64 * j]; p[i][j] = y1[64 * j]; q[i][j] = y2[64 * j]; }
    }
    const f32x4* gr = (const f32x4*)gnext + lane; f32x4 gg[4];
#pragma unroll
    for (int j = 0; j < 4; ++j) gg[j] = gr[64 * j];
#pragma unroll
    for (int i = 0; i < 4; ++i) { float s = 0.f;
#pragma unroll
        for (int j = 0; j < 4; ++j) { f32x4& x = v[i][j]; const u32x2 pp = p[i][j], qq = q[i][j], xx = xb[i][j]; const float w1 = tw[i].x, w2 = tw[i].y;
            x = (f32x4){bf2f(xx.x & 0xffffu), bf2f(xx.x >> 16), bf2f(xx.y & 0xffffu), bf2f(xx.y >> 16)};
            x.x += w1 * bf2f(pp.x & 0xffffu) + w2 * bf2f(qq.x & 0xffffu); x.y += w1 * bf2f(pp.x >> 16) + w2 * bf2f(qq.x >> 16);
            x.z += w1 * bf2f(pp.y & 0xffffu) + w2 * bf2f(qq.y & 0xffffu); x.w += w1 * bf2f(pp.y >> 16) + w2 * bf2f(qq.y >> 16);
            s += (x.x * x.x + x.y * x.y) + (x.z * x.z + x.w * x.w); }
        const float rstd = 1.0f / sqrtf(wave_sum(s) * (1.f / D) + EPS);
        f32x4* xo = (f32x4*)(OUT + (size_t)(row0 + i) * D) + lane; u32x2* xs = (u32x2*)(XRB + (size_t)(row0 + i) * XRP) + lane; u32x2* xn = (u32x2*)(XN + (size_t)(row0 + i) * D) + lane;
#pragma unroll
        for (int j = 0; j < 4; ++j) { const f32x4 y = v[i][j] * rstd * gg[j];
            if (final_) xo[64 * j] = y; else { { u32x2 o2; o2.x = pk2(v[i][j].x, v[i][j].y); o2.y = pk2(v[i][j].z, v[i][j].w); xs[64 * j] = o2; } u32x2 o; o.x = pk2(y.x, y.y); o.y = pk2(y.z, y.w); xn[64 * j] = o; ((unsigned*)(XN8 + (size_t)(row0 + i) * D))[lane + 64 * j] = pk4_fp8(y); } }
    }
}
typedef float f32x16 __attribute__((ext_vector_type(16)));
typedef short s16x8 __attribute__((ext_vector_type(8)));
typedef short s16x4 __attribute__((ext_vector_type(4)));
DI int crow(int r, int hi) { return (r & 3) + 8 * (r >> 2) + 4 * hi; }
DI float max2f(float a, float b) { float r; asm("v_max_f32_e32 %0, %1, %2" : "=v"(r) : "v"(a), "v"(b)); return r; }
DI float add2f(float a, float b) { float r = a + b; asm("" : "+v"(r)); return r; }
DI float rowmax16(const f32x16& s) { float r;
    asm("s_nop 15\n\ts_nop 7\n\tv_max3_f32 %0, %1, %2, %3\n\tv_max3_f32 %0, %0, %4, %5\n\tv_max3_f32 %0, %0, %6, %7\n\tv_max3_f32 %0, %0, %8, %9\n\tv_max3_f32 %0, %0, %10, %11\n\tv_max3_f32 %0, %0, %12, %13\n\tv_max3_f32 %0, %0, %14, %15\n\tv_max_f32_e32 %0, %0, %16"
        : "=&v"(r) : "v"(s[0]), "v"(s[1]), "v"(s[2]), "v"(s[3]), "v"(s[4]), "v"(s[5]), "v"(s[6]), "v"(s[7]), "v"(s[8]), "v"(s[9]), "v"(s[10]), "v"(s[11]), "v"(s[12]), "v"(s[13]), "v"(s[14]), "v"(s[15]));
    return r; }
DI float xhalf(float x, int hi) {
    auto rr = __builtin_amdgcn_permlane32_swap(__float_as_uint(x), __float_as_uint(x), false, false);
    return __uint_as_float(hi ? rr[0] : rr[1]);
}
template <int NCH> struct KFrag { s16x8 k[NCH / 2]; };
struct VFrag { s16x8 v[2][2]; };
template <int NCH> DI void k_load(KFrag<NCH>& f, const bf16* KT, int bh, int kb, int r32, int hi) {
    const bf16* kp = KT + ((((size_t)bh * (SEQ / 64) + (kb >> 6)) * NCH) * 64 + (kb & 63) + r32) * 8;
#pragma unroll
    for (int d0 = 0; d0 < NCH / 2; ++d0) f.k[d0] = *(const s16x8*)(kp + (size_t)(2 * d0 + hi) * 512);
}
DI void v_load(VFrag& f, const bf16* VT, int bh, int kb, int r32, int hi) {
    const bf16* vp = VT + ((size_t)bh * (SEQ / 64) + (kb >> 6)) * 4096 + ((kb & 63) >> 5) * 2048 + (size_t)r32 * 16 + hi * 8;
#pragma unroll
    for (int s = 0; s < 2; ++s)
#pragma unroll
        for (int dh = 0; dh < 2; ++dh) f.v[s][dh] = *(const s16x8*)(vp + (s * 2 + dh) * 512);
}
typedef int v8i_t __attribute__((ext_vector_type(8))); typedef int v4i_t __attribute__((ext_vector_type(4)));
DI v8i_t ld32(const unsigned char* p) { const v4i_t a = *(const v4i_t*)p, b = *(const v4i_t*)(p + 16); return __builtin_shufflevector(a, b, 0, 1, 2, 3, 4, 5, 6, 7); }
DI void k_load8(v8i_t (&f)[2], const bf16* KT, int bh, int kb, int r32, int hi) {
    const unsigned char* kp = (const unsigned char*)KT + (((size_t)bh * (SEQ / 64) + (kb >> 6)) * 3 * 64 + (kb & 63) + r32) * 32;
    f[0] = ld32(kp + (size_t)hi * 2048); f[1] = ld32(kp + 2 * 2048);
}
DI f32x16 att_qk8(const v8i_t (&k)[2], const v8i_t (&q)[2], const f32x16& c) {
    f32x16 sc = __builtin_amdgcn_mfma_scale_f32_32x32x64_f8f6f4(k[0], q[0], c, 0, 0, 0, 0, 0, 0);
    return __builtin_amdgcn_mfma_scale_f32_32x32x64_f8f6f4(k[1], q[1], sc, 0, 0, 0, 0, 0, 0);
}
template <int ND0> DI f32x16 att_qk(const s16x8 (&k)[ND0], const s16x8 (&q)[ND0]) {
    f32x16 sc;
#pragma unroll
    for (int r = 0; r < 16; ++r) sc[r] = 0.f;
#pragma unroll
    for (int d0 = 0; d0 < ND0; ++d0) sc = __builtin_amdgcn_mfma_f32_32x32x16_bf16(k[d0], q[d0], sc, 0, 0, 0);
    return sc;
}
DI void att_pack(const float (&p)[16], s16x8 (&pf)[2]) {
#pragma unroll
    for (int s = 0; s < 2; ++s) { u32x4 w; w.x = pk2(p[8 * s], p[8 * s + 1]); w.y = pk2(p[8 * s + 2], p[8 * s + 3]); w.z = pk2(p[8 * s + 4], p[8 * s + 5]); w.w = pk2(p[8 * s + 6], p[8 * s + 7]); pf[s] = __builtin_bit_cast(s16x8, w); }
}
DI void att_pv(f32x16& o0, f32x16& o1, const VFrag& vf, const s16x8 (&pf)[2]) {
#pragma unroll
    for (int s = 0; s < 2; ++s) {
        o0 = __builtin_amdgcn_mfma_f32_32x32x16_bf16(vf.v[s][0], pf[s], o0, 0, 0, 0);
        o1 = __builtin_amdgcn_mfma_f32_32x32x16_bf16(vf.v[s][1], pf[s], o1, 0, 0, 0);
    }
}
DI void att_mask_diag(f32x16& s, int q0, int hi) {
    int Ls = 4 * hi - q0; asm volatile("" : "+v"(Ls));
#pragma unroll
    for (int r = 0; r < 16; ++r) if (Ls > -((r & 3) + 8 * (r >> 2))) s[r] = -INFINITY;
}
constexpr float MLA_PMAX8 = 256.0f;
DI void v_load8(v8i_t (&f)[2], const bf16* VT, int bh, int T, int r32, int hi) {
    const unsigned char* vp = (const unsigned char*)VT + ((((size_t)bh * (SEQ / 64) + T) * 2 * 32 + r32) * 2 + hi) * 32;
    f[0] = ld32(vp); f[1] = ld32(vp + 32 * 64);
}
template <bool INIT> DI void att_exps16(const f32x16& sc, v8i_t& w, int wofs, float (&q)[4]) {
#pragma unroll
    for (int r = 0; r < 16; r += 4) { const float a0 = __builtin_amdgcn_exp2f(sc[r]), a1 = __builtin_amdgcn_exp2f(sc[r + 1]), a2 = __builtin_amdgcn_exp2f(sc[r + 2]), a3 = __builtin_amdgcn_exp2f(sc[r + 3]);
        if (INIT && r == 0) { q[0] = a0; q[1] = a1; q[2] = a2; q[3] = a3; } else { q[0] = add2f(q[0], a0); q[1] = add2f(q[1], a1); q[2] = add2f(q[2], a2); q[3] = add2f(q[3], a3); }
        w[wofs + (r >> 2)] = (int)pk4_fp8((f32x4){a0, a1, a2, a3}); }
}
template <int J> DI void mla_sub64(const v8i_t (&kA)[2], const v8i_t (&kB)[2], const v8i_t (&qf)[2], f32x16& nm, float& l, f32x16& o0, f32x16& o1, v8i_t& pw, bool diag, bool first, int r32, int hi) {
    float ps;
    auto halves = [&]() { float q[4];
        { f32x16 sa = att_qk8(kA, qf, nm); if (J == 0 && diag) att_mask_diag(sa, r32, hi); att_exps16<true>(sa, pw, 0, q); }
        if (J == 0 && diag) {
#pragma unroll
            for (int i = 4; i < 8; ++i) pw[i] = 0; }
        else { f32x16 sb = att_qk8(kB, qf, nm); if (J == 1 && diag) att_mask_diag(sb, r32, hi); att_exps16<false>(sb, pw, 4, q); }
        ps = add2f(add2f(q[0], q[1]), add2f(q[2], q[3])); };
    halves();
    if (first || __builtin_amdgcn_ballot_w64(!(ps <= MLA_PMAX8)) != 0ull) {
        float tm;
        { f32x16 sa = att_qk8(kA, qf, nm); if (J == 0 && diag) att_mask_diag(sa, r32, hi); tm = rowmax16(sa); }
        if (!(J == 0 && diag)) { f32x16 sb = att_qk8(kB, qf, nm); if (J == 1 && diag) att_mask_diag(sb, r32, hi); tm = max2f(tm, rowmax16(sb)); }
        tm = max2f(tm, xhalf(tm, hi));
        const float d = first ? tm : max2f(tm, 0.f), alpha = first ? 1.0f : __builtin_amdgcn_exp2f(-d);
        l *= alpha;
#pragma unroll
        for (int r = 0; r < 16; ++r) { o0[r] *= alpha; o1[r] *= alpha; nm[r] -= d; }
        halves();
    }
    l = add2f(l, ps);
}
DI void mla_wave_unit(const bf16* Q, const bf16* KT, const bf16* VT, bf16* O, int bh, int qblk) {
    const int lane = lane_id();
    const int b = bh >> 3, h = bh & 7, r32 = lane & 31, hi = lane >> 5;
    const int t0 = qblk * 64; const size_t row0 = (size_t)b * SEQ + t0 + r32;
    v8i_t qf[2][2];
#pragma unroll
    for (int j = 0; j < 2; ++j) { const unsigned char* qp = (const unsigned char*)Q + (row0 + 32 * j) * 768 + h * 96;
        qf[j][0] = ld32(qp + 32 * hi); const v8i_t t = ld32(qp + 64);
#pragma unroll
        for (int i = 0; i < 8; ++i) qf[j][1][i] = hi ? 0 : t[i]; }
    f32x16 o0[2], o1[2], nm[2]; float l[2];
#pragma unroll
    for (int j = 0; j < 2; ++j) { l[j] = 0.f;
#pragma unroll
        for (int r = 0; r < 16; ++r) { o0[j][r] = 0.f; o1[j][r] = 0.f; nm[j][r] = 0.f; } }
    v8i_t kA[2], kB[2], vf[2], pw;
    k_load8(kA, KT, bh, 0, r32, hi); k_load8(kB, KT, bh, 32, r32, hi); v_load8(vf, VT, bh, 0, r32, hi);
    for (int T = 0; T <= qblk; ++T) {
        const bool diag = T == qblk; const int Tn = T < SEQ / 64 - 1 ? T + 1 : T;
        mla_sub64<0>(kA, kB, qf[0], nm[0], l[0], o0[0], o1[0], pw, diag, T == 0, r32, hi);
        o0[0] = __builtin_amdgcn_mfma_scale_f32_32x32x64_f8f6f4(vf[0], pw, o0[0], 0, 0, 0, 0, 0, 0); o1[0] = __builtin_amdgcn_mfma_scale_f32_32x32x64_f8f6f4(vf[1], pw, o1[0], 0, 0, 0, 0, 0, 0);
        mla_sub64<1>(kA, kB, qf[1], nm[1], l[1], o0[1], o1[1], pw, diag, T == 0, r32, hi);
        k_load8(kA, KT, bh, 64 * Tn, r32, hi); k_load8(kB, KT, bh, 64 * Tn + 32, r32, hi);
        o0[1] = __builtin_amdgcn_mfma_scale_f32_32x32x64_f8f6f4(vf[0], pw, o0[1], 0, 0, 0, 0, 0, 0); o1[1] = __builtin_amdgcn_mfma_scale_f32_32x32x64_f8f6f4(vf[1], pw, o1[1], 0, 0, 0, 0, 0, 0);
        v_load8(vf, VT, bh, Tn, r32, hi);
    }
    int r32e = r32; asm volatile("" : "+v"(r32e));
    const size_t rowe = (size_t)b * SEQ + t0 + r32e;
#pragma unroll
    for (int j = 0; j < 2; ++j) {
        l[j] += xhalf(l[j], hi); const float inv = 16.0f / l[j];
        unsigned char* op = (unsigned char*)O + (rowe + 32 * j) * 512 + h * 64 + 4 * hi;
#pragma unroll
        for (int a = 0; a < 4; ++a) {
            *(unsigned*)(op + 8 * a) = pk4_fp8((f32x4){o0[j][4 * a], o0[j][4 * a + 1], o0[j][4 * a + 2], o0[j][4 * a + 3]} * inv);
            *(unsigned*)(op + 32 + 8 * a) = pk4_fp8((f32x4){o1[j][4 * a], o1[j][4 * a + 1], o1[j][4 * a + 2], o1[j][4 * a + 3]} * inv);
        }
    }
}
DI void sb_step(const f32x16& sc, float& R, s16x8 (&pf)[2], bool diag, int L, int d, int hi) {
    float p[16], z[16], sp[16];
#pragma unroll
    for (int r = 0; r < 16; ++r) { z[r] = sc[r]; sp[r] = __builtin_amdgcn_fmed3f(z[r], 0.f, INFINITY) + __builtin_amdgcn_logf(1.0f + __builtin_amdgcn_exp2f(-fabsf(z[r]))); }
    if (diag) { int Ls = L; asm volatile("" : "+v"(Ls));
#pragma unroll
        for (int r = 0; r < 16; ++r) if (!(Ls < d - ((r & 3) + 8 * (r >> 2)))) { sp[r] = 0.f; z[r] = -INFINITY; } }
    float g[4], og[4];
#pragma unroll
    for (int a = 0; a < 4; ++a) { g[a] = add2f(add2f(sp[4 * a], sp[4 * a + 1]), add2f(sp[4 * a + 2], sp[4 * a + 3])); og[a] = xhalf(g[a], hi); }
    float SA[4]; float run = 0.f;
#pragma unroll
    for (int a = 3; a >= 0; --a) { SA[a] = run + (hi ? 0.f : og[a]); run += g[a] + og[a]; }
#pragma unroll
    for (int a = 0; a < 4; ++a) { float suf = R - SA[a];
#pragma unroll
        for (int i = 3; i >= 0; --i) { const int r = 4 * a + i; suf -= sp[r]; p[r] = __builtin_amdgcn_exp2f(z[r] + suf); } }
    R -= run;
    att_pack(p, pf);
}
DI void sb_wave_unit(const bf16* Q, const bf16* KT, const bf16* VT, bf16* O, int bh, int qblk) {
    constexpr int NCH = 8, ND0 = 4; const int lane = lane_id();
    const int b = bh >> 3, h = bh & 7, r32 = lane & 31, hi = lane >> 5;
    const int t0 = qblk * 64; const size_t row0 = (size_t)b * SEQ + t0 + r32; const int L = 4 * hi - r32;
    s16x8 qf[2][ND0];
#pragma unroll
    for (int j = 0; j < 2; ++j)
#pragma unroll
        for (int d0 = 0; d0 < ND0; ++d0) qf[j][d0] = *(const s16x8*)(Q + (row0 + 32 * j) * 512 + h * 64 + d0 * 16 + hi * 8);
    f32x16 o0[2], o1[2]; float R[2] = {0.f, 0.f};
#pragma unroll
    for (int j = 0; j < 2; ++j)
#pragma unroll
        for (int r = 0; r < 16; ++r) { o0[j][r] = 0.f; o1[j][r] = 0.f; }
    KFrag<NCH> cur, nxt; VFrag vf; s16x8 pf[2];
    bool done0 = false, done1 = false;
    k_load<NCH>(cur, KT, bh, t0 + 32, r32, hi);
    for (int kb = t0 + 32; kb >= 0; kb -= 32) {
        v_load(vf, VT, bh, kb, r32, hi);
        k_load<NCH>(nxt, KT, bh, kb >= 32 ? kb - 32 : 0, r32, hi);
        f32x16 s0, s1;
        if (kb <= t0 && !done0) s0 = att_qk<ND0>(cur.k, qf[0]);
        if (!done1) s1 = att_qk<ND0>(cur.k, qf[1]);
        if (kb <= t0 && !done0) { sb_step(s0, R[0], pf, kb == t0, L, t0 - kb, hi); att_pv(o0[0], o1[0], vf, pf); done0 = __builtin_amdgcn_ballot_w64(R[0] >= -150.0f) == 0ull; }
        if (!done1) { sb_step(s1, R[1], pf, kb == t0 + 32, L, t0 + 32 - kb, hi); att_pv(o0[1], o1[1], vf, pf); done1 = __builtin_amdgcn_ballot_w64(R[1] >= -150.0f) == 0ull; }
        if (done0 && done1) break;
        cur = nxt;
    }
    int r32e = r32; asm volatile("" : "+v"(r32e));
    const size_t rowe = (size_t)b * SEQ + t0 + r32e;
#pragma unroll
    for (int j = 0; j < 2; ++j) {
        unsigned char* op = (unsigned char*)O + (rowe + 32 * j) * 512 + h * 64 + 4 * hi;
#pragma unroll
        for (int a = 0; a < 4; ++a) {
            *(unsigned*)(op + 8 * a) = pk4_fp8((f32x4){o0[j][4 * a], o0[j][4 * a + 1], o0[j][4 * a + 2], o0[j][4 * a + 3]} * 16.0f);
            *(unsigned*)(op + 32 + 8 * a) = pk4_fp8((f32x4){o1[j][4 * a], o1[j][4 * a + 1], o1[j][4 * a + 2], o1[j][4 * a + 3]} * 16.0f);
        }
    }
}
#define LAS __attribute__((address_space(3)))
namespace pg8 {
typedef short bf16x8 __attribute__((ext_vector_type(8)));
constexpr int BM = 256, BK = 64, HALF = 128, HTB = HALF * BK * 2, STAGE_BYTES = 8 * HTB, NXCD = 8, WGM = 8;
DI int lds_byte(int r, int c) { const int st = (r >> 4) * 2 + (c >> 5), rr = r & 15, cc = c & 31, ob = rr * 64 + cc * 2; return st * 1024 + (ob ^ (((ob >> 9) & 1) << 5)); }
DI void stage_rc(int b, int& R, int& C) { const int st = b / 1024, sb = b % 1024, swz = sb ^ (((sb >> 9) & 1) << 5); R = (st >> 1) * 16 + swz / 64; C = (st & 1) * 32 + (swz % 64) / 2; }
typedef int pg8_v8i __attribute__((ext_vector_type(8))); typedef int pg8_v4i __attribute__((ext_vector_type(4)));
DI pg8_v8i pg8_cat(bf16x8 lo, bf16x8 hi) { const pg8_v4i a = __builtin_bit_cast(pg8_v4i, lo), b = __builtin_bit_cast(pg8_v4i, hi); return __builtin_shufflevector(a, b, 0, 1, 2, 3, 4, 5, 6, 7); }
DI int perm32(int rho) { const int n = rho >> 4, i = rho & 15; return 8 * (i >> 2) + 4 * n + (i & 3); }
struct Unit { const char* a; const char* b; const int* gl; int row0, col0, pn, nvalid, K, aux; };
struct DenseOrder {
    const char *A, *B; int nM, nN, nwg, G, c, K;
    DI void init(const void* A_, const void* B_, int Mrows, int N, int K_, int G_, int c_) { A = (const char*)A_; B = (const char*)B_; nM = Mrows / BM; nN = N / BM; nwg = nM * nN; G = G_; c = c_; K = K_; }
    DI bool next(int i, Unit& u) const {
        const long L = (long)i * G + c; if (L >= nwg) return false;
        int wgid = (int)L; { const int q = nwg / NXCD, r = nwg % NXCD, xcd = wgid % NXCD, off = wgid / NXCD; wgid = (xcd < r ? xcd * (q + 1) : r * (q + 1) + (xcd - r) * q) + off; }
        const int nig = WGM * nN, gid = wgid / nig, fm = gid * WGM, gsz = (nM - fm) < WGM ? (nM - fm) : WGM;
        const int pm = fm + ((wgid % nig) % gsz), pn = (wgid % nig) / gsz;
        u.a = A + (size_t)pm * BM * K * 2; u.b = B + (size_t)pn * BM * K * 2; u.gl = nullptr; u.row0 = pm * BM; u.col0 = pn * BM; u.pn = pn; u.nvalid = 256; u.K = K; u.aux = 0; return true;
    }
};
template <unsigned MASK> struct MaskedDense {
    DenseOrder T;
    DI void init(const void* A_, const void* B_, int Mrows, int K_, int G_, int c_) { asm volatile("" : "+s"(c_));
        T.init(A_, B_, Mrows, __builtin_popcount(MASK) * BM, K_, G_, c_); }
    DI bool next(int i, Unit& u) const {
        if (!T.next(i, u)) return false;
        unsigned m = MASK; for (int j = 0; j < u.pn; ++j) m &= m - 1u;
        const int p = __builtin_ctz(m); u.b = T.B + (size_t)p * 524288; u.col0 = p * BM; u.pn = p; return true;
    }
};
template <bool GATHER> struct GroupedOrder {
    LAS int* tbl;
    const char* A; const char* B; const int* LIST; int K, NCT, brows, G, c;
    DI void init_lanes(const unsigned* cnt, int lane) {
        const int n = lane < NEXP ? (int)cnt[lane * 64] : 0; int v = (n + 255) >> 8; const int own = v;
#pragma unroll
        for (int d = 1; d < 32; d <<= 1) { const int t = __builtin_amdgcn_ds_bpermute((lane - d) << 2, v); if ((lane & 31) >= d) v += t; }
        tbl[lane] = lane < NEXP ? v - own : 0x7fffffff; tbl[64 + lane] = n; asm volatile("s_waitcnt lgkmcnt(0)" ::: "memory");
    }
    DI bool next(int i, Unit& u) const {
        const int L = i * G + c, rt = L / NCT, pn = L % NCT;
        const int ln = lane_id(), startL = tbl[ln], cntL = tbl[64 + ln];
        const unsigned long long mk = __builtin_amdgcn_ballot_w64(startL <= rt); const int e = 63 - __builtin_clzll(mk | 1ull);
        const int st = __builtin_amdgcn_readlane(startL, e), ne = __builtin_amdgcn_readlane(cntL, e), ti = rt - st;
        if (ti * BM >= ne) return false;
        u.row0 = rt * BM; u.col0 = pn * BM; u.pn = pn; u.K = K; u.aux = 0; u.b = B + ((size_t)e * brows + pn * BM) * K * 2;
        if (GATHER) { u.a = A; u.gl = LIST + (size_t)e * M + ti * BM; const int rem = ne - ti * BM; u.nvalid = rem < BM ? rem : BM; }
        else { u.a = A + (size_t)rt * BM * K * 2; u.gl = nullptr; u.nvalid = 256; }
        return true;
    }
};
template <int KIND, int BR0 = 0, int NBR = 3> struct BranchOrder {
    DenseOrder T; const char* ws;
    DI bool next(int i, Unit& u) const {
        Unit t; if (!T.next(i / NBR, t)) return false; const int br = BR0 + i % NBR; const int pm = t.row0 / BM, pn = t.pn;
        u = t; u.aux = br; u.K = KIND == 2 ? 256 : 512;
        if (KIND == 0) { u.a = ws + WS_XN8 + (size_t)pm * BM * 1024; u.b = ws + WS_WG + ((size_t)br * 1024 + pn * BM) * 1024; }
        else if (KIND == 2) { u.a = ws + (br == 1 ? WS_OMLA : WS_OSB) + (size_t)pm * BM * 512; u.b = ws + (br == 1 ? WS_WOM : WS_WOS) + (size_t)pn * BM * 512; }
        else { const size_t ao = br == 0 ? WS_ACONV : br == 1 ? WS_OMLA : WS_OSB, wo = br == 0 ? WS_WOC : br == 1 ? WS_WOM : WS_WOS;
            u.a = ws + ao + (size_t)pm * BM * 512 * 2; u.b = ws + wo + (size_t)pn * BM * 512 * 2; }
        return true;
    }
};
template <class E> struct EpiAdapt {
    static constexpr int TAIL = E::TAIL;
    E e;
    DI void operator()(const f32x4 (&acc)[2][2][4][2], const Unit& u, int wid) const {
        const int ln_ = lane_id(), fr = ln_ & 15, fq = ln_ >> 4, wr = wid >> 2, wc = wid & 3;
        const bool pr = e.is_pair(u.pn);
#pragma unroll
        for (int ai = 0; ai < 2; ++ai) {
            if (pr) {
#pragma unroll
                for (int m = 0; m < 4; ++m) {
                    int row = u.row0 + ai * HALF + wr * 64 + m * 16 + fr; asm volatile("" : "+v"(row));
                    float a[8], b[8];
#pragma unroll
                    for (int j = 0; j < 4; ++j) { a[j] = acc[ai][0][m][0][j]; a[4 + j] = acc[ai][0][m][1][j]; b[j] = acc[ai][1][m][0][j]; b[4 + j] = acc[ai][1][m][1][j]; }
                    e.pair(row, u.col0 + wc * 32 + 8 * fq, a, b, 0.f);
                }
            } else {
                typename E::Pre P[4][2]; float ctx[4]; int rows[4];
#pragma unroll
                for (int m = 0; m < 4; ++m) {
                    int row = u.row0 + ai * HALF + wr * 64 + m * 16 + fr; asm volatile("" : "+v"(row)); rows[m] = row; ctx[m] = e.rowctx(row);
#pragma unroll
                    for (int bj = 0; bj < 2; ++bj) P[m][bj] = e.pre(row, u.col0 + bj * HALF + wc * 32 + 8 * fq, u.aux);
                }
#pragma unroll
                for (int m = 0; m < 4; ++m) { float part = 0.f;
#pragma unroll
                    for (int bj = 0; bj < 2; ++bj) { float v[8];
#pragma unroll
                        for (int j = 0; j < 4; ++j) { v[j] = acc[ai][bj][m][0][j]; v[4 + j] = acc[ai][bj][m][1][j]; }
                        part += e(rows[m], u.col0 + bj * HALF + wc * 32 + 8 * fq, v, ctx[m], u.aux, P[m][bj]); }
                    if (E::ROWSTAT && e.wants_stat(u.pn)) { const int ln = fr | (fq << 4); part += shfl_xor_l(part, 16, ln); part += shfl_xor_l(part, 32, ln); if (fq == 0) e.rowstat(rows[m], u.pn, wc, part); }
                }
            }
            asm volatile("" ::: "memory");
        }
    }
};
template <class Epi, class Sched, bool GATHER, bool VARK = false, bool FP8 = false, bool RELAX = true>
DI void gemm_phase(LAS unsigned char* lds, const int wid_in, const int K0, const Sched& S, const Epi& E) {
    int wid = wid_in; asm volatile("" : "+s"(wid));
    const int lane = lane_id(), tid = wid * 64 + lane, wr = wid >> 2, wc = wid & 3, fr = lane & 15, fq = lane >> 4;
    const size_t kstep = (size_t)(BK * 2);
    const unsigned ldsw = (unsigned)wid * 1024u;
    const int aoff = FP8 ? lds_byte(wr * 64 + fr, fq * 16) : lds_byte(wr * 64 + fr, fq * 8), boff = FP8 ? lds_byte(wc * 32 + fr, fq * 16) : lds_byte(wc * 32 + fr, fq * 8);
    LAS unsigned char* pa_ = lds + aoff; LAS unsigned char* pb_ = lds + 4 * HTB + boff; asm volatile("" : "+v"(pa_), "+v"(pb_));
#define PG8_SA(b, h) (((b) * 2 + (h)) * HTB)
#define PG8_SB(b, h) ((4 + (b) * 2 + (h)) * HTB)
#define PG8_STAGE_B(bufoff, gbase, vb) do { _Pragma("unroll") for (int _i = 0; _i < 2; ++_i) { unsigned _o = (vb)[_i]; asm volatile("" : "+v"(_o));   \
        __builtin_amdgcn_global_load_lds((const unsigned*)((const char*)(gbase) + _o), (LAS unsigned*)(lds + (bufoff) + ldsw + _i * 8192), 16, 0, 0); } } while (0)
#define PG8_STAGE_A(bufoff, gbase, vo, h, hs) do { _Pragma("unroll") for (int _i = 0; _i < 2; ++_i) { unsigned _o = (vo)[GATHER ? (h) : 0][_i]; asm volatile("" : "+v"(_o)); \
        __builtin_amdgcn_global_load_lds((const unsigned*)((const char*)(gbase) + (GATHER ? (size_t)0 : (size_t)(h) * (hs)) + _o), (LAS unsigned*)(lds + (bufoff) + ldsw + _i * 8192), 16, 0, 0); } } while (0)
#define PG8_SETVO(vo, vb, u, KK) do { int RA[2], CA[2]; { const int _t = wid * 64 + lane_id();     \
        _Pragma("unroll") for (int _i = 0; _i < 2; ++_i) { int _R, _C; stage_rc(_t * 16 + _i * 8192, _R, _C); RA[_i] = _R; CA[_i] = _C; vb[_i] = (unsigned)(((_R & ~31) + perm32(_R & 31)) * (KK) + _C) * 2u; } } \
        _Pragma("unroll") for (int _h = 0; _h < (GATHER ? 2 : 1); ++_h) _Pragma("unroll") for (int _i = 0; _i < 2; ++_i) { const int _r = _h * HALF + RA[_i]; \
        if (GATHER) { const int _tok = (_r < (u).nvalid) ? (u).gl[_r] : 0; vo[_h][_i] = (unsigned)(_tok * (KK) + CA[_i]) * 2u; } else vo[_h][_i] = (unsigned)(_r * (KK) + CA[_i]) * 2u; } } while (0)
#define PG8_LDA(dst, b, h) do { if (FP8) { _Pragma("unroll") for (int m = 0; m < 4; ++m) dst##8[m] = pg8_cat(*(const LAS bf16x8*)(pa_ + PG8_SA(b, h) + m * 2048), *(const LAS bf16x8*)(pa_ + PG8_SA(b, h) + m * 2048 + 16)); } \
        else { _Pragma("unroll") for (int m = 0; m < 4; ++m) _Pragma("unroll") for (int k = 0; k < 2; ++k) dst[m][k] = *(const LAS bf16x8*)(pa_ + PG8_SA(b, h) + m * 2048 + k * 1024); } } while (0)
#define PG8_LDB(dst, b, h) do { if (FP8) { _Pragma("unroll") for (int n = 0; n < 2; ++n) dst##8[n] = pg8_cat(*(const LAS bf16x8*)(pb_ + PG8_SA(b, h) + n * 2048), *(const LAS bf16x8*)(pb_ + PG8_SA(b, h) + n * 2048 + 16)); } \
        else { _Pragma("unroll") for (int n = 0; n < 2; ++n) _Pragma("unroll") for (int k = 0; k < 2; ++k) dst[n][k] = *(const LAS bf16x8*)(pb_ + PG8_SA(b, h) + n * 2048 + k * 1024); } } while (0)
#define PG8_MMA(ai, bj, At, Bt) do { __builtin_amdgcn_s_setprio(1); _Pragma("unroll") for (int m = 0; m < 4; ++m) _Pragma("unroll") for (int n = 0; n < 2; ++n) { \
        if (FP8) acc[ai][bj][m][n] = __builtin_amdgcn_mfma_scale_f32_16x16x128_f8f6f4(Bt##8[n], At##8[m], acc[ai][bj][m][n], 0, 0, 0, 0, 0, 0); \
        else { _Pragma("unroll") for (int k = 0; k < 2; ++k) acc[ai][bj][m][n] = __builtin_amdgcn_mfma_f32_16x16x32_bf16(Bt[n][k], At[m][k], acc[ai][bj][m][n], 0, 0, 0); } } \
        __builtin_amdgcn_s_setprio(0); } while (0)
#define PG8_WAIT_V(n) asm volatile("s_waitcnt vmcnt(" #n ")" ::: "memory")
#define PG8_WAIT_R() do { if (rel) asm volatile("s_waitcnt vmcnt(%0)" :: "n"(8 + Epi::TAIL) : "memory"); else asm volatile("s_waitcnt vmcnt(8)" ::: "memory"); } while (0)
#define PG8_WAIT_L(n) asm volatile("s_waitcnt lgkmcnt(" #n ")" ::: "memory")
#define PG8_BAR __builtin_amdgcn_s_barrier()
#define PG8_SCHED __builtin_amdgcn_sched_barrier(0)
    Unit cur, nxt; int ui = 0;
    if (!S.next(0, cur)) return;
    f32x4 acc[2][2][4][2];
#pragma unroll
    for (int a = 0; a < 2; ++a)
#pragma unroll
        for (int b = 0; b < 2; ++b)
#pragma unroll
            for (int m = 0; m < 4; ++m)
#pragma unroll
                for (int n = 0; n < 2; ++n) acc[a][b][m][n] = (f32x4){0.f, 0.f, 0.f, 0.f};
    bf16x8 At[4][2], B0[2][2], B1[2][2]; pg8_v8i At8[4], B08[2], B18[2];
    unsigned voffA[GATHER ? 2 : 1][2], voffN[GATHER ? 2 : 1][2], voffB[2], voffBn[2];
    int kC = VARK ? cur.K : K0;
    PG8_SETVO(voffA, voffB, cur, kC);
    size_t hstep = (size_t)HALF * kC * 2;
    const char* cA = cur.a; const char* cB = cur.b;
    PG8_STAGE_B(PG8_SB(0, 0), cB, voffB); PG8_STAGE_B(PG8_SB(0, 1), cB + hstep, voffB); PG8_STAGE_A(PG8_SA(0, 0), cA, voffA, 0, hstep); PG8_STAGE_A(PG8_SA(0, 1), cA, voffA, 1, hstep);
    if (wr == 1) PG8_BAR;
    PG8_WAIT_V(2); PG8_BAR;
    PG8_STAGE_B(PG8_SB(1, 0), cB + kstep, voffB); PG8_STAGE_A(PG8_SA(1, 0), cA + kstep, voffA, 0, hstep); PG8_STAGE_B(PG8_SB(1, 1), cB + hstep + kstep, voffB); PG8_STAGE_A(PG8_SA(1, 1), cA + kstep, voffA, 1, hstep);
    PG8_WAIT_V(8); PG8_BAR;
    for (;;) {
        const bool has_next = S.next(ui + 1, nxt);
        const char* nA = has_next ? nxt.a : cA; const char* nB = has_next ? nxt.b : cB;
        const int kN = (VARK && has_next) ? nxt.K : kC; const size_t hstepN = (size_t)HALF * kN * 2;
        if (GATHER || VARK) { if (has_next) { PG8_SETVO(voffN, voffBn, nxt, kN); } else {
#pragma unroll
            for (int i = 0; i < 2; ++i) voffBn[i] = voffB[i];
#pragma unroll
            for (int h = 0; h < (GATHER ? 2 : 1); ++h)
#pragma unroll
                for (int i = 0; i < 2; ++i) voffN[h][i] = voffA[h][i]; } }
        const int nt = kC / BK;
#pragma unroll 1
        for (int t = 0; t < nt; t += 2) {
            const bool last = (t == nt - 2); const bool rel = RELAX && !GATHER && (ui > 0) && (t == 0);
            const char* a1 = cA + (size_t)(t + 1) * kstep;
            const char* a2 = last ? nA : cA + (size_t)(t + 2) * kstep; const char* b2 = last ? nB : cB + (size_t)(t + 2) * kstep;
            const char* a3 = a2 + kstep; const char* b3 = b2 + kstep;
            unsigned v2[GATHER ? 2 : 1][2], vb2[2]; const size_t h2 = (VARK && last) ? hstepN : hstep;
#pragma unroll
            for (int i = 0; i < 2; ++i) vb2[i] = (VARK && last) ? voffBn[i] : voffB[i];
#pragma unroll
            for (int h = 0; h < (GATHER ? 2 : 1); ++h)
#pragma unroll
                for (int i = 0; i < 2; ++i) v2[h][i] = ((GATHER || VARK) && last) ? voffN[h][i] : voffA[h][i];
            PG8_LDB(B0, 0, 0); PG8_LDB(B1, 0, 1); PG8_SCHED; PG8_LDA(At, 0, 0); if (t != 0) PG8_STAGE_A(PG8_SA(1, 1), a1, voffA, 1, hstep);
            PG8_WAIT_R(); PG8_WAIT_L(0); PG8_BAR; PG8_MMA(0, 0, At, B0); PG8_MMA(0, 1, At, B1); PG8_BAR; PG8_SCHED;
            PG8_LDA(At, 0, 1); PG8_STAGE_B(PG8_SB(0, 0), b2, vb2); PG8_STAGE_B(PG8_SB(0, 1), b2 + h2, vb2); PG8_STAGE_A(PG8_SA(0, 0), a2, v2, 0, h2);
            PG8_WAIT_R(); PG8_WAIT_L(0); PG8_BAR; PG8_MMA(1, 0, At, B0); PG8_MMA(1, 1, At, B1); PG8_BAR; PG8_SCHED;
            PG8_LDB(B0, 1, 0); PG8_LDB(B1, 1, 1); PG8_SCHED; PG8_LDA(At, 1, 0); PG8_STAGE_A(PG8_SA(0, 1), a2, v2, 1, h2);
            PG8_WAIT_R(); PG8_WAIT_L(0); PG8_BAR; PG8_MMA(0, 0, At, B0); PG8_MMA(0, 1, At, B1); PG8_BAR; PG8_SCHED;
            PG8_LDA(At, 1, 1); PG8_STAGE_B(PG8_SB(1, 0), b3, vb2); PG8_STAGE_B(PG8_SB(1, 1), b3 + h2, vb2); PG8_STAGE_A(PG8_SA(1, 0), a3, v2, 0, h2);
            PG8_WAIT_V(8); PG8_WAIT_L(0); PG8_BAR; PG8_MMA(1, 0, At, B0); PG8_MMA(1, 1, At, B1); PG8_BAR; PG8_SCHED;
        }
        if (has_next) { if (GATHER || VARK) PG8_STAGE_A(PG8_SA(1, 1), nA + kstep, voffN, 1, hstepN); else PG8_STAGE_A(PG8_SA(1, 1), nA + kstep, voffA, 1, hstep); }
        if (wr == 0) PG8_BAR;
        E(acc, cur, wid);
        if (!has_next) break;
#pragma unroll
        for (int a = 0; a < 2; ++a)
#pragma unroll
            for (int b = 0; b < 2; ++b)
#pragma unroll
                for (int m = 0; m < 4; ++m)
#pragma unroll
                    for (int n = 0; n < 2; ++n) acc[a][b][m][n] = (f32x4){0.f, 0.f, 0.f, 0.f};
        cur = nxt; cA = nA; cB = nB; ++ui;
        if (GATHER || VARK) {
#pragma unroll
        for (int i = 0; i < 2; ++i) voffB[i] = voffBn[i];
#pragma unroll
        for (int h = 0; h < (GATHER ? 2 : 1); ++h)
#pragma unroll
            for (int i = 0; i < 2; ++i) voffA[h][i] = voffN[h][i]; kC = kN; hstep = hstepN; }
        if (wr == 1) PG8_BAR;
    }
    PG8_WAIT_V(0);
    PG8_BAR;
#undef PG8_SA
#undef PG8_SB
#undef PG8_STAGE_A
#undef PG8_STAGE_B
#undef PG8_SETVO
#undef PG8_LDA
#undef PG8_LDB
#undef PG8_MMA
#undef PG8_WAIT_V
#undef PG8_WAIT_R
#undef PG8_WAIT_L
#undef PG8_BAR
#undef PG8_SCHED
}
}

#define XB_TMO      128
#define XB_XCNT(j)  (256  + 64 * (j))
#define XB_XSUB(j)  (1280 + 64 * (j))
#define XB_XGEN(j)  (2304 + 64 * (j))
#define XB_TOP      3328
#define XB_TOPGEN   3392
#define XCD_BAR_WORDS 3456
#define XB_SPIN_CAP (1u << 18)

__device__ __forceinline__ unsigned xb_ld(unsigned* p)              { return __hip_atomic_load(p, __ATOMIC_RELAXED, __HIP_MEMORY_SCOPE_AGENT); }
__device__ __forceinline__ unsigned xb_add(unsigned* p, unsigned v) { return __hip_atomic_fetch_add(p, v, __ATOMIC_RELAXED, __HIP_MEMORY_SCOPE_AGENT); }
__device__ __forceinline__ unsigned xb_xcc_id() { return (unsigned)__builtin_amdgcn_s_getreg((3 << 11) | 20) & 0xFu; }
#define XB_SPIN(cond, bar) do { unsigned _sp = 0; while (cond) { __builtin_amdgcn_s_sleep(1); \
    if ((++_sp & 255u) == 0u) { if (xb_ld(&(bar)[XB_TMO])) break; if (_sp > XB_SPIN_CAP) { atomicAdd(&(bar)[XB_TMO], 1u); break; } } } } while (0)

struct XcdBarrier {
    unsigned* bar; unsigned x;
    volatile LAS unsigned* st;
    int wave;
};

__device__ __forceinline__ XcdBarrier xcd_barrier_post(unsigned* bar, volatile LAS unsigned* st) {
    XcdBarrier b; b.bar = bar; b.x = xb_xcc_id(); b.st = st;
    if (threadIdx.x == 0) (void)xb_add(&bar[XB_XCNT(b.x)], 1u);
    return b;
}
__device__ __forceinline__ void xcd_barrier_complete(unsigned* bar, unsigned x, unsigned& nloc, unsigned& nx) {
    const unsigned G = gridDim.x * gridDim.y * gridDim.z;
    unsigned sum, cnt, mine, sp = 0u;
    for (;;) {
        sum = 0u; cnt = 0u; mine = 0u;
#pragma unroll
        for (unsigned j = 0; j < 16; ++j) { const unsigned c = xb_ld(&bar[XB_XCNT(j)]); sum += c; cnt += (c > 0u) ? 1u : 0u; }
        if (sum == G) { mine = xb_ld(&bar[XB_XCNT(x)]); break; }
        __builtin_amdgcn_s_sleep(1);
        if ((++sp & 255u) == 0u) { if (xb_ld(&bar[XB_TMO])) break; if (sp > XB_SPIN_CAP) { atomicAdd(&bar[XB_TMO], 1u); break; } }
    }
    nloc = mine > 0u ? mine : 1u; nx = cnt > 0u ? cnt : 1u;
}

__device__ __forceinline__ void xcd_barrier(const XcdBarrier& b) {
    asm volatile("s_waitcnt vmcnt(0)" ::: "memory");
    __syncthreads();
    if (b.wave == 0 && lane_id() == 0) {
        unsigned* bar = b.bar;
        __builtin_amdgcn_s_waitcnt(0);
        unsigned nloc = b.st[0], nx = b.st[1];
        if (nloc == 0u) { xcd_barrier_complete(bar, b.x, nloc, nx); b.st[0] = nloc; b.st[1] = nx; }
        const unsigned old = xb_add(&bar[XB_XSUB(b.x)], 1u);
        const unsigned gen = old / nloc;
        if (old + 1u == (gen + 1u) * nloc) {
            __builtin_amdgcn_fence(__ATOMIC_RELEASE, "agent");
            asm volatile("s_waitcnt vmcnt(0)" ::: "memory");
            const unsigned og = xb_add(&bar[XB_TOP], 1u);
            const unsigned tg = og / nx;
            if (og + 1u == (tg + 1u) * nx) xb_add(&bar[XB_TOPGEN], 1u);
            else XB_SPIN(xb_ld(&bar[XB_TOPGEN]) == tg, bar);
            __builtin_amdgcn_fence(__ATOMIC_ACQUIRE, "agent");
            xb_add(&bar[XB_XGEN(b.x)], 1u);
            asm volatile("s_waitcnt vmcnt(0)" ::: "memory");
        } else {
            XB_SPIN(xb_ld(&bar[XB_XGEN(b.x)]) == gen, bar);
            __builtin_amdgcn_fence(__ATOMIC_ACQUIRE, "agent");
            asm volatile("s_waitcnt vmcnt(0)" ::: "memory");
        }
    }
    __syncthreads();
}

constexpr int NWAVES = 8, RING_BYTES = 131072, LDSCTL_OFF = RING_BYTES, MISC_OFF = LDSCTL_OFF + 320, LDS_BYTES = 147456;
constexpr int CW_BAR = 4096;
constexpr int NPHASE = 1 + 9 * DEPTH;
struct Args { const float* in[23]; float* out; unsigned char* ws; int ph_lo, ph_hi, li, pad; };

typedef short s16x8r __attribute__((ext_vector_type(8)));
DI void t1_group(const bf16* XRB, const float* g, const bf16* WR, const float* brg, const float* bre, unsigned char* ws, int layer, int grp_, bool valid, int lane, int wave, LAS int* lcnt, LAS int* lbase) {
    const int grp = valid ? grp_ : 0;
    const int tok = lane & 15, kg = lane >> 4, row = grp * 16 + tok;
    const bf16* xr = XRB + (size_t)row * XRP + 8 * kg; float ss;
    { const f32x4 q = *(const f32x4*)((const float*)(ws + WS_SSQ2) + (size_t)row * 16 + 4 * kg); ss = (q.x + q.y) + (q.z + q.w); }
    ss += shfl_xor_l(ss, 16, lane); ss += shfl_xor_l(ss, 32, lane);
    const float rstd = 1.0f / sqrtf(ss * (1.f / D) + EPS);
    unsigned char* hrow = ws + WS_H2 + (size_t)row * D + 8 * kg;
    const bf16* wa = WR + (size_t)tok * 1024 + 8 * kg;
    f32x4 acc0 = {0.f, 0.f, 0.f, 0.f}, acc1 = acc0, acc2 = acc0;
#pragma unroll 16
    for (int ks = 0; ks < 32; ++ks) {
        float xt[8]; unpk8(*(const u32x4*)(xr + 32 * ks), xt); const f32x4 a = {xt[0], xt[1], xt[2], xt[3]}, b = {xt[4], xt[5], xt[6], xt[7]}, ga = *(const f32x4*)(g + 32 * ks + 8 * kg), gb = *(const f32x4*)(g + 32 * ks + 8 * kg + 4);
        u32x4 w; w.x = pk2(a.x * rstd * ga.x, a.y * rstd * ga.y); w.y = pk2(a.z * rstd * ga.z, a.w * rstd * ga.w); w.z = pk2(b.x * rstd * gb.x, b.y * rstd * gb.y); w.w = pk2(b.z * rstd * gb.z, b.w * rstd * gb.w);
        { u32x2 h8; h8.x = pk4_fp8((f32x4){a.x * rstd * ga.x, a.y * rstd * ga.y, a.z * rstd * ga.z, a.w * rstd * ga.w}); h8.y = pk4_fp8((f32x4){b.x * rstd * gb.x, b.y * rstd * gb.y, b.z * rstd * gb.z, b.w * rstd * gb.w});
          if (valid) *(u32x2*)(hrow + 32 * ks) = h8; }
        const s16x8r hf = __builtin_bit_cast(s16x8r, w);
        const s16x8r w0 = *(const s16x8r*)(wa + 32 * ks), w1 = *(const s16x8r*)(wa + 16 * 1024 + 32 * ks), w2 = *(const s16x8r*)(wa + 32 * 1024 + 32 * ks);
        acc0 = __builtin_amdgcn_mfma_f32_16x16x32_bf16(w0, hf, acc0, 0, 0, 0); acc1 = __builtin_amdgcn_mfma_f32_16x16x32_bf16(w1, hf, acc1, 0, 0, 0); acc2 = __builtin_amdgcn_mfma_f32_16x16x32_bf16(w2, hf, acc2, 0, 0, 0);
    }
    float gl[4]; int gi = 0;
#pragma unroll
    for (int e = 0; e < 4; ++e) gl[e] = acc0[e] + brg[e];
    float gm = gl[0];
#pragma unroll
    for (int e = 1; e < 4; ++e) if (gl[e] > gm) { gm = gl[e]; gi = e; }
    const bool pick = valid && kg == gi; int e1 = 0, e2 = 0, r1 = 0, r2 = 0; float w1 = 0.f, w2 = 0.f;
    if (pick) {
        float gs = 0.f;
#pragma unroll
        for (int e = 0; e < 4; ++e) gs += __expf(gl[e] - gm);
        const float gw = 1.0f / gs;
        float sel[8];
#pragma unroll
        for (int e = 0; e < 4; ++e) { sel[e] = acc1[e] + bre[8 * kg + e]; sel[4 + e] = acc2[e] + bre[8 * kg + 4 + e]; }
        int i1 = 0; float m1 = sel[0];
#pragma unroll
        for (int e = 1; e < 8; ++e) if (sel[e] > m1) { m1 = sel[e]; i1 = e; }
        int i2 = -1; float m2 = -INFINITY;
#pragma unroll
        for (int e = 0; e < 8; ++e) if (e != i1 && sel[e] > m2) { m2 = sel[e]; i2 = e; }
        const float r = __expf(m2 - m1); w1 = gw / (1.0f + r); w2 = gw * r / (1.0f + r);
        e1 = gi * 8 + i1; e2 = gi * 8 + i2;
        r1 = __atomic_fetch_add(lcnt + e1, 1, __ATOMIC_RELAXED); r2 = __atomic_fetch_add(lcnt + e2, 1, __ATOMIC_RELAXED);
    }
    __syncthreads();
    if (wave == 0 && lane < NEXP) { const int c = lcnt[lane]; unsigned* cnt = (unsigned*)(ws + WS_CTL) + CW_CNT + layer * 32 * 64;
        lbase[lane] = c ? (int)atomicAdd(cnt + lane * 64, (unsigned)c) : 0; lcnt[lane] = 0; }
    __syncthreads();
    if (pick) { const int s1 = lbase[e1] + r1, s2 = lbase[e2] + r2;
        int* LIST = (int*)(ws + WS_LIST); LIST[(size_t)e1 * M + s1] = row; LIST[(size_t)e2 * M + s2] = row;
        ((int4*)(ws + WS_TOKSLOT))[row] = make_int4(e1, s1, e2, s2); ((float2*)(ws + WS_TOKW))[row] = make_float2(w1, w2); }
}

__global__ void __launch_bounds__(NWAVES * 64, 2) mk_fwd(Args args) {
    extern __shared__ __attribute__((aligned(16))) unsigned char lds_raw[];
    LAS unsigned char* lds = (LAS unsigned char*)lds_raw;
    const int wave = __builtin_amdgcn_readfirstlane(threadIdx.x >> 6);
    const int G = gridDim.x; const int bx = blockIdx.x; const int vcu = (G % 8 == 0) ? (bx % 8) * (G / 8) + bx / 8 : bx;
    unsigned char* ws = args.ws; const float* const* in = args.in; float* XR = args.out; bf16* XRB = (bf16*)args.out + 1024;
    for (int u = threadIdx.x; u < (LDS_BYTES - LDSCTL_OFF) / 4; u += NWAVES * 64) ((LAS unsigned*)(lds + LDSCTL_OFF))[u] = 0u;
    __syncthreads();
    unsigned* ctl = (unsigned*)(ws + WS_CTL);
    XcdBarrier bar; bar.bar = ctl + CW_BAR + args.li * XCD_BAR_WORDS; bar.x = 0; bar.st = nullptr;
    bar = xcd_barrier_post(ctl + CW_BAR + args.li * XCD_BAR_WORDS, (volatile LAS unsigned*)(lds + MISC_OFF) + 8);
    bar.wave = wave;
#define IN(k) true
#define SEAM(k) do { if ((k) + 1 < NPHASE) xcd_barrier(bar); } while (0)
    bf16 *XN = (bf16*)(ws + WS_XN), *SBQ = (bf16*)(ws + WS_SBQ), *SBKT = (bf16*)(ws + WS_SBKT), *SBVT = (bf16*)(ws + WS_SBVT), *KT = (bf16*)(ws + WS_KT), *Qb = (bf16*)(ws + WS_Q), *VT = (bf16*)(ws + WS_VT);
    bf16 *U = (bf16*)(ws + WS_U), *BG = (bf16*)(ws + WS_BG), *CQ = (bf16*)(ws + WS_CQ), *CKV = (bf16*)(ws + WS_CKV), *ACONV = (bf16*)(ws + WS_ACONV), *OMLA = (bf16*)(ws + WS_OMLA), *OSB = (bf16*)(ws + WS_OSB);
    unsigned char* GATES = ws + WS_GATES; bf16 *MERGED = (bf16*)(ws + WS_MERGED), *H2 = (bf16*)(ws + WS_H2), *ACT = (bf16*)(ws + WS_ACT), *Y = (bf16*)(ws + WS_Y);
    float* SSQ = (float*)(ws + WS_SSQ); float2* CS = (float2*)(ws + WS_CS);
    const int gw = vcu * NWAVES + wave, NGW = G * NWAVES;
    LAS float* scr = (LAS float*)(lds + wave * 16384);

    if (IN(0)) { const int lane = lane_id();
        for (int k = gw; k < WI_EARLY; k += NGW) { WItem s; wdecode(wi_early(k), in, 0, ws, s); tr_item(s, scr, lane); }
        for (int i = gw * 64 + lane; i < DEPTH * 3072; i += NGW * 64) ((float*)(ws + WS_GB))[i] = __builtin_fmaf(in[4][i], -1.4426950408889634f, -7.994353436858858f);
        for (int r8 = gw; r8 < M / 8; r8 += NGW) { rms_rowsN<8>(in[0], in[2], XN, ws + WS_XN8, 8 * r8, lane); cs_rows4((const int*)in[1], CS, 8 * r8, lane); cs_rows4((const int*)in[1], CS, 8 * r8 + 4, lane); }
    }
    SEAM(0);
    for (int l = 0; l < DEPTH; ++l) {
        const int pb = 1 + 9 * l;
        if (IN(pb + 0)) {
            pg8::EpiAdapt<EpiWinA> E{EpiWinA{U, BG, SBQ, SBKT, SBVT, CQ, CKV, KT, SSQ, CS}};
            { pg8::MaskedDense<PH1_F8MASK> S; S.init(ws + WS_XN8, ws + WS_WA, M, 512, G, bx);
              pg8::gemm_phase<pg8::EpiAdapt<EpiWinA>, pg8::MaskedDense<PH1_F8MASK>, false, false, true>(lds, wave, 512, S, E); }
            { constexpr unsigned REST = ((1u << (NA / 256)) - 1u) & ~PH1_F8MASK; pg8::MaskedDense<REST> S; S.init(XN, ws + WS_WA, M, 1024, G, bx);
              pg8::gemm_phase<pg8::EpiAdapt<EpiWinA>, pg8::MaskedDense<REST>, false>(lds, wave, 1024, S, E); }
        }
        SEAM(pb + 0);
        if (IN(pb + 1)) {
            { pg8::DenseOrder S; S.init(CQ, ws + WS_WUQ, M, 768, 256, G, bx); pg8::EpiAdapt<EpiQ> E{EpiQ{Qb, SSQ, CS}};
              pg8::gemm_phase<pg8::EpiAdapt<EpiQ>, pg8::DenseOrder, false, false, false, false>(lds, wave, 256, S, E); }
            { pg8::DenseOrder S; S.init(CKV, ws + WS_WUKV, M, 1024, 128, G, bx); pg8::EpiAdapt<EpiKV> E{EpiKV{KT, VT, SSQ}};
              pg8::gemm_phase<pg8::EpiAdapt<EpiKV>, pg8::DenseOrder, false, false, false, false>(lds, wave, 128, S, E); }
            const float* cw = in[5] + (size_t)l * 3 * 512; const int tid = wave * 64 + lane_id();
            { const int rstep = G * NWAVES; int id = vcu * (NWAVES * 64) + tid;
              for (; id + 3 * rstep * 64 < M * 64; id += 4 * rstep * 64) conv_items4(U, BG, cw, ACONV, id >> 6, rstep, id & 63);
              for (; id < M * 64; id += rstep * 64) conv_item(U, BG, cw, ACONV, id >> 6, id & 63); }
        }
        SEAM(pb + 1);
        if (IN(pb + 2)) {
            ATTN_PHASE_BODY
        }
        SEAM(pb + 2);
        if (IN(pb + 3)) {
            { pg8::BranchOrder<0> S; S.T.init(nullptr, nullptr, M, 1024, 1024, G, bx); S.ws = (const char*)ws;
              pg8::EpiAdapt<EpiGate8> E{EpiGate8{GATES, (const float*)(ws + WS_GB) + (size_t)l * 3072}};
              pg8::gemm_phase<pg8::EpiAdapt<EpiGate8>, pg8::BranchOrder<0>, false, false, true>(lds, wave, 512, S, E); }
            { pg8::BranchOrder<1, 0, 1> S; S.T.init(nullptr, nullptr, M, 1024, 1024, G, bx); S.ws = (const char*)ws;
              pg8::EpiAdapt<EpiY3<false>> E{EpiY3<false>{GATES, MERGED}};
              pg8::gemm_phase<pg8::EpiAdapt<EpiY3<false>>, pg8::BranchOrder<1, 0, 1>, false>(lds, wave, 512, S, E); }
            { pg8::BranchOrder<2, 1, 2> S; S.T.init(nullptr, nullptr, M, 1024, 1024, G, bx); S.ws = (const char*)ws;
              pg8::EpiAdapt<EpiY3<true>> E{EpiY3<true>{GATES, MERGED}};
              pg8::gemm_phase<pg8::EpiAdapt<EpiY3<true>>, pg8::BranchOrder<2, 1, 2>, false, false, true>(lds, wave, 256, S, E); }
        }
        SEAM(pb + 3);
        if (IN(pb + 4)) {
            pg8::DenseOrder S; S.init(MERGED, ws + WS_WO, M, 1024, 1024, G, bx); pg8::EpiAdapt<EpiWo> E{EpiWo{l == 0 ? in[0] : nullptr, XRB, (float*)(ws + WS_SSQ2)}};
            pg8::gemm_phase<pg8::EpiAdapt<EpiWo>, pg8::DenseOrder, false>(lds, wave, 1024, S, E);
        }
        SEAM(pb + 4);
        if (IN(pb + 5)) { const int lane = lane_id();
            for (int g0 = 0; g0 < M / 16; g0 += NGW) t1_group(XRB, in[14] + l * 1024, (const bf16*)(ws + WS_WR), in[16] + l * 4, in[18] + l * 32, ws, l, g0 + gw, g0 + gw < M / 16, lane, wave,
                                                            (LAS int*)(lds + LDSCTL_OFF + 6144), (LAS int*)(lds + LDSCTL_OFF + 6144 + 256));
        }
        SEAM(pb + 5);
        const unsigned* cnt = ctl + CW_CNT + l * 32 * 64;
        if (IN(pb + 6)) {
            pg8::GroupedOrder<true> S{(LAS int*)(lds + LDSCTL_OFF + 1024), (const char*)H2, (const char*)(ws + WS_WGU), (const int*)(ws + WS_LIST), 512, 2, 512, G, bx}; S.init_lanes(cnt, lane_id());
            pg8::EpiAdapt<EpiGU> E{EpiGU{ACT}};
            pg8::gemm_phase<pg8::EpiAdapt<EpiGU>, pg8::GroupedOrder<true>, true, false, true>(lds, wave, 512, S, E);
        }
        SEAM(pb + 6);
        if (IN(pb + 7)) {
            pg8::GroupedOrder<false> S{(LAS int*)(lds + LDSCTL_OFF + 1024), (const char*)ACT, (const char*)(ws + WS_WD), nullptr, 256, 4, 1024, G, bx}; S.init_lanes(cnt, lane_id());
            pg8::EpiAdapt<EpiDown> E{EpiDown{Y}};
            pg8::gemm_phase<pg8::EpiAdapt<EpiDown>, pg8::GroupedOrder<false>, false>(lds, wave, 256, S, E);
        }
        SEAM(pb + 7);
        if (IN(pb + 8)) { const int lane = lane_id();
            const bool fin = (l + 1 == DEPTH); const float* gnext = fin ? in[22] : in[2] + (l + 1) * 1024;
            const int baseL = moe_base_lanes(cnt, lane);
            for (int r4 = gw; r4 < M / 4; r4 += NGW) t2_rows4(XR, XRB, Y, baseL, (const int4*)(ws + WS_TOKSLOT), (const float2*)(ws + WS_TOKW), gnext, XN, ws + WS_XN8, fin, 4 * r4, lane);
            if (!fin) { for (int k = gw; k < WI_EARLY; k += NGW) { WItem s; wdecode(wi_early(k), in, l + 1, ws, s); tr_item(s, scr, lane); } }
        }
        SEAM(pb + 8);
    }
#undef IN
#undef SEAM
}
template <class T> static T* wsp(void* ws, size_t off) { return (T*)((unsigned char*)ws + off); }
static void launch_mk(Args a, int lo, int hi, int li, int grid, hipStream_t s) { a.ph_lo = lo; a.ph_hi = hi; a.li = li; a.pad = 0; hipLaunchKernelGGL(mk_fwd, dim3(grid), dim3(NWAVES * 64), LDS_BYTES, s, a); }
extern "C" void kernel_launch(void* const* d_in, const int* in_sizes, int n_in, void* d_out, int out_size, void* d_ws, size_t ws_size, hipStream_t stream) {
    static int grid = 0;
    if (grid == 0) {
        if (n_in != 23 || out_size != M * D || ws_size < WS_END) { fprintf(stderr, "kernel_launch: unexpected shapes (n_in %d out %d ws %zu)\n", n_in, out_size, ws_size); grid = -1; return; }
        int dev = 0, cus = 0;
        if (hipGetDevice(&dev) != hipSuccess || hipDeviceGetAttribute(&cus, hipDeviceAttributeMultiprocessorCount, dev) != hipSuccess) { grid = -1; return; }
        if (hipFuncSetAttribute((const void*)mk_fwd, hipFuncAttributeMaxDynamicSharedMemorySize, LDS_BYTES) != hipSuccess) { fprintf(stderr, "kernel_launch: hipFuncSetAttribute failed\n"); grid = -1; return; }
        int per_cu = 0; (void)hipOccupancyMaxActiveBlocksPerMultiprocessor(&per_cu, (const void*)mk_fwd, NWAVES * 64, LDS_BYTES); (void)hipGetLastError();
        grid = cus;
    }
    if (grid < 0) return;
    unsigned char* ws = (unsigned char*)d_ws;
    (void)hipMemsetAsync(ws + WS_CTL, 0, 1 * MiB, stream);
    Args a{}; for (int i = 0; i < 23; ++i) a.in[i] = (const float*)d_in[i]; a.out = (float*)d_out; a.ws = ws;
    launch_mk(a, 0, NPHASE, 0, grid, stream);
}
```

```cpp
#define ATTN_PHASE_BODY { if (wave >= 4) __builtin_amdgcn_s_setprio(1);     \
    for (int u = gw; u < 2048; u += NGW) for (int i = 0; i < 2; ++i) { const int bh = u >> 5, a = u & 31; mla_wave_unit(Qb, KT, VT, OMLA, bh, i == 0 ? 63 - a : a); } \
      \
      \
    { LAS int* ctr_ = (LAS int*)(lds + LDSCTL_OFF + 4096) + 2 * l; \
      for (;;) { int t_ = 0; if (lane_id() == 0) t_ = __atomic_fetch_add(ctr_, 1, __ATOMIC_RELAXED); t_ = __builtin_amdgcn_readfirstlane(t_); \
        const int k_ = vcu + t_ * G; \
        if (k_ < WI_LATE) { WItem s; wdecode(wi_late(k_), in, l, ws, s); tr_item(s, scr, lane_id()); } \
        else if (k_ < WI_LATE + 48) wr_item(in[15] + (size_t)l * 1024 * 4, in[17] + (size_t)l * 1024 * 32, (bf16*)(ws + WS_WR), k_ - WI_LATE, lane_id()); \
        else break; } \
      for (;;) { int t_ = 0; if (lane_id() == 0) t_ = __atomic_fetch_add(ctr_ + 1, 1, __ATOMIC_RELAXED); t_ = __builtin_amdgcn_readfirstlane(t_); \
        if (t_ >= 16) break; \
        const int u = vcu * 16 + t_; sb_wave_unit(SBQ, SBKT, SBVT, OSB, u >> 6, u & 63); } } \
    __builtin_amdgcn_s_setprio(0); }
#include <hip/hip_runtime.h>
#include <stdint.h>
#include <stdio.h>

#define DI __device__ __forceinline__
typedef unsigned short bf16;
typedef unsigned u32x4 __attribute__((ext_vector_type(4)));
typedef unsigned u32x2 __attribute__((ext_vector_type(2)));
typedef float f32x4 __attribute__((ext_vector_type(4)));
typedef float f32x2 __attribute__((ext_vector_type(2)));
typedef __bf16 bf16x2_t __attribute__((ext_vector_type(2)));

constexpr int D = 1024, NBATCH = 8, SEQ = 4096, M = NBATCH * SEQ, DEPTH = 2;
constexpr int CONVW = 512, QRANK = 256, KVRANK = 128, NH = 8;
constexpr int OFF_CQ = 1536, OFF_CKV = 1792, OFF_KR = 1920, OFF_SB = 1952, OFF_GATE = 3488, IN_COLS = 6560;
constexpr int NEXP = 32, NGRP = 4, EPG = 8, DEXP = 256;
constexpr int NA = 3584;
constexpr int MOE_ROWS = 73728;
constexpr float EPS = 1e-6f;
constexpr int XRP = 2048;
constexpr float LOG2E = 1.4426950408889634f;
constexpr float QSCALE_MLA = 0.10206207261596575f * LOG2E;
constexpr float QSCALE_SB = 0.125f * LOG2E;

constexpr size_t MiB = 1u << 20;
constexpr size_t WS_CTL = 0;
constexpr size_t WS_TOKSLOT = 1 * MiB;
constexpr size_t WS_TOKW = 1 * MiB + 512 * 1024;
constexpr size_t WS_LIST = 2 * MiB;
constexpr size_t WS_CS = 6 * MiB;
constexpr size_t WS_SSQ = 10 * MiB;
constexpr size_t WS_SSQ2 = 12 * MiB;
constexpr size_t WS_GB = 14 * MiB;
constexpr size_t WS_WA = 16 * MiB;
constexpr size_t WS_WG = 23 * MiB;
constexpr size_t WS_WUQ = 29 * MiB;
constexpr size_t WS_WUKV = 29 * MiB + 512 * 1024;
constexpr size_t WS_WOC = 30 * MiB, WS_WOM = 31 * MiB, WS_WOS = 32 * MiB;
constexpr size_t WS_WO = 33 * MiB;
constexpr size_t WS_WR = 35 * MiB;
constexpr size_t WS_WGU = 36 * MiB;
constexpr size_t WS_WD = 68 * MiB;
constexpr size_t WS_XN8 = 84 * MiB;
constexpr size_t WS_XN = 116 * MiB;
constexpr size_t WS_ACONV = 116 * MiB;
constexpr size_t WS_SBQ = 180 * MiB, WS_SBKT = 212 * MiB, WS_SBVT = 244 * MiB;
constexpr size_t WS_KT = 276 * MiB;
constexpr size_t WS_Q = 324 * MiB;
constexpr size_t WS_VT = 372 * MiB;
constexpr size_t WS_U = 404 * MiB, WS_BG = 436 * MiB;
constexpr size_t WS_CQ = 468 * MiB, WS_CKV = 484 * MiB;
constexpr size_t WS_OMLA = 436 * MiB, WS_OSB = 468 * MiB;
constexpr size_t WS_GATES = 180 * MiB;
constexpr size_t WS_MERGED = 372 * MiB;
constexpr size_t WS_H2 = 180 * MiB;
constexpr size_t WS_ACT = 244 * MiB;
constexpr size_t WS_Y = 280 * MiB;
constexpr size_t WS_END = 500 * MiB;
constexpr int CW_CNT = 32768;

DI float bf2f(unsigned h) { return __uint_as_float(h << 16); }
DI unsigned pk2(float lo, float hi) { f32x2 v = {lo, hi}; bf16x2_t b = __builtin_convertvector(v, bf16x2_t); return __builtin_bit_cast(unsigned, b); }
DI u32x4 pk8(const float (&v)[8]) { u32x4 w; w.x = pk2(v[0], v[1]); w.y = pk2(v[2], v[3]); w.z = pk2(v[4], v[5]); w.w = pk2(v[6], v[7]); return w; }
DI void unpk8(u32x4 w, float (&v)[8]) { v[0] = bf2f(w.x & 0xffffu); v[1] = bf2f(w.x >> 16); v[2] = bf2f(w.y & 0xffffu); v[3] = bf2f(w.y >> 16);
    v[4] = bf2f(w.z & 0xffffu); v[5] = bf2f(w.z >> 16); v[6] = bf2f(w.w & 0xffffu); v[7] = bf2f(w.w >> 16); }
DI int lane_id() { int l; asm volatile("v_mbcnt_lo_u32_b32 %0, -1, 0\n\tv_mbcnt_hi_u32_b32 %0, -1, %0" : "=v"(l)); return l; }
DI float shfl_xor_l(float v, int o, int lane) { return __int_as_float(__builtin_amdgcn_ds_bpermute((lane ^ o) << 2, __float_as_int(v))); }
DI float wave_sum(float v) { const int l = lane_id();
#pragma unroll
    for (int o = 1; o < 64; o <<= 1) v += shfl_xor_l(v, o, l);
    return v;
}
DI size_t vt8_idx(int bh, int key, int d) { const int k = key & 63, k5 = k & 31, hi = (k5 >> 2) & 1, sl = (k >> 5) * 16 + (k5 & 3) + 4 * (k5 >> 3);
    return (((((size_t)bh * (SEQ / 64) + (key >> 6)) * 2 + (d >> 5)) * 32 + (d & 31)) * 2 + hi) * 32 + sl; }
DI size_t kt8_idx(int bh, int key, int d) { return ((((size_t)bh * (SEQ / 64) + (key >> 6)) * 3 + (d >> 5)) * 64 + (key & 63)) * 32 + (d & 31); }
template <int NCH> DI size_t kt_idx(int bh, int key, int chunk) { return ((((size_t)bh * (SEQ / 64) + (key >> 6)) * NCH + chunk) * 64 + (key & 63)) * 8; }
DI size_t vt_idx(int bh, int key, int d) {
    const int k = key & 63;
    return ((size_t)bh * (SEQ / 64) + (key >> 6)) * 4096 + (size_t)((((((k >> 5) * 2 + ((k >> 4) & 1)) * 2 + (d >> 5)) * 32 + (d & 31)) * 2 + ((k >> 2) & 1)) * 8 + ((k >> 3) & 1) * 4 + (k & 3));
}

DI bool moe_locate(const unsigned* cnt, int tile, int& e, int& i, int& rowbase) {
    int acc = 0;
    for (int k = 0; k < NEXP; ++k) { const int n = (int)((cnt[k * 64] + 255u) >> 8); if (tile < acc + n) { e = k; i = tile - acc; rowbase = acc * 256; return true; } acc += n; }
    return false;
}
DI int moe_base(const unsigned* cnt, int e) { int acc = 0; for (int k = 0; k < e; ++k) acc += (int)((cnt[k * 64] + 255u) >> 8); return acc * 256; }

struct WItem { const float* W; int ldw, K, src, perm; const float* gain; bf16* dst; int kb; int f8; };
constexpr unsigned PH1_F8MASK = 0x3fc0u;
constexpr int WI_A = (NA / 32) * 16, WI_G = 96 * 16, WI_UQ = 24 * 4, WI_UKV = 32 * 2, WI_OUT = 32 * 8, WI_O = 32 * 16, WI_GU = NEXP * 16 * 16, WI_D = NEXP * 32 * 4;
constexpr int WI_TOTAL = WI_A + WI_G + WI_UQ + WI_UKV + 3 * WI_OUT + WI_O + WI_GU + WI_D;
constexpr int WI_EARLY = WI_A + WI_UQ + WI_UKV, WI_LATE = WI_TOTAL - WI_EARLY;
DI int wi_early(int k) { return k < WI_A ? k : k + WI_G; }
DI int wi_late(int k) { return k < WI_G ? WI_A + k : k + WI_A + WI_UQ + WI_UKV; }
DI void wdecode(int it, const float* const* in, int l, unsigned char* ws, WItem& s) {
    const float* w_in = in[3] + (size_t)l * 1024 * IN_COLS;
    s.perm = 0; s.gain = nullptr; s.f8 = 0;
    if (it < WI_A) { const int nb = it >> 4; s.kb = it & 15; s.W = w_in; s.ldw = IN_COLS; s.K = 1024; s.dst = (bf16*)(ws + WS_WA) + (size_t)nb * 32 * 1024;
        if ((PH1_F8MASK >> (nb >> 3)) & 1u) { s.f8 = 1; s.dst = (bf16*)(ws + WS_WA + (size_t)(nb >> 3) * 524288 + (size_t)(nb & 7) * 32 * 1024); }
        if (nb < 32) { const int T = nb >> 3, w = nb & 7; s.src = (w < 4) ? 128 * T + 32 * w : 1024 + 128 * T + 32 * (w - 4); }
        else if (nb < 48) s.src = 512 + 32 * (nb - 32);
        else if (nb < 96) s.src = OFF_SB + 32 * (nb - 48);
        else if (nb < 104) s.src = OFF_CQ + 32 * (nb - 96);
        else if (nb < 108) s.src = OFF_CKV + 32 * (nb - 104);
        else if (nb == 108) { s.src = OFF_KR; s.perm = 1; }
        else s.src = -1;
        return; }
    it -= WI_A;
    if (it < WI_G) { const int nb = it >> 4; s.kb = it & 15; s.W = w_in; s.ldw = IN_COLS; s.K = 1024; s.src = OFF_GATE + 32 * nb; s.f8 = 1; s.dst = (bf16*)(ws + WS_WG + (size_t)nb * 32 * 1024); return; }
    it -= WI_G;
    if (it < WI_UQ) { const int nb = it >> 2; s.kb = it & 3; s.W = in[9] + (size_t)l * 256 * 768; s.ldw = 768; s.K = 256; s.gain = in[7] + l * 256; const int h = nb / 3, part = nb % 3;
        s.src = h * 96 + part * 32; s.perm = (part == 2); s.dst = (bf16*)(ws + WS_WUQ) + (size_t)nb * 32 * 256; return; }
    it -= WI_UQ;
    if (it < WI_UKV) { const int nb = it >> 1; s.kb = it & 1; s.W = in[10] + (size_t)l * 128 * 1024; s.ldw = 1024; s.K = 128; s.gain = in[8] + l * 128;
        s.src = (nb < 16) ? (nb >> 1) * 128 + (nb & 1) * 32 : ((nb - 16) >> 1) * 128 + 64 + (nb & 1) * 32; s.dst = (bf16*)(ws + WS_WUKV) + (size_t)nb * 32 * 128; return; }
    it -= WI_UKV;
    for (int j = 0; j < 3; ++j) { if (it < WI_OUT) { const int nb = it >> 3; s.kb = it & 7; s.W = (j == 0 ? in[6] : j == 1 ? in[11] : in[12]) + (size_t)l * 512 * 1024; s.ldw = 1024; s.K = 512; s.src = 32 * nb; s.f8 = 2;
            s.dst = (bf16*)(ws + (j == 0 ? WS_WOC : j == 1 ? WS_WOM : WS_WOS)) + (size_t)nb * 32 * 512;
            if (j) { s.f8 = 1; s.dst = (bf16*)(ws + (j == 1 ? WS_WOM : WS_WOS) + (size_t)nb * 32 * 512); }
            return; } it -= WI_OUT; }
    if (it < WI_O) { const int nb = it >> 4; s.kb = it & 15; s.W = in[13] + (size_t)l * 1024 * 1024; s.ldw = 1024; s.K = 1024; s.src = 32 * nb; s.dst = (bf16*)(ws + WS_WO) + (size_t)nb * 32 * 1024; return; }
    it -= WI_O;
    if (it < WI_GU) { const int e = it >> 8, r = it & 255, nb = r >> 4; s.kb = r & 15; const int pn = nb >> 3, w = nb & 7;
        s.W = (w < 4 ? in[19] : in[20]) + ((size_t)l * NEXP + e) * 1024 * 256; s.ldw = 256; s.K = 1024; s.src = 128 * pn + 32 * (w & 3); s.f8 = 1; s.dst = (bf16*)(ws + WS_WGU + ((size_t)e * 512 + nb * 32) * 1024); return; }
    it -= WI_GU;
    { const int e = it >> 7, r = it & 127, nb = r >> 2; s.kb = r & 3; s.W = in[21] + ((size_t)l * NEXP + e) * 256 * 1024; s.ldw = 1024; s.K = 256; s.src = 32 * nb; s.f8 = 1; s.dst = (bf16*)(ws + WS_WD + ((size_t)e * 1024 + nb * 32) * 256); }
}
DI void wr_item(const float* wrg, const float* wre, bf16* WR, int r, int lane) {
    const int tile = r >> 4, g4 = (r & 15) >> 2, j = r & 3; const float* W = tile == 0 ? wrg + j : wre + 8 * g4 + (tile == 2 ? 4 : 0) + j; const int ld = tile == 0 ? 4 : 32;
    for (int k = lane; k < 1024; k += 64) WR[(size_t)r * 1024 + k] = (bf16)(pk2(W[(size_t)k * ld], 0.f) & 0xffffu);
}
template <class FP> DI void tr_item(const WItem& s, FP scr, int lane) {
    const int k0 = 64 * s.kb, c4 = (lane & 7) * 4;
    f32x4 w[8];
#pragma unroll
    for (int i = 0; i < 8; ++i) { const int kk = 8 * i + (lane >> 3);
        w[i] = (s.src >= 0) ? *(const f32x4*)(s.W + (size_t)(k0 + kk) * s.ldw + s.src + c4) : (f32x4){0.f, 0.f, 0.f, 0.f}; }
#pragma unroll
    for (int i = 0; i < 8; ++i) { const int kk = 8 * i + (lane >> 3); f32x4 x = w[i]; if (s.gain) x = x * s.gain[k0 + kk];
#pragma unroll
        for (int e = 0; e < 4; ++e) { const int sc = c4 + e, c = s.perm ? ((sc & 15) * 2 + (sc >> 4)) : sc; scr[kk * 33 + c] = x[e]; } }
    asm volatile("s_waitcnt lgkmcnt(0)" ::: "memory");
    if (s.f8 == 1) {
        const int n = lane >> 1, kh = lane & 1; unsigned w[8];
#pragma unroll
        for (int q = 0; q < 8; ++q) { const auto* p = scr + (kh * 32 + 4 * q) * 33 + n; unsigned x = 0u;
            x = __builtin_amdgcn_cvt_pk_fp8_f32(p[0] * 64.0f, p[33] * 64.0f, x, false); x = __builtin_amdgcn_cvt_pk_fp8_f32(p[66] * 64.0f, p[99] * 64.0f, x, true); w[q] = x; }
        unsigned char* d = (unsigned char*)s.dst + (size_t)n * s.K + k0 + kh * 32;
        *(u32x4*)d = (u32x4){w[0], w[1], w[2], w[3]}; *(u32x4*)(d + 16) = (u32x4){w[4], w[5], w[6], w[7]};
        asm volatile("s_waitcnt lgkmcnt(0)" ::: "memory"); return;
    }
    const int c8 = lane & 7; const float sc = s.f8 == 2 ? 1.0f / 255.0f : 1.0f;
#pragma unroll
    for (int j = 0; j < 4; ++j) { const int n = (lane >> 3) + 8 * j; const auto* p = scr + (8 * c8) * 33 + n;
        u32x4 o; o.x = pk2(p[0 * 33] * sc, p[1 * 33] * sc); o.y = pk2(p[2 * 33] * sc, p[3 * 33] * sc); o.z = pk2(p[4 * 33] * sc, p[5 * 33] * sc); o.w = pk2(p[6 * 33] * sc, p[7 * 33] * sc);
        *(u32x4*)(s.dst + (size_t)n * s.K + k0 + 8 * c8) = o; }
    asm volatile("s_waitcnt lgkmcnt(0)" ::: "memory");
}
DI void rms_row(const float* xrow, const float* g, bf16* orow, float* fout, int lane) {
    const f32x4* xr = (const f32x4*)xrow + lane; const f32x4* gr = (const f32x4*)g + lane;
    f32x4 v[4]; float s = 0.f;
#pragma unroll
    for (int j = 0; j < 4; ++j) { v[j] = xr[64 * j]; s += (v[j].x * v[j].x + v[j].y * v[j].y) + (v[j].z * v[j].z + v[j].w * v[j].w); }
    const float rstd = 1.0f / sqrtf(wave_sum(s) * (1.f / D) + EPS);
#pragma unroll
    for (int j = 0; j < 4; ++j) { const f32x4 gg = gr[64 * j]; const f32x4 y = v[j] * rstd * gg;
        if (orow) { u32x2 o; o.x = pk2(y.x, y.y); o.y = pk2(y.z, y.w); ((u32x2*)orow)[lane + 64 * j] = o; }
        if (fout) ((f32x4*)fout)[lane + 64 * j] = y; }
}
DI unsigned pk4_fp8(f32x4 y) { unsigned w = 0u; w = __builtin_amdgcn_cvt_pk_fp8_f32(y.x, y.y, w, false); w = __builtin_amdgcn_cvt_pk_fp8_f32(y.z, y.w, w, true); return w; }
template <int NR> DI void rms_rowsN(const float* x, const float* g, bf16* out, unsigned char* out8, int row0, int lane) {
    f32x4 v[NR][4];
#pragma unroll
    for (int i = 0; i < NR; ++i)
#pragma unroll
        for (int j = 0; j < 4; ++j) v[i][j] = ((const f32x4*)(x + (size_t)(row0 + i) * D))[lane + 64 * j];
    f32x4 gg[4];
#pragma unroll
    for (int j = 0; j < 4; ++j) gg[j] = ((const f32x4*)g)[lane + 64 * j];
#pragma unroll
    for (int i = 0; i < NR; ++i) { float s = 0.f;
#pragma unroll
        for (int j = 0; j < 4; ++j) s += (v[i][j].x * v[i][j].x + v[i][j].y * v[i][j].y) + (v[i][j].z * v[i][j].z + v[i][j].w * v[i][j].w);
        const float rstd = 1.0f / sqrtf(wave_sum(s) * (1.f / D) + EPS);
#pragma unroll
        for (int j = 0; j < 4; ++j) { const f32x4 y = v[i][j] * rstd * gg[j]; u32x2 o; o.x = pk2(y.x, y.y); o.y = pk2(y.z, y.w); ((u32x2*)(out + (size_t)(row0 + i) * D))[lane + 64 * j] = o;
            ((unsigned*)(out8 + (size_t)(row0 + i) * D))[lane + 64 * j] = pk4_fp8(y); } }
}
DI void cs_rows4(const int* positions, float2* CS, int row0, int lane) {
    const int row = row0 + (lane >> 4), i = lane & 15; const float freq = powf(10000.0f, -(float)i / 16.0f); const float ang = (float)positions[row] * freq; const double a = (double)ang;
    CS[(size_t)row * 16 + i] = make_float2((float)cos(a), (float)sin(a));
}

struct EpiWinA {
    static constexpr int TAIL = 8;
    bf16 *U, *BG, *SBQ, *SBKT, *SBVT, *CQ, *CKV, *KT; float* SSQ; const float2* CS;
    DI bool is_pair(int pn) const { return pn < 4; }
    DI float rowctx(int) const { return 0.f; }
    DI void pair(int row, int col0, const float (&a)[8], const float (&b)[8], float) const {
        const int T = col0 >> 8, c = col0 & 255; float u[8];
        const float sc = ((PH1_F8MASK >> T) & 1u) ? 1.0f / 4096.0f : 1.0f;
#pragma unroll
        for (int j = 0; j < 8; ++j) u[j] = a[j] * b[j] * sc;
        *(u32x4*)(U + (size_t)row * 512 + 128 * T + c) = pk8(u);
    }
    struct Pre {}; DI Pre pre(int, int, int) const { return Pre{}; }
    static constexpr bool ROWSTAT = true;
    DI bool wants_stat(int pn) const { return pn >= 12; }
    DI void rowstat(int row, int pn, int wc, float tot) const { SSQ[(size_t)row * 8 + (pn == 12 ? 0 : 4) + wc] = tot; }
    DI float operator()(int row, int col0, const float (&v_)[8], float, int, const Pre&) const {
        const int b = row / SEQ, t = row % SEQ; float ret = 0.f; float v[8]; const float sc = ((PH1_F8MASK >> (col0 >> 8)) & 1u) ? 1.0f / 64.0f : 1.0f;
#pragma unroll
        for (int j = 0; j < 8; ++j) v[j] = v_[j] * sc;
        if (col0 < 1536) { *(u32x4*)(BG + (size_t)row * 512 + (col0 - 1024)) = pk8(v); }
        else if (col0 < 2048) { float q[8];
#pragma unroll
            for (int j = 0; j < 8; ++j) q[j] = v[j] * QSCALE_SB;
            *(u32x4*)(SBQ + (size_t)row * 512 + (col0 - 1536)) = pk8(q); }
        else if (col0 < 2560) { const int c = col0 - 2048, h = c >> 6, d = c & 63; *(u32x4*)(SBKT + kt_idx<8>(b * 8 + h, t, d >> 3)) = pk8(v); }
        else if (col0 < 3072) { const int c = col0 - 2560, h = c >> 6, d = c & 63;
#pragma unroll
            for (int j = 0; j < 8; ++j) SBVT[vt_idx(b * 8 + h, t, d + j)] = (bf16)(pk2(v[j], 0.f) & 0xffffu); }
        else if (col0 < 3328) { const int c = col0 - 3072; *(u32x4*)(CQ + (size_t)row * 256 + c) = pk8(v); float s = 0.f;
#pragma unroll
            for (int j = 0; j < 8; ++j) s += v[j] * v[j];
            ret = s; }
        else { const int c = col0 - 3328;
            if (c < 128) { *(u32x4*)(CKV + (size_t)row * 128 + c) = pk8(v); float s = 0.f;
#pragma unroll
                for (int j = 0; j < 8; ++j) s += v[j] * v[j];
                ret = s; }
            else if (c < 160) { const int i0 = (c - 128) >> 1; float r[8];
#pragma unroll
                for (int j = 0; j < 4; ++j) { const float2 cs = CS[(size_t)row * 16 + i0 + j]; const float x1 = v[2 * j], x2 = v[2 * j + 1]; r[2 * j] = x1 * cs.x - x2 * cs.y; r[2 * j + 1] = x2 * cs.x + x1 * cs.y; }
                u32x2 w; w.x = pk4_fp8((f32x4){r[0], r[1], r[2], r[3]}); w.y = pk4_fp8((f32x4){r[4], r[5], r[6], r[7]});
#pragma unroll
                for (int h = 0; h < NH; ++h) *(u32x2*)((unsigned char*)KT + kt8_idx(b * 8 + h, t, 64 + (c - 128))) = w; }
        }
        return ret;
    }
};
struct EpiQ {
    static constexpr int TAIL = 16;
    bf16* Q; const float* SSQ; const float2* CS;
    DI bool is_pair(int) const { return false; }
    DI void pair(int, int, const float (&)[8], const float (&)[8], float) const {}
    static constexpr bool ROWSTAT = false;
    DI bool wants_stat(int) const { return false; }
    DI void rowstat(int, int, int, float) const {}
    DI float rowctx(int row) const { const f32x4 x = *(const f32x4*)(SSQ + (size_t)row * 8); return 1.0f / sqrtf(((x.x + x.y) + (x.z + x.w)) * (1.f / 256.f) + EPS); }
    struct Pre { float2 cs[4]; };
    DI Pre pre(int row, int col0, int) const { Pre p; const int dd = col0 % 96; if (dd >= 64) { const int i0 = (dd - 64) >> 1;
#pragma unroll
            for (int j = 0; j < 4; ++j) p.cs[j] = CS[(size_t)row * 16 + i0 + j]; } else {
#pragma unroll
            for (int j = 0; j < 4; ++j) p.cs[j] = make_float2(1.f, 0.f); }
        return p; }
    DI float operator()(int row, int col0, const float (&v)[8], float rstd, int, const Pre& P) const {
        const int dd = col0 % 96; float r[8];
#pragma unroll
        for (int j = 0; j < 8; ++j) r[j] = v[j] * rstd;
        if (dd >= 64) {
#pragma unroll
            for (int j = 0; j < 4; ++j) { const float2 cs = P.cs[j]; const float x1 = r[2 * j], x2 = r[2 * j + 1]; r[2 * j] = x1 * cs.x - x2 * cs.y; r[2 * j + 1] = x2 * cs.x + x1 * cs.y; } }
#pragma unroll
        for (int j = 0; j < 8; ++j) r[j] *= QSCALE_MLA;
        { u32x2 w; w.x = pk4_fp8((f32x4){r[0], r[1], r[2], r[3]}); w.y = pk4_fp8((f32x4){r[4], r[5], r[6], r[7]}); *(u32x2*)((unsigned char*)Q + (size_t)row * 768 + col0) = w; }
        return 0.f;
    }
};
struct EpiKV {
    static constexpr int TAIL = 16;
    bf16 *KT, *VT; const float* SSQ;
    DI bool is_pair(int) const { return false; }
    DI void pair(int, int, const float (&)[8], const float (&)[8], float) const {}
    static constexpr bool ROWSTAT = false;
    DI bool wants_stat(int) const { return false; }
    DI void rowstat(int, int, int, float) const {}
    DI float rowctx(int row) const { const f32x4 x = *(const f32x4*)(SSQ + (size_t)row * 8 + 4); return 1.0f / sqrtf(((x.x + x.y) + (x.z + x.w)) * (1.f / 128.f) + EPS); }
    struct Pre {}; DI Pre pre(int, int, int) const { return Pre{}; }
    DI float operator()(int row, int col0, const float (&v)[8], float rstd, int, const Pre&) const {
        const int b = row / SEQ, t = row % SEQ; float r[8];
#pragma unroll
        for (int j = 0; j < 8; ++j) r[j] = v[j] * rstd;
        if (col0 < 512) { const int h = col0 >> 6, d = col0 & 63; u32x2 w; w.x = pk4_fp8((f32x4){r[0], r[1], r[2], r[3]}); w.y = pk4_fp8((f32x4){r[4], r[5], r[6], r[7]});
            *(u32x2*)((unsigned char*)KT + kt8_idx(b * 8 + h, t, d)) = w; }
        else { const int c = col0 - 512, h = c >> 6, d = c & 63; const unsigned w0 = pk4_fp8((f32x4){r[0], r[1], r[2], r[3]}), w1 = pk4_fp8((f32x4){r[4], r[5], r[6], r[7]});
#pragma unroll
            for (int j = 0; j < 8; ++j) ((unsigned char*)VT)[vt8_idx(b * 8 + h, t, d + j)] = (unsigned char)(((j < 4 ? w0 : w1) >> (8 * (j & 3))) & 0xffu); }
        return 0.f;
    }
};
struct EpiGate8 {
    static constexpr int TAIL = 16;
    unsigned char* GATES; const float* bgate;
    DI bool is_pair(int) const { return false; }
    DI void pair(int, int, const float (&)[8], const float (&)[8], float) const {}
    DI float rowctx(int) const { return 0.f; }
    static constexpr bool ROWSTAT = false;
    DI bool wants_stat(int) const { return false; }
    DI void rowstat(int, int, int, float) const {}
    struct Pre {}; DI Pre pre(int, int, int) const { return Pre{}; }
    DI float operator()(int row, int col0, const float (&v)[8], float, int br, const Pre&) const {
        float r[8]; const float* bg = bgate + br * 1024 + col0;
#pragma unroll
        for (int j = 0; j < 8; ++j) r[j] = __builtin_amdgcn_rcpf(__builtin_amdgcn_exp2f(__builtin_fmaf(v[j], -1.4426950408889634f / 64.0f, bg[j])) + 1.0f / 255.0f);
        u32x2 w; w.x = __builtin_amdgcn_cvt_pk_u8_f32(r[0], 0, 0u); w.x = __builtin_amdgcn_cvt_pk_u8_f32(r[1], 1, w.x); w.x = __builtin_amdgcn_cvt_pk_u8_f32(r[2], 2, w.x); w.x = __builtin_amdgcn_cvt_pk_u8_f32(r[3], 3, w.x);
        w.y = __builtin_amdgcn_cvt_pk_u8_f32(r[4], 0, 0u); w.y = __builtin_amdgcn_cvt_pk_u8_f32(r[5], 1, w.y); w.y = __builtin_amdgcn_cvt_pk_u8_f32(r[6], 2, w.y); w.y = __builtin_amdgcn_cvt_pk_u8_f32(r[7], 3, w.y);
        *(u32x2*)(GATES + (size_t)row * 3072 + br * 1024 + col0) = w; return 0.f; }
};
template <bool F8> struct EpiY3 {
    static constexpr int TAIL = 16;
    const unsigned char* GATES; bf16* MERGED;
    DI bool is_pair(int) const { return false; }
    DI void pair(int, int, const float (&)[8], const float (&)[8], float) const {}
    DI float rowctx(int) const { return 0.f; }
    static constexpr bool ROWSTAT = false;
    DI bool wants_stat(int) const { return false; }
    DI void rowstat(int, int, int, float) const {}
    struct Pre { u32x2 g; u32x4 m; };
    DI Pre pre(int row, int col0, int br) const { Pre p; p.g = *(const u32x2*)(GATES + (size_t)row * 3072 + br * 1024 + col0); p.m = (u32x4){0u, 0u, 0u, 0u};
        if (br) p.m = *(const u32x4*)(MERGED + (size_t)row * 1024 + col0); return p; }
    DI float operator()(int row, int col0, const float (&v)[8], float, int, const Pre& P) const {
        float g[8], m[8]; unpk8(P.m, m);
#pragma unroll
        for (int j = 0; j < 4; ++j) { g[j] = (float)((P.g.x >> (8 * j)) & 0xffu); g[4 + j] = (float)((P.g.y >> (8 * j)) & 0xffu); }
#pragma unroll
        for (int j = 0; j < 8; ++j) m[j] += g[j] * (F8 ? v[j] * (1.0f / (1024.0f * 255.0f)) : v[j]);
        *(u32x4*)(MERGED + (size_t)row * 1024 + col0) = pk8(m); return 0.f; }
};
struct EpiWo {
    static constexpr int TAIL = 16;
    const float* xin; bf16* XRB; float* SSQ2;
    DI bool is_pair(int) const { return false; }
    DI void pair(int, int, const float (&)[8], const float (&)[8], float) const {}
    DI float rowctx(int) const { return 0.f; }
    static constexpr bool ROWSTAT = true;
    DI bool wants_stat(int) const { return true; }
    DI void rowstat(int row, int pn, int wc, float tot) const { SSQ2[(size_t)row * 16 + pn * 4 + wc] = tot; }
    struct Pre { f32x4 a, b; };
    DI Pre pre(int row, int col0, int) const { Pre p;
        if (xin) { p.a = *(const f32x4*)(xin + (size_t)row * 1024 + col0); p.b = *(const f32x4*)(xin + (size_t)row * 1024 + col0 + 4); }
        else { float t[8]; unpk8(*(const u32x4*)(XRB + (size_t)row * XRP + col0), t); p.a = (f32x4){t[0], t[1], t[2], t[3]}; p.b = (f32x4){t[4], t[5], t[6], t[7]}; }
        return p; }
    DI float operator()(int row, int col0, const float (&v)[8], float, int, const Pre& P) const {
        const float r[8] = {P.a.x + v[0], P.a.y + v[1], P.a.z + v[2], P.a.w + v[3], P.b.x + v[4], P.b.y + v[5], P.b.z + v[6], P.b.w + v[7]};
        *(u32x4*)(XRB + (size_t)row * XRP + col0) = pk8(r); float q = 0.f;
#pragma unroll
        for (int j = 0; j < 8; ++j) q += r[j] * r[j];
        return q; }
};
struct EpiGU {
    static constexpr int TAIL = 8;
    bf16* ACT;
    DI bool is_pair(int) const { return true; }
    DI float rowctx(int) const { return 0.f; }
    static constexpr bool ROWSTAT = false;
    DI bool wants_stat(int) const { return false; }
    DI void rowstat(int, int, int, float) const {}
    struct Pre {}; DI Pre pre(int, int, int) const { return Pre{}; }
    DI float operator()(int, int, const float (&)[8], float, int, const Pre&) const { return 0.f; }
    DI void pair(int row, int col0, const float (&a)[8], const float (&b)[8], float) const { const int pn = col0 >> 8, c = col0 & 255; float r[8];
#pragma unroll
        for (int j = 0; j < 8; ++j) { const float g = a[j] * (1.0f / 64.0f), u = b[j] * (1.0f / 64.0f); r[j] = g / (1.0f + __expf(-g)) * u; }
        u32x2 w; w.x = pk4_fp8((f32x4){r[0], r[1], r[2], r[3]} * 16.0f); w.y = pk4_fp8((f32x4){r[4], r[5], r[6], r[7]} * 16.0f);
        *(u32x2*)((unsigned char*)ACT + (size_t)row * 256 + 128 * pn + c) = w; }
};
struct EpiDown {
    static constexpr int TAIL = 16;
    bf16* Y;
    DI bool is_pair(int) const { return false; }
    DI void pair(int, int, const float (&)[8], const float (&)[8], float) const {}
    DI float rowctx(int) const { return 0.f; }
    static constexpr bool ROWSTAT = false;
    DI bool wants_stat(int) const { return false; }
    DI void rowstat(int, int, int, float) const {}
    struct Pre {}; DI Pre pre(int, int, int) const { return Pre{}; }
    DI float operator()(int row, int col0, const float (&v)[8], float, int, const Pre&) const { float r[8];
#pragma unroll
        for (int j = 0; j < 8; ++j) r[j] = v[j] * (1.0f / 1024.0f);
        *(u32x4*)(Y + (size_t)row * 1024 + col0) = pk8(r); return 0.f; }
};

DI void conv_item(const bf16* U, const bf16* BG, const float* cw, bf16* ACONV, int row, int c8) {
    const int t = row % SEQ, c = c8 * 8; float u0[8], u1[8], u2[8], bg[8], r[8];
    unpk8(*(const u32x4*)(U + (size_t)row * 512 + c), u2);
    if (t >= 1) unpk8(*(const u32x4*)(U + (size_t)(row - 1) * 512 + c), u1); else {
#pragma unroll
        for (int j = 0; j < 8; ++j) u1[j] = 0.f; }
    if (t >= 2) unpk8(*(const u32x4*)(U + (size_t)(row - 2) * 512 + c), u0); else {
#pragma unroll
        for (int j = 0; j < 8; ++j) u0[j] = 0.f; }
    unpk8(*(const u32x4*)(BG + (size_t)row * 512 + c), bg);
#pragma unroll
    for (int j = 0; j < 8; ++j) r[j] = bg[j] * (cw[c + j] * u0[j] + cw[512 + c + j] * u1[j] + cw[1024 + c + j] * u2[j]);
    *(u32x4*)(ACONV + (size_t)row * 512 + c) = pk8(r);
}
DI void conv_items4(const bf16* U, const bf16* BG, const float* cw, bf16* ACONV, int row0, int rstep, int c8) {
    const int c = c8 * 8; u32x4 r2[4], r1[4], r0[4], rb[4];
#pragma unroll
    for (int k = 0; k < 4; ++k) { const int row = row0 + k * rstep, t = row % SEQ;
        r2[k] = *(const u32x4*)(U + (size_t)row * 512 + c); r1[k] = (t >= 1) ? *(const u32x4*)(U + (size_t)(row - 1) * 512 + c) : (u32x4){0u, 0u, 0u, 0u};
        r0[k] = (t >= 2) ? *(const u32x4*)(U + (size_t)(row - 2) * 512 + c) : (u32x4){0u, 0u, 0u, 0u}; rb[k] = *(const u32x4*)(BG + (size_t)row * 512 + c); }
    float w0[8], w1[8], w2[8];
#pragma unroll
    for (int j = 0; j < 8; ++j) { w0[j] = cw[c + j]; w1[j] = cw[512 + c + j]; w2[j] = cw[1024 + c + j]; }
#pragma unroll
    for (int k = 0; k < 4; ++k) { float u0[8], u1[8], u2[8], bg[8], r[8]; unpk8(r0[k], u0); unpk8(r1[k], u1); unpk8(r2[k], u2); unpk8(rb[k], bg);
#pragma unroll
        for (int j = 0; j < 8; ++j) r[j] = bg[j] * (w0[j] * u0[j] + w1[j] * u1[j] + w2[j] * u2[j]);
        *(u32x4*)(ACONV + (size_t)(row0 + k * rstep) * 512 + c) = pk8(r); }
}
DI int moe_base_lanes(const unsigned* cnt, int lane) {
    int v = lane < NEXP ? (int)((cnt[lane * 64] + 255u) >> 8) * 256 : 0; const int own = v;
#pragma unroll
    for (int d = 1; d < 32; d <<= 1) { const int t = __builtin_amdgcn_ds_bpermute((lane - d) << 2, v); if ((lane & 31) >= d) v += t; }
    return v - own;
}
DI void t2_rows4(float* OUT, bf16* XRB, const bf16* Y, int baseL, const int4* TS, const float2* TW, const float* gnext, bf16* XN, unsigned char* XN8, int final_, int row0, int lane) {
    int4 ts[4]; float2 tw[4];
#pragma unroll
    for (int i = 0; i < 4; ++i) { ts[i] = TS[row0 + i]; tw[i] = TW[row0 + i]; }
    f32x4 v[4][4]; u32x2 p[4][4], q[4][4], xb[4][4];
#pragma unroll
    for (int i = 0; i < 4; ++i) {
        const size_t a1 = (size_t)__builtin_amdgcn_readlane(baseL, __builtin_amdgcn_readfirstlane(ts[i].x)) + ts[i].y, a2 = (size_t)__builtin_amdgcn_readlane(baseL, __builtin_amdgcn_readfirstlane(ts[i].z)) + ts[i].w;
        const u32x2* xr = (const u32x2*)(XRB + (size_t)(row0 + i) * XRP) + lane; const u32x2* y1 = (const u32x2*)(Y + a1 * 1024) + lane; const u32x2* y2 = (const u32x2*)(Y + a2 * 1024) + lane;
#pragma unroll
        for (int j = 0; j < 4; ++j) { xb[i][j] = xr[64 * j]; p[i][j] = y1[64 * j]; q[i][j] = y2[64 * j]; }
    }
    const f32x4* gr = (const f32x4*)gnext + lane; f32x4 gg[4];
#pragma unroll
    for (int j = 0; j < 4; ++j) gg[j] = gr[64 * j];
#pragma unroll
    for (int i = 0; i < 4; ++i) { float s = 0.f;
#pragma unroll
        for (int j = 0; j < 4; ++j) { f32x4& x = v[i][j]; const u32x2 pp = p[i][j], qq = q[i][j], xx = xb[i][j]; const float w1 = tw[i].x, w2 = tw[i].y;
            x = (f32x4){bf2f(xx.x & 0xffffu), bf2f(xx.x >> 16), bf2f(xx.y & 0xffffu), bf2f(xx.y >> 16)};
            x.x += w1 * bf2f(pp.x & 0xffffu) + w2 * bf2f(qq.x & 0xffffu); x.y += w1 * bf2f(pp.x >> 16) + w2 * bf2f(qq.x >> 16);
            x.z += w1 * bf2f(pp.y & 0xffffu) + w2 * bf2f(qq.y & 0xffffu); x.w += w1 * bf2f(pp.y >> 16) + w2 * bf2f(qq.y >> 16);
            s += (x.x * x.x + x.y * x.y) + (x.z * x.z + x.w * x.w); }
        const float rstd = 1.0f / sqrtf(wave_sum(s) * (1.f / D) + EPS);
        f32x4* xo = (f32x4*)(OUT + (size_t)(row0 + i) * D) + lane; u32x2* xs = (u32x2*)(XRB + (size_t)(row0 + i) * XRP) + lane; u32x2* xn = (u32x2*)(XN + (size_t)(row0 + i) * D) + lane;
#pragma unroll
        for (int j = 0; j < 4; ++j) { const f32x4 y = v[i][j] * rstd * gg[j];
            if (final_) xo[64 * j] = y; else { { u32x2 o2; o2.x = pk2(v[i][j].x, v[i][j].y); o2.y = pk2(v[i][j].z, v[i][j].w); xs[64 * j] = o2; } u32x2 o; o.x = pk2(y.x, y.y); o.y = pk2(y.z, y.w); xn[64 * j] = o; ((unsigned*)(XN8 + (size_t)(row0 + i) * D))[lane + 64 * j] = pk4_fp8(y); } }
    }
}
typedef float f32x16 __attribute__((ext_vector_type(16)));
typedef short s16x8 __attribute__((ext_vector_type(8)));
typedef short s16x4 __attribute__((ext_vector_type(4)));
DI int crow(int r, int hi) { return (r & 3) + 8 * (r >> 2) + 4 * hi; }
DI float max2f(float a, float b) { float r; asm("v_max_f32_e32 %0, %1, %2" : "=v"(r) : "v"(a), "v"(b)); return r; }
DI float add2f(float a, float b) { float r = a + b; asm("" : "+v"(r)); return r; }
DI float rowmax16(const f32x16& s) { float r;
    asm("s_nop 15\n\ts_nop 7\n\tv_max3_f32 %0, %1, %2, %3\n\tv_max3_f32 %0, %0, %4, %5\n\tv_max3_f32 %0, %0, %6, %7\n\tv_max3_f32 %0, %0, %8, %9\n\tv_max3_f32 %0, %0, %10, %11\n\tv_max3_f32 %0, %0, %12, %13\n\tv_max3_f32 %0, %0, %14, %15\n\tv_max_f32_e32 %0, %0, %16"
        : "=&v"(r) : "v"(s[0]), "v"(s[1]), "v"(s[2]), "v"(s[3]), "v"(s[4]), "v"(s[5]), "v"(s[6]), "v"(s[7]), "v"(s[8]), "v"(s[9]), "v"(s[10]), "v"(s[11]), "v"(s[12]), "v"(s[13]), "v"(s[14]), "v"(s[15]));
    return r; }
DI float xhalf(float x, int hi) {
    auto rr = __builtin_amdgcn_permlane32_swap(__float_as_uint(x), __float_as_uint(x), false, false);
    return __uint_as_float(hi ? rr[0] : rr[1]);
}
template <int NCH> struct KFrag { s16x8 k[NCH / 2]; };
struct VFrag { s16x8 v[2][2]; };
template <int NCH> DI void k_load(KFrag<NCH>& f, const bf16* KT, int bh, int kb, int r32, int hi) {
    const bf16* kp = KT + ((((size_t)bh * (SEQ / 64) + (kb >> 6)) * NCH) * 64 + (kb & 63) + r32) * 8;
#pragma unroll
    for (int d0 = 0; d0 < NCH / 2; ++d0) f.k[d0] = *(const s16x8*)(kp + (size_t)(2 * d0 + hi) * 512);
}
DI void v_load(VFrag& f, const bf16* VT, int bh, int kb, int r32, int hi) {
    const bf16* vp = VT + ((size_t)bh * (SEQ / 64) + (kb >> 6)) * 4096 + ((kb & 63) >> 5) * 2048 + (size_t)r32 * 16 + hi * 8;
#pragma unroll
    for (int s = 0; s < 2; ++s)
#pragma unroll
        for (int dh = 0; dh < 2; ++dh) f.v[s][dh] = *(const s16x8*)(vp + (s * 2 + dh) * 512);
}
typedef int v8i_t __attribute__((ext_vector_type(8))); typedef int v4i_t __attribute__((ext_vector_type(4)));
DI v8i_t ld32(const unsigned char* p) { const v4i_t a = *(const v4i_t*)p, b = *(const v4i_t*)(p + 16); return __builtin_shufflevector(a, b, 0, 1, 2, 3, 4, 5, 6, 7); }
DI void k_load8(v8i_t (&f)[2], const bf16* KT, int bh, int kb, int r32, int hi) {
    const unsigned char* kp = (const unsigned char*)KT + (((size_t)bh * (SEQ / 64) + (kb >> 6)) * 3 * 64 + (kb & 63) + r32) * 32;
    f[0] = ld32(kp + (size_t)hi * 2048); f[1] = ld32(kp + 2 * 2048);
}
DI f32x16 att_qk8(const v8i_t (&k)[2], const v8i_t (&q)[2], const f32x16& c) {
    f32x16 sc = __builtin_amdgcn_mfma_scale_f32_32x32x64_f8f6f4(k[0], q[0], c, 0, 0, 0, 0, 0, 0);
    return __builtin_amdgcn_mfma_scale_f32_32x32x64_f8f6f4(k[1], q[1], sc, 0, 0, 0, 0, 0, 0);
}
template <int ND0> DI f32x16 att_qk(const s16x8 (&k)[ND0], const s16x8 (&q)[ND0]) {
    f32x16 sc;
#pragma unroll
    for (int r = 0; r < 16; ++r) sc[r] = 0.f;
#pragma unroll
    for (int d0 = 0; d0 < ND0; ++d0) sc = __builtin_amdgcn_mfma_f32_32x32x16_bf16(k[d0], q[d0], sc, 0, 0, 0);
    return sc;
}
DI void att_pack(const float (&p)[16], s16x8 (&pf)[2]) {
#pragma unroll
    for (int s = 0; s < 2; ++s) { u32x4 w; w.x = pk2(p[8 * s], p[8 * s + 1]); w.y = pk2(p[8 * s + 2], p[8 * s + 3]); w.z = pk2(p[8 * s + 4], p[8 * s + 5]); w.w = pk2(p[8 * s + 6], p[8 * s + 7]); pf[s] = __builtin_bit_cast(s16x8, w); }
}
DI void att_pv(f32x16& o0, f32x16& o1, const VFrag& vf, const s16x8 (&pf)[2]) {
#pragma unroll
    for (int s = 0; s < 2; ++s) {
        o0 = __builtin_amdgcn_mfma_f32_32x32x16_bf16(vf.v[s][0], pf[s], o0, 0, 0, 0);
        o1 = __builtin_amdgcn_mfma_f32_32x32x16_bf16(vf.v[s][1], pf[s], o1, 0, 0, 0);
    }
}
DI void att_mask_diag(f32x16& s, int q0, int hi) {
    int Ls = 4 * hi - q0; asm volatile("" : "+v"(Ls));
#pragma unroll
    for (int r = 0; r < 16; ++r) if (Ls > -((r & 3) + 8 * (r >> 2))) s[r] = -INFINITY;
}
constexpr float MLA_PMAX8 = 256.0f;
DI void v_load8(v8i_t (&f)[2], const bf16* VT, int bh, int T, int r32, int hi) {
    const unsigned char* vp = (const unsigned char*)VT + ((((size_t)bh * (SEQ / 64) + T) * 2 * 32 + r32) * 2 + hi) * 32;
    f[0] = ld32(vp); f[1] = ld32(vp + 32 * 64);
}
template <bool INIT> DI void att_exps16(const f32x16& sc, v8i_t& w, int wofs, float (&q)[4]) {
#pragma unroll
    for (int r = 0; r < 16; r += 4) { const float a0 = __builtin_amdgcn_exp2f(sc[r]), a1 = __builtin_amdgcn_exp2f(sc[r + 1]), a2 = __builtin_amdgcn_exp2f(sc[r + 2]), a3 = __builtin_amdgcn_exp2f(sc[r + 3]);
        if (INIT && r == 0) { q[0] = a0; q[1] = a1; q[2] = a2; q[3] = a3; } else { q[0] = add2f(q[0], a0); q[1] = add2f(q[1], a1); q[2] = add2f(q[2], a2); q[3] = add2f(q[3], a3); }
        w[wofs + (r >> 2)] = (int)pk4_fp8((f32x4){a0, a1, a2, a3}); }
}
template <int J> DI void mla_sub64(const v8i_t (&kA)[2], const v8i_t (&kB)[2], const v8i_t (&qf)[2], f32x16& nm, float& l, f32x16& o0, f32x16& o1, v8i_t& pw, bool diag, bool first, int r32, int hi) {
    float ps;
    auto halves = [&]() { float q[4];
        { f32x16 sa = att_qk8(kA, qf, nm); if (J == 0 && diag) att_mask_diag(sa, r32, hi); att_exps16<true>(sa, pw, 0, q); }
        if (J == 0 && diag) {
#pragma unroll
            for (int i = 4; i < 8; ++i) pw[i] = 0; }
        else { f32x16 sb = att_qk8(kB, qf, nm); if (J == 1 && diag) att_mask_diag(sb, r32, hi); att_exps16<false>(sb, pw, 4, q); }
        ps = add2f(add2f(q[0], q[1]), add2f(q[2], q[3])); };
    halves();
    if (first || __builtin_amdgcn_ballot_w64(!(ps <= MLA_PMAX8)) != 0ull) {
        float tm;
        { f32x16 sa = att_qk8(kA, qf, nm); if (J == 0 && diag) att_mask_diag(sa, r32, hi); tm = rowmax16(sa); }
        if (!(J == 0 && diag)) { f32x16 sb = att_qk8(kB, qf, nm); if (J == 1 && diag) att_mask_diag(sb, r32, hi); tm = max2f(tm, rowmax16(sb)); }
        tm = max2f(tm, xhalf(tm, hi));
        const float d = first ? tm : max2f(tm, 0.f), alpha = first ? 1.0f : __builtin_amdgcn_exp2f(-d);
        l *= alpha;
#pragma unroll
        for (int r = 0; r < 16; ++r) { o0[r] *= alpha; o1[r] *= alpha; nm[r] -= d; }
        halves();
    }
    l = add2f(l, ps);
}
DI void mla_wave_unit(const bf16* Q, const bf16* KT, const bf16* VT, bf16* O, int bh, int qblk) {
    const int lane = lane_id();
    const int b = bh >> 3, h = bh & 7, r32 = lane & 31, hi = lane >> 5;
    const int t0 = qblk * 64; const size_t row0 = (size_t)b * SEQ + t0 + r32;
    v8i_t qf[2][2];
#pragma unroll
    for (int j = 0; j < 2; ++j) { const unsigned char* qp = (const unsigned char*)Q + (row0 + 32 * j) * 768 + h * 96;
        qf[j][0] = ld32(qp + 32 * hi); const v8i_t t = ld32(qp + 64);
#pragma unroll
        for (int i = 0; i < 8; ++i) qf[j][1][i] = hi ? 0 : t[i]; }
    f32x16 o0[2], o1[2], nm[2]; float l[2];
#pragma unroll
    for (int j = 0; j < 2; ++j) { l[j] = 0.f;
#pragma unroll
        for (int r = 0; r < 16; ++r) { o0[j][r] = 0.f; o1[j][r] = 0.f; nm[j][r] = 0.f; } }
    v8i_t kA[2], kB[2], vf[2], pw;
    k_load8(kA, KT, bh, 0, r32, hi); k_load8(kB, KT, bh, 32, r32, hi); v_load8(vf, VT, bh, 0, r32, hi);
    for (int T = 0; T <= qblk; ++T) {
        const bool diag = T == qblk; const int Tn = T < SEQ / 64 - 1 ? T + 1 : T;
        mla_sub64<0>(kA, kB, qf[0], nm[0], l[0], o0[0], o1[0], pw, diag, T == 0, r32, hi);
        o0[0] = __builtin_amdgcn_mfma_scale_f32_32x32x64_f8f6f4(vf[0], pw, o0[0], 0, 0, 0, 0, 0, 0); o1[0] = __builtin_amdgcn_mfma_scale_f32_32x32x64_f8f6f4(vf[1], pw, o1[0], 0, 0, 0, 0, 0, 0);
        mla_sub64<1>(kA, kB, qf[1], nm[1], l[1], o0[1], o1[1], pw, diag, T == 0, r32, hi);
        k_load8(kA, KT, bh, 64 * Tn, r32, hi); k_load8(kB, KT, bh, 64 * Tn + 32, r32, hi);
        o0[1] = __builtin_amdgcn_mfma_scale_f32_32x32x64_f8f6f4(vf[0], pw, o0[1], 0, 0, 0, 0, 0, 0); o1[1] = __builtin_amdgcn_mfma_scale_f32_32x32x64_f8f6f4(vf[1], pw, o1[1], 0, 0, 0, 0, 0, 0);
        v_load8(vf, VT, bh, Tn, r32, hi);
    }
    int r32e = r32; asm volatile("" : "+v"(r32e));
    const size_t rowe = (size_t)b * SEQ + t0 + r32e;
#pragma unroll
    for (int j = 0; j < 2; ++j) {
        l[j] += xhalf(l[j], hi); const float inv = 16.0f / l[j];
        unsigned char* op = (unsigned char*)O + (rowe + 32 * j) * 512 + h * 64 + 4 * hi;
#pragma unroll
        for (int a = 0; a < 4; ++a) {
            *(unsigned*)(op + 8 * a) = pk4_fp8((f32x4){o0[j][4 * a], o0[j][4 * a + 1], o0[j][4 * a + 2], o0[j][4 * a + 3]} * inv);
            *(unsigned*)(op + 32 + 8 * a) = pk4_fp8((f32x4){o1[j][4 * a], o1[j][4 * a + 1], o1[j][4 * a + 2], o1[j][4 * a + 3]} * inv);
        }
    }
}
DI void sb_step(const f32x16& sc, float& R, s16x8 (&pf)[2], bool diag, int L, int d, int hi) {
    float p[16], z[16], sp[16];
#pragma unroll
    for (int r = 0; r < 16; ++r) { z[r] = sc[r]; sp[r] = __builtin_amdgcn_fmed3f(z[r], 0.f, INFINITY) + __builtin_amdgcn_logf(1.0f + __builtin_amdgcn_exp2f(-fabsf(z[r]))); }
    if (diag) { int Ls = L; asm volatile("" : "+v"(Ls));
#pragma unroll
        for (int r = 0; r < 16; ++r) if (!(Ls < d - ((r & 3) + 8 * (r >> 2)))) { sp[r] = 0.f; z[r] = -INFINITY; } }
    float g[4], og[4];
#pragma unroll
    for (int a = 0; a < 4; ++a) { g[a] = add2f(add2f(sp[4 * a], sp[4 * a + 1]), add2f(sp[4 * a + 2], sp[4 * a + 3])); og[a] = xhalf(g[a], hi); }
    float SA[4]; float run = 0.f;
#pragma unroll
    for (int a = 3; a >= 0; --a) { SA[a] = run + (hi ? 0.f : og[a]); run += g[a] + og[a]; }
#pragma unroll
    for (int a = 0; a < 4; ++a) { float suf = R - SA[a];
#pragma unroll
        for (int i = 3; i >= 0; --i) { const int r = 4 * a + i; suf -= sp[r]; p[r] = __builtin_amdgcn_exp2f(z[r] + suf); } }
    R -= run;
    att_pack(p, pf);
}
DI void sb_wave_unit(const bf16* Q, const bf16* KT, const bf16* VT, bf16* O, int bh, int qblk) {
    constexpr int NCH = 8, ND0 = 4; const int lane = lane_id();
    const int b = bh >> 3, h = bh & 7, r32 = lane & 31, hi = lane >> 5;
    const int t0 = qblk * 64; const size_t row0 = (size_t)b * SEQ + t0 + r32; const int L = 4 * hi - r32;
    s16x8 qf[2][ND0];
#pragma unroll
    for (int j = 0; j < 2; ++j)
#pragma unroll
        for (int d0 = 0; d0 < ND0; ++d0) qf[j][d0] = *(const s16x8*)(Q + (row0 + 32 * j) * 512 + h * 64 + d0 * 16 + hi * 8);
    f32x16 o0[2], o1[2]; float R[2] = {0.f, 0.f};
#pragma unroll
    for (int j = 0; j < 2; ++j)
#pragma unroll
        for (int r = 0; r < 16; ++r) { o0[j][r] = 0.f; o1[j][r] = 0.f; }
    KFrag<NCH> cur, nxt; VFrag vf; s16x8 pf[2];
    bool done0 = false, done1 = false;
    k_load<NCH>(cur, KT, bh, t0 + 32, r32, hi);
    for (int kb = t0 + 32; kb >= 0; kb -= 32) {
        v_load(vf, VT, bh, kb, r32, hi);
        k_load<NCH>(nxt, KT, bh, kb >= 32 ? kb - 32 : 0, r32, hi);
        f32x16 s0, s1;
        if (kb <= t0 && !done0) s0 = att_qk<ND0>(cur.k, qf[0]);
        if (!done1) s1 = att_qk<ND0>(cur.k, qf[1]);
        if (kb <= t0 && !done0) { sb_step(s0, R[0], pf, kb == t0, L, t0 - kb, hi); att_pv(o0[0], o1[0], vf, pf); done0 = __builtin_amdgcn_ballot_w64(R[0] >= -150.0f) == 0ull; }
        if (!done1) { sb_step(s1, R[1], pf, kb == t0 + 32, L, t0 + 32 - kb, hi); att_pv(o0[1], o1[1], vf, pf); done1 = __builtin_amdgcn_ballot_w64(R[1] >= -150.0f) == 0ull; }
        if (done0 && done1) break;
        cur = nxt;
    }
    int r32e = r32; asm volatile("" : "+v"(r32e));
    const size_t rowe = (size_t)b * SEQ + t0 + r32e;
#pragma unroll
    for (int j = 0; j < 2; ++j) {
        unsigned char* op = (unsigned char*)O + (rowe + 32 * j) * 512 + h * 64 + 4 * hi;
#pragma unroll
        for (int a = 0; a < 4; ++a) {
            *(unsigned*)(op + 8 * a) = pk4_fp8((f32x4){o0[j][4 * a], o0[j][4 * a + 1], o0[j][4 * a + 2], o0[j][4 * a + 3]} * 16.0f);
            *(unsigned*)(op + 32 + 8 * a) = pk4_fp8((f32x4){o1[j][4 * a], o1[j][4 * a + 1], o1[j][4 * a + 2], o1[j][4 * a + 3]} * 16.0f);
        }
    }
}
#define LAS __attribute__((address_space(3)))
namespace pg8 {
typedef short bf16x8 __attribute__((ext_vector_type(8)));
constexpr int BM = 256, BK = 64, HALF = 128, HTB = HALF * BK * 2, STAGE_BYTES = 8 * HTB, NXCD = 8, WGM = 8;
DI int lds_byte(int r, int c) { const int st = (r >> 4) * 2 + (c >> 5), rr = r & 15, cc = c & 31, ob = rr * 64 + cc * 2; return st * 1024 + (ob ^ (((ob >> 9) & 1) << 5)); }
DI void stage_rc(int b, int& R, int& C) { const int st = b / 1024, sb = b % 1024, swz = sb ^ (((sb >> 9) & 1) << 5); R = (st >> 1) * 16 + swz / 64; C = (st & 1) * 32 + (swz % 64) / 2; }
typedef int pg8_v8i __attribute__((ext_vector_type(8))); typedef int pg8_v4i __attribute__((ext_vector_type(4)));
DI pg8_v8i pg8_cat(bf16x8 lo, bf16x8 hi) { const pg8_v4i a = __builtin_bit_cast(pg8_v4i, lo), b = __builtin_bit_cast(pg8_v4i, hi); return __builtin_shufflevector(a, b, 0, 1, 2, 3, 4, 5, 6, 7); }
DI int perm32(int rho) { const int n = rho >> 4, i = rho & 15; return 8 * (i >> 2) + 4 * n + (i & 3); }
struct Unit { const char* a; const char* b; const int* gl; int row0, col0, pn, nvalid, K, aux; };
struct DenseOrder {
    const char *A, *B; int nM, nN, nwg, G, c, K;
    DI void init(const void* A_, const void* B_, int Mrows, int N, int K_, int G_, int c_) { A = (const char*)A_; B = (const char*)B_; nM = Mrows / BM; nN = N / BM; nwg = nM * nN; G = G_; c = c_; K = K_; }
    DI bool next(int i, Unit& u) const {
        const long L = (long)i * G + c; if (L >= nwg) return false;
        int wgid = (int)L; { const int q = nwg / NXCD, r = nwg % NXCD, xcd = wgid % NXCD, off = wgid / NXCD; wgid = (xcd < r ? xcd * (q + 1) : r * (q + 1) + (xcd - r) * q) + off; }
        const int nig = WGM * nN, gid = wgid / nig, fm = gid * WGM, gsz = (nM - fm) < WGM ? (nM - fm) : WGM;
        const int pm = fm + ((wgid % nig) % gsz), pn = (wgid % nig) / gsz;
        u.a = A + (size_t)pm * BM * K * 2; u.b = B + (size_t)pn * BM * K * 2; u.gl = nullptr; u.row0 = pm * BM; u.col0 = pn * BM; u.pn = pn; u.nvalid = 256; u.K = K; u.aux = 0; return true;
    }
};
template <unsigned MASK> struct MaskedDense {
    DenseOrder T;
    DI void init(const void* A_, const void* B_, int Mrows, int K_, int G_, int c_) { asm volatile("" : "+s"(c_));
        T.init(A_, B_, Mrows, __builtin_popcount(MASK) * BM, K_, G_, c_); }
    DI bool next(int i, Unit& u) const {
        if (!T.next(i, u)) return false;
        unsigned m = MASK; for (int j = 0; j < u.pn; ++j) m &= m - 1u;
        const int p = __builtin_ctz(m); u.b = T.B + (size_t)p * 524288; u.col0 = p * BM; u.pn = p; return true;
    }
};
template <bool GATHER> struct GroupedOrder {
    LAS int* tbl;
    const char* A; const char* B; const int* LIST; int K, NCT, brows, G, c;
    DI void init_lanes(const unsigned* cnt, int lane) {
        const int n = lane < NEXP ? (int)cnt[lane * 64] : 0; int v = (n + 255) >> 8; const int own = v;
#pragma unroll
        for (int d = 1; d < 32; d <<= 1) { const int t = __builtin_amdgcn_ds_bpermute((lane - d) << 2, v); if ((lane & 31) >= d) v += t; }
        tbl[lane] = lane < NEXP ? v - own : 0x7fffffff; tbl[64 + lane] = n; asm volatile("s_waitcnt lgkmcnt(0)" ::: "memory");
    }
    DI bool next(int i, Unit& u) const {
        const int L = i * G + c, rt = L / NCT, pn = L % NCT;
        const int ln = lane_id(), startL = tbl[ln], cntL = tbl[64 + ln];
        const unsigned long long mk = __builtin_amdgcn_ballot_w64(startL <= rt); const int e = 63 - __builtin_clzll(mk | 1ull);
        const int st = __builtin_amdgcn_readlane(startL, e), ne = __builtin_amdgcn_readlane(cntL, e), ti = rt - st;
        if (ti * BM >= ne) return false;
        u.row0 = rt * BM; u.col0 = pn * BM; u.pn = pn; u.K = K; u.aux = 0; u.b = B + ((size_t)e * brows + pn * BM) * K * 2;
        if (GATHER) { u.a = A; u.gl = LIST + (size_t)e * M + ti * BM; const int rem = ne - ti * BM; u.nvalid = rem < BM ? rem : BM; }
        else { u.a = A + (size_t)rt * BM * K * 2; u.gl = nullptr; u.nvalid = 256; }
        return true;
    }
};
template <int KIND, int BR0 = 0, int NBR = 3> struct BranchOrder {
    DenseOrder T; const char* ws;
    DI bool next(int i, Unit& u) const {
        Unit t; if (!T.next(i / NBR, t)) return false; const int br = BR0 + i % NBR; const int pm = t.row0 / BM, pn = t.pn;
        u = t; u.aux = br; u.K = KIND == 2 ? 256 : 512;
        if (KIND == 0) { u.a = ws + WS_XN8 + (size_t)pm * BM * 1024; u.b = ws + WS_WG + ((size_t)br * 1024 + pn * BM) * 1024; }
        else if (KIND == 2) { u.a = ws + (br == 1 ? WS_OMLA : WS_OSB) + (size_t)pm * BM * 512; u.b = ws + (br == 1 ? WS_WOM : WS_WOS) + (size_t)pn * BM * 512; }
        else { const size_t ao = br == 0 ? WS_ACONV : br == 1 ? WS_OMLA : WS_OSB, wo = br == 0 ? WS_WOC : br == 1 ? WS_WOM : WS_WOS;
            u.a = ws + ao + (size_t)pm * BM * 512 * 2; u.b = ws + wo + (size_t)pn * BM * 512 * 2; }
        return true;
    }
};
template <class E> struct EpiAdapt {
    static constexpr int TAIL = E::TAIL;
    E e;
    DI void operator()(const f32x4 (&acc)[2][2][4][2], const Unit& u, int wid) const {
        const int ln_ = lane_id(), fr = ln_ & 15, fq = ln_ >> 4, wr = wid >> 2, wc = wid & 3;
        const bool pr = e.is_pair(u.pn);
#pragma unroll
        for (int ai = 0; ai < 2; ++ai) {
            if (pr) {
#pragma unroll
                for (int m = 0; m < 4; ++m) {
                    int row = u.row0 + ai * HALF + wr * 64 + m * 16 + fr; asm volatile("" : "+v"(row));
                    float a[8], b[8];
#pragma unroll
                    for (int j = 0; j < 4; ++j) { a[j] = acc[ai][0][m][0][j]; a[4 + j] = acc[ai][0][m][1][j]; b[j] = acc[ai][1][m][0][j]; b[4 + j] = acc[ai][1][m][1][j]; }
                    e.pair(row, u.col0 + wc * 32 + 8 * fq, a, b, 0.f);
                }
            } else {
                typename E::Pre P[4][2]; float ctx[4]; int rows[4];
#pragma unroll
                for (int m = 0; m < 4; ++m) {
                    int row = u.row0 + ai * HALF + wr * 64 + m * 16 + fr; asm volatile("" : "+v"(row)); rows[m] = row; ctx[m] = e.rowctx(row);
#pragma unroll
                    for (int bj = 0; bj < 2; ++bj) P[m][bj] = e.pre(row, u.col0 + bj * HALF + wc * 32 + 8 * fq, u.aux);
                }
#pragma unroll
                for (int m = 0; m < 4; ++m) { float part = 0.f;
#pragma unroll
                    for (int bj = 0; bj < 2; ++bj) { float v[8];
#pragma unroll
                        for (int j = 0; j < 4; ++j) { v[j] = acc[ai][bj][m][0][j]; v[4 + j] = acc[ai][bj][m][1][j]; }
                        part += e(rows[m], u.col0 + bj * HALF + wc * 32 + 8 * fq, v, ctx[m], u.aux, P[m][bj]); }
                    if (E::ROWSTAT && e.wants_stat(u.pn)) { const int ln = fr | (fq << 4); part += shfl_xor_l(part, 16, ln); part += shfl_xor_l(part, 32, ln); if (fq == 0) e.rowstat(rows[m], u.pn, wc, part); }
                }
            }
            asm volatile("" ::: "memory");
        }
    }
};
template <class Epi, class Sched, bool GATHER, bool VARK = false, bool FP8 = false, bool RELAX = true>
DI void gemm_phase(LAS unsigned char* lds, const int wid_in, const int K0, const Sched& S, const Epi& E) {
    int wid = wid_in; asm volatile("" : "+s"(wid));
    const int lane = lane_id(), tid = wid * 64 + lane, wr = wid >> 2, wc = wid & 3, fr = lane & 15, fq = lane >> 4;
    const size_t kstep = (size_t)(BK * 2);
    const unsigned ldsw = (unsigned)wid * 1024u;
    const int aoff = FP8 ? lds_byte(wr * 64 + fr, fq * 16) : lds_byte(wr * 64 + fr, fq * 8), boff = FP8 ? lds_byte(wc * 32 + fr, fq * 16) : lds_byte(wc * 32 + fr, fq * 8);
    LAS unsigned char* pa_ = lds + aoff; LAS unsigned char* pb_ = lds + 4 * HTB + boff; asm volatile("" : "+v"(pa_), "+v"(pb_));
#define PG8_SA(b, h) (((b) * 2 + (h)) * HTB)
#define PG8_SB(b, h) ((4 + (b) * 2 + (h)) * HTB)
#define PG8_STAGE_B(bufoff, gbase, vb) do { _Pragma("unroll") for (int _i = 0; _i < 2; ++_i) { unsigned _o = (vb)[_i]; asm volatile("" : "+v"(_o));   \
        __builtin_amdgcn_global_load_lds((const unsigned*)((const char*)(gbase) + _o), (LAS unsigned*)(lds + (bufoff) + ldsw + _i * 8192), 16, 0, 0); } } while (0)
#define PG8_STAGE_A(bufoff, gbase, vo, h, hs) do { _Pragma("unroll") for (int _i = 0; _i < 2; ++_i) { unsigned _o = (vo)[GATHER ? (h) : 0][_i]; asm volatile("" : "+v"(_o)); \
        __builtin_amdgcn_global_load_lds((const unsigned*)((const char*)(gbase) + (GATHER ? (size_t)0 : (size_t)(h) * (hs)) + _o), (LAS unsigned*)(lds + (bufoff) + ldsw + _i * 8192), 16, 0, 0); } } while (0)
#define PG8_SETVO(vo, vb, u, KK) do { int RA[2], CA[2]; { const int _t = wid * 64 + lane_id();     \
        _Pragma("unroll") for (int _i = 0; _i < 2; ++_i) { int _R, _C; stage_rc(_t * 16 + _i * 8192, _R, _C); RA[_i] = _R; CA[_i] = _C; vb[_i] = (unsigned)(((_R & ~31) + perm32(_R & 31)) * (KK) + _C) * 2u; } } \
        _Pragma("unroll") for (int _h = 0; _h < (GATHER ? 2 : 1); ++_h) _Pragma("unroll") for (int _i = 0; _i < 2; ++_i) { const int _r = _h * HALF + RA[_i]; \
        if (GATHER) { const int _tok = (_r < (u).nvalid) ? (u).gl[_r] : 0; vo[_h][_i] = (unsigned)(_tok * (KK) + CA[_i]) * 2u; } else vo[_h][_i] = (unsigned)(_r * (KK) + CA[_i]) * 2u; } } while (0)
#define PG8_LDA(dst, b, h) do { if (FP8) { _Pragma("unroll") for (int m = 0; m < 4; ++m) dst##8[m] = pg8_cat(*(const LAS bf16x8*)(pa_ + PG8_SA(b, h) + m * 2048), *(const LAS bf16x8*)(pa_ + PG8_SA(b, h) + m * 2048 + 16)); } \
        else { _Pragma("unroll") for (int m = 0; m < 4; ++m) _Pragma("unroll") for (int k = 0; k < 2; ++k) dst[m][k] = *(const LAS bf16x8*)(pa_ + PG8_SA(b, h) + m * 2048 + k * 1024); } } while (0)
#define PG8_LDB(dst, b, h) do { if (FP8) { _Pragma("unroll") for (int n = 0; n < 2; ++n) dst##8[n] = pg8_cat(*(const LAS bf16x8*)(pb_ + PG8_SA(b, h) + n * 2048), *(const LAS bf16x8*)(pb_ + PG8_SA(b, h) + n * 2048 + 16)); } \
        else { _Pragma("unroll") for (int n = 0; n < 2; ++n) _Pragma("unroll") for (int k = 0; k < 2; ++k) dst[n][k] = *(const LAS bf16x8*)(pb_ + PG8_SA(b, h) + n * 2048 + k * 1024); } } while (0)
#define PG8_MMA(ai, bj, At, Bt) do { __builtin_amdgcn_s_setprio(1); _Pragma("unroll") for (int m = 0; m < 4; ++m) _Pragma("unroll") for (int n = 0; n < 2; ++n) { \
        if (FP8) acc[ai][bj][m][n] = __builtin_amdgcn_mfma_scale_f32_16x16x128_f8f6f4(Bt##8[n], At##8[m], acc[ai][bj][m][n], 0, 0, 0, 0, 0, 0); \
        else { _Pragma("unroll") for (int k = 0; k < 2; ++k) acc[ai][bj][m][n] = __builtin_amdgcn_mfma_f32_16x16x32_bf16(Bt[n][k], At[m][k], acc[ai][bj][m][n], 0, 0, 0); } } \
        __builtin_amdgcn_s_setprio(0); } while (0)
#define PG8_WAIT_V(n) asm volatile("s_waitcnt vmcnt(" #n ")" ::: "memory")
#define PG8_WAIT_R() do { if (rel) asm volatile("s_waitcnt vmcnt(%0)" :: "n"(8 + Epi::TAIL) : "memory"); else asm volatile("s_waitcnt vmcnt(8)" ::: "memory"); } while (0)
#define PG8_WAIT_L(n) asm volatile("s_waitcnt lgkmcnt(" #n ")" ::: "memory")
#define PG8_BAR __builtin_amdgcn_s_barrier()
#define PG8_SCHED __builtin_amdgcn_sched_barrier(0)
    Unit cur, nxt; int ui = 0;
    if (!S.next(0, cur)) return;
    f32x4 acc[2][2][4][2];
#pragma unroll
    for (int a = 0; a < 2; ++a)
#pragma unroll
        for (int b = 0; b < 2; ++b)
#pragma unroll
            for (int m = 0; m < 4; ++m)
#pragma unroll
                for (int n = 0; n < 2; ++n) acc[a][b][m][n] = (f32x4){0.f, 0.f, 0.f, 0.f};
    bf16x8 At[4][2], B0[2][2], B1[2][2]; pg8_v8i At8[4], B08[2], B18[2];
    unsigned voffA[GATHER ? 2 : 1][2], voffN[GATHER ? 2 : 1][2], voffB[2], voffBn[2];
    int kC = VARK ? cur.K : K0;
    PG8_SETVO(voffA, voffB, cur, kC);
    size_t hstep = (size_t)HALF * kC * 2;
    const char* cA = cur.a; const char* cB = cur.b;
    PG8_STAGE_B(PG8_SB(0, 0), cB, voffB); PG8_STAGE_B(PG8_SB(0, 1), cB + hstep, voffB); PG8_STAGE_A(PG8_SA(0, 0), cA, voffA, 0, hstep); PG8_STAGE_A(PG8_SA(0, 1), cA, voffA, 1, hstep);
    if (wr == 1) PG8_BAR;
    PG8_WAIT_V(2); PG8_BAR;
    PG8_STAGE_B(PG8_SB(1, 0), cB + kstep, voffB); PG8_STAGE_A(PG8_SA(1, 0), cA + kstep, voffA, 0, hstep); PG8_STAGE_B(PG8_SB(1, 1), cB + hstep + kstep, voffB); PG8_STAGE_A(PG8_SA(1, 1), cA + kstep, voffA, 1, hstep);
    PG8_WAIT_V(8); PG8_BAR;
    for (;;) {
        const bool has_next = S.next(ui + 1, nxt);
        const char* nA = has_next ? nxt.a : cA; const char* nB = has_next ? nxt.b : cB;
        const int kN = (VARK && has_next) ? nxt.K : kC; const size_t hstepN = (size_t)HALF * kN * 2;
        if (GATHER || VARK) { if (has_next) { PG8_SETVO(voffN, voffBn, nxt, kN); } else {
#pragma unroll
            for (int i = 0; i < 2; ++i) voffBn[i] = voffB[i];
#pragma unroll
            for (int h = 0; h < (GATHER ? 2 : 1); ++h)
#pragma unroll
                for (int i = 0; i < 2; ++i) voffN[h][i] = voffA[h][i]; } }
        const int nt = kC / BK;
#pragma unroll 1
        for (int t = 0; t < nt; t += 2) {
            const bool last = (t == nt - 2); const bool rel = RELAX && !GATHER && (ui > 0) && (t == 0);
            const char* a1 = cA + (size_t)(t + 1) * kstep;
            const char* a2 = last ? nA : cA + (size_t)(t + 2) * kstep; const char* b2 = last ? nB : cB + (size_t)(t + 2) * kstep;
            const char* a3 = a2 + kstep; const char* b3 = b2 + kstep;
            unsigned v2[GATHER ? 2 : 1][2], vb2[2]; const size_t h2 = (VARK && last) ? hstepN : hstep;
#pragma unroll
            for (int i = 0; i < 2; ++i) vb2[i] = (VARK && last) ? voffBn[i] : voffB[i];
#pragma unroll
            for (int h = 0; h < (GATHER ? 2 : 1); ++h)
#pragma unroll
                for (int i = 0; i < 2; ++i) v2[h][i] = ((GATHER || VARK) && last) ? voffN[h][i] : voffA[h][i];
            PG8_LDB(B0, 0, 0); PG8_LDB(B1, 0, 1); PG8_SCHED; PG8_LDA(At, 0, 0); if (t != 0) PG8_STAGE_A(PG8_SA(1, 1), a1, voffA, 1, hstep);
            PG8_WAIT_R(); PG8_WAIT_L(0); PG8_BAR; PG8_MMA(0, 0, At, B0); PG8_MMA(0, 1, At, B1); PG8_BAR; PG8_SCHED;
            PG8_LDA(At, 0, 1); PG8_STAGE_B(PG8_SB(0, 0), b2, vb2); PG8_STAGE_B(PG8_SB(0, 1), b2 + h2, vb2); PG8_STAGE_A(PG8_SA(0, 0), a2, v2, 0, h2);
            PG8_WAIT_R(); PG8_WAIT_L(0); PG8_BAR; PG8_MMA(1, 0, At, B0); PG8_MMA(1, 1, At, B1); PG8_BAR; PG8_SCHED;
            PG8_LDB(B0, 1, 0); PG8_LDB(B1, 1, 1); PG8_SCHED; PG8_LDA(At, 1, 0); PG8_STAGE_A(PG8_SA(0, 1), a2, v2, 1, h2);
            PG8_WAIT_R(); PG8_WAIT_L(0); PG8_BAR; PG8_MMA(0, 0, At, B0); PG8_MMA(0, 1, At, B1); PG8_BAR; PG8_SCHED;
            PG8_LDA(At, 1, 1); PG8_STAGE_B(PG8_SB(1, 0), b3, vb2); PG8_STAGE_B(PG8_SB(1, 1), b3 + h2, vb2); PG8_STAGE_A(PG8_SA(1, 0), a3, v2, 0, h2);
            PG8_WAIT_V(8); PG8_WAIT_L(0); PG8_BAR; PG8_MMA(1, 0, At, B0); PG8_MMA(1, 1, At, B1); PG8_BAR; PG8_SCHED;
        }
        if (has_next) { if (GATHER || VARK) PG8_STAGE_A(PG8_SA(1, 1), nA + kstep, voffN, 1, hstepN); else PG8_STAGE_A(PG8_SA(1, 1), nA + kstep, voffA, 1, hstep); }
        if (wr == 0) PG8_BAR;
        E(acc, cur, wid);
        if (!has_next) break;
#pragma unroll
        for (int a = 0; a < 2; ++a)
#pragma unroll
            for (int b = 0; b < 2; ++b)
#pragma unroll
                for (int m = 0; m < 4; ++m)
#pragma unroll
                    for (int n = 0; n < 2; ++n) acc[a][b][m][n] = (f32x4){0.f, 0.f, 0.f, 0.f};
        cur = nxt; cA = nA; cB = nB; ++ui;
        if (GATHER || VARK) {
#pragma unroll
        for (int i = 0; i < 2; ++i) voffB[i] = voffBn[i];
#pragma unroll
        for (int h = 0; h < (GATHER ? 2 : 1); ++h)
#pragma unroll
            for (int i = 0; i < 2; ++i) voffA[h][i] = voffN[h][i]; kC = kN; hstep = hstepN; }
        if (wr == 1) PG8_BAR;
    }
    PG8_WAIT_V(0);
    PG8_BAR;
#undef PG8_SA
#undef PG8_SB
#undef PG8_STAGE_A
#undef PG8_STAGE_B
#undef PG8_SETVO
#undef PG8_LDA
#undef PG8_LDB
#undef PG8_MMA
#undef PG8_WAIT_V
#undef PG8_WAIT_R
#undef PG8_WAIT_L
#undef PG8_BAR
#undef PG8_SCHED
}
}

#define XB_TMO      128
#define XB_XCNT(j)  (256  + 64 * (j))
#define XB_XSUB(j)  (1280 + 64 * (j))
#define XB_XGEN(j)  (2304 + 64 * (j))
#define XB_TOP      3328
#define XB_TOPGEN   3392
#define XCD_BAR_WORDS 3456
#define XB_SPIN_CAP (1u << 18)

__device__ __forceinline__ unsigned xb_ld(unsigned* p)              { return __hip_atomic_load(p, __ATOMIC_RELAXED, __HIP_MEMORY_SCOPE_AGENT); }
__device__ __forceinline__ unsigned xb_add(unsigned* p, unsigned v) { return __hip_atomic_fetch_add(p, v, __ATOMIC_RELAXED, __HIP_MEMORY_SCOPE_AGENT); }
__device__ __forceinline__ unsigned xb_xcc_id() { return (unsigned)__builtin_amdgcn_s_getreg((3 << 11) | 20) & 0xFu; }
#define XB_SPIN(cond, bar) do { unsigned _sp = 0; while (cond) { __builtin_amdgcn_s_sleep(1); \
    if ((++_sp & 255u) == 0u) { if (xb_ld(&(bar)[XB_TMO])) break; if (_sp > XB_SPIN_CAP) { atomicAdd(&(bar)[XB_TMO], 1u); break; } } } } while (0)

struct XcdBarrier {
    unsigned* bar; unsigned x;
    volatile LAS unsigned* st;
    int wave;
};

__device__ __forceinline__ XcdBarrier xcd_barrier_post(unsigned* bar, volatile LAS unsigned* st) {
    XcdBarrier b; b.bar = bar; b.x = xb_xcc_id(); b.st = st;
    if (threadIdx.x == 0) (void)xb_add(&bar[XB_XCNT(b.x)], 1u);
    return b;
}
__device__ __forceinline__ void xcd_barrier_complete(unsigned* bar, unsigned x, unsigned& nloc, unsigned& nx) {
    const unsigned G = gridDim.x * gridDim.y * gridDim.z;
    unsigned sum, cnt, mine, sp = 0u;
    for (;;) {
        sum = 0u; cnt = 0u; mine = 0u;
#pragma unroll
        for (unsigned j = 0; j < 16; ++j) { const unsigned c = xb_ld(&bar[XB_XCNT(j)]); sum += c; cnt += (c > 0u) ? 1u : 0u; }
        if (sum == G) { mine = xb_ld(&bar[XB_XCNT(x)]); break; }
        __builtin_amdgcn_s_sleep(1);
        if ((++sp & 255u) == 0u) { if (xb_ld(&bar[XB_TMO])) break; if (sp > XB_SPIN_CAP) { atomicAdd(&bar[XB_TMO], 1u); break; } }
    }
    nloc = mine > 0u ? mine : 1u; nx = cnt > 0u ? cnt : 1u;
}

__device__ __forceinline__ void xcd_barrier(const XcdBarrier& b) {
    asm volatile("s_waitcnt vmcnt(0)" ::: "memory");
    __syncthreads();
    if (b.wave == 0 && lane_id() == 0) {
        unsigned* bar = b.bar;
        __builtin_amdgcn_s_waitcnt(0);
        unsigned nloc = b.st[0], nx = b.st[1];
        if (nloc == 0u) { xcd_barrier_complete(bar, b.x, nloc, nx); b.st[0] = nloc; b.st[1] = nx; }
        const unsigned old = xb_add(&bar[XB_XSUB(b.x)], 1u);
        const unsigned gen = old / nloc;
        if (old + 1u == (gen + 1u) * nloc) {
            __builtin_amdgcn_fence(__ATOMIC_RELEASE, "agent");
            asm volatile("s_waitcnt vmcnt(0)" ::: "memory");
            const unsigned og = xb_add(&bar[XB_TOP], 1u);
            const unsigned tg = og / nx;
            if (og + 1u == (tg + 1u) * nx) xb_add(&bar[XB_TOPGEN], 1u);
            else XB_SPIN(xb_ld(&bar[XB_TOPGEN]) == tg, bar);
            __builtin_amdgcn_fence(__ATOMIC_ACQUIRE, "agent");
            xb_add(&bar[XB_XGEN(b.x)], 1u);
            asm volatile("s_waitcnt vmcnt(0)" ::: "memory");
        } else {
            XB_SPIN(xb_ld(&bar[XB_XGEN(b.x)]) == gen, bar);
            __builtin_amdgcn_fence(__ATOMIC_ACQUIRE, "agent");
            asm volatile("s_waitcnt vmcnt(0)" ::: "memory");
        }
    }
    __syncthreads();
}

constexpr int NWAVES = 8, RING_BYTES = 131072, LDSCTL_OFF = RING_BYTES, MISC_OFF = LDSCTL_OFF + 320, LDS_BYTES = 147456;
constexpr int CW_BAR = 4096;
constexpr int NPHASE = 1 + 9 * DEPTH;
struct Args { const float* in[23]; float* out; unsigned char* ws; int ph_lo, ph_hi, li, pad; };

typedef short s16x8r __attribute__((ext_vector_type(8)));
DI void t1_group(const bf16* XRB, const float* g, const bf16* WR, const float* brg, const float* bre, unsigned char* ws, int layer, int grp_, bool valid, int lane, int wave, LAS int* lcnt, LAS int* lbase) {
    const int grp = valid ? grp_ : 0;
    const int tok = lane & 15, kg = lane >> 4, row = grp * 16 + tok;
    const bf16* xr = XRB + (size_t)row * XRP + 8 * kg; float ss;
    { const f32x4 q = *(const f32x4*)((const float*)(ws + WS_SSQ2) + (size_t)row * 16 + 4 * kg); ss = (q.x + q.y) + (q.z + q.w); }
    ss += shfl_xor_l(ss, 16, lane); ss += shfl_xor_l(ss, 32, lane);
    const float rstd = 1.0f / sqrtf(ss * (1.f / D) + EPS);
    unsigned char* hrow = ws + WS_H2 + (size_t)row * D + 8 * kg;
    const bf16* wa = WR + (size_t)tok * 1024 + 8 * kg;
    f32x4 acc0 = {0.f, 0.f, 0.f, 0.f}, acc1 = acc0, acc2 = acc0;
#pragma unroll 16
    for (int ks = 0; ks < 32; ++ks) {
        float xt[8]; unpk8(*(const u32x4*)(xr + 32 * ks), xt); const f32x4 a = {xt[0], xt[1], xt[2], xt[3]}, b = {xt[4], xt[5], xt[6], xt[7]}, ga = *(const f32x4*)(g + 32 * ks + 8 * kg), gb = *(const f32x4*)(g + 32 * ks + 8 * kg + 4);
        u32x4 w; w.x = pk2(a.x * rstd * ga.x, a.y * rstd * ga.y); w.y = pk2(a.z * rstd * ga.z, a.w * rstd * ga.w); w.z = pk2(b.x * rstd * gb.x, b.y * rstd * gb.y); w.w = pk2(b.z * rstd * gb.z, b.w * rstd * gb.w);
        { u32x2 h8; h8.x = pk4_fp8((f32x4){a.x * rstd * ga.x, a.y * rstd * ga.y, a.z * rstd * ga.z, a.w * rstd * ga.w}); h8.y = pk4_fp8((f32x4){b.x * rstd * gb.x, b.y * rstd * gb.y, b.z * rstd * gb.z, b.w * rstd * gb.w});
          if (valid) *(u32x2*)(hrow + 32 * ks) = h8; }
        const s16x8r hf = __builtin_bit_cast(s16x8r, w);
        const s16x8r w0 = *(const s16x8r*)(wa + 32 * ks), w1 = *(const s16x8r*)(wa + 16 * 1024 + 32 * ks), w2 = *(const s16x8r*)(wa + 32 * 1024 + 32 * ks);
        acc0 = __builtin_amdgcn_mfma_f32_16x16x32_bf16(w0, hf, acc0, 0, 0, 0); acc1 = __builtin_amdgcn_mfma_f32_16x16x32_bf16(w1, hf, acc1, 0, 0, 0); acc2 = __builtin_amdgcn_mfma_f32_16x16x32_bf16(w2, hf, acc2, 0, 0, 0);
    }
    float gl[4]; int gi = 0;
#pragma unroll
    for (int e = 0; e < 4; ++e) gl[e] = acc0[e] + brg[e];
    float gm = gl[0];
#pragma unroll
    for (int e = 1; e < 4; ++e) if (gl[e] > gm) { gm = gl[e]; gi = e; }
    const bool pick = valid && kg == gi; int e1 = 0, e2 = 0, r1 = 0, r2 = 0; float w1 = 0.f, w2 = 0.f;
    if (pick) {
        float gs = 0.f;
#pragma unroll
        for (int e = 0; e < 4; ++e) gs += __expf(gl[e] - gm);
        const float gw = 1.0f / gs;
        float sel[8];
#pragma unroll
        for (int e = 0; e < 4; ++e) { sel[e] = acc1[e] + bre[8 * kg + e]; sel[4 + e] = acc2[e] + bre[8 * kg + 4 + e]; }
        int i1 = 0; float m1 = sel[0];
#pragma unroll
        for (int e = 1; e < 8; ++e) if (sel[e] > m1) { m1 = sel[e]; i1 = e; }
        int i2 = -1; float m2 = -INFINITY;
#pragma unroll
        for (int e = 0; e < 8; ++e) if (e != i1 && sel[e] > m2) { m2 = sel[e]; i2 = e; }
        const float r = __expf(m2 - m1); w1 = gw / (1.0f + r); w2 = gw * r / (1.0f + r);
        e1 = gi * 8 + i1; e2 = gi * 8 + i2;
        r1 = __atomic_fetch_add(lcnt + e1, 1, __ATOMIC_RELAXED); r2 = __atomic_fetch_add(lcnt + e2, 1, __ATOMIC_RELAXED);
    }
    __syncthreads();
    if (wave == 0 && lane < NEXP) { const int c = lcnt[lane]; unsigned* cnt = (unsigned*)(ws + WS_CTL) + CW_CNT + layer * 32 * 64;
        lbase[lane] = c ? (int)atomicAdd(cnt + lane * 64, (unsigned)c) : 0; lcnt[lane] = 0; }
    __syncthreads();
    if (pick) { const int s1 = lbase[e1] + r1, s2 = lbase[e2] + r2;
        int* LIST = (int*)(ws + WS_LIST); LIST[(size_t)e1 * M + s1] = row; LIST[(size_t)e2 * M + s2] = row;
        ((int4*)(ws + WS_TOKSLOT))[row] = make_int4(e1, s1, e2, s2); ((float2*)(ws + WS_TOKW))[row] = make_float2(w1, w2); }
}

__global__ void __launch_bounds__(NWAVES * 64, 2) mk_fwd(Args args) {
    extern __shared__ __attribute__((aligned(16))) unsigned char lds_raw[];
    LAS unsigned char* lds = (LAS unsigned char*)lds_raw;
    const int wave = __builtin_amdgcn_readfirstlane(threadIdx.x >> 6);
    const int G = gridDim.x; const int bx = blockIdx.x; const int vcu = (G % 8 == 0) ? (bx % 8) * (G / 8) + bx / 8 : bx;
    unsigned char* ws = args.ws; const float* const* in = args.in; float* XR = args.out; bf16* XRB = (bf16*)args.out + 1024;
    for (int u = threadIdx.x; u < (LDS_BYTES - LDSCTL_OFF) / 4; u += NWAVES * 64) ((LAS unsigned*)(lds + LDSCTL_OFF))[u] = 0u;
    __syncthreads();
    unsigned* ctl = (unsigned*)(ws + WS_CTL);
    XcdBarrier bar; bar.bar = ctl + CW_BAR + args.li * XCD_BAR_WORDS; bar.x = 0; bar.st = nullptr;
    bar = xcd_barrier_post(ctl + CW_BAR + args.li * XCD_BAR_WORDS, (volatile LAS unsigned*)(lds + MISC_OFF) + 8);
    bar.wave = wave;
#define IN(k) true
#define SEAM(k) do { if ((k) + 1 < NPHASE) xcd_barrier(bar); } while (0)
    bf16 *XN = (bf16*)(ws + WS_XN), *SBQ = (bf16*)(ws + WS_SBQ), *SBKT = (bf16*)(ws + WS_SBKT), *SBVT = (bf16*)(ws + WS_SBVT), *KT = (bf16*)(ws + WS_KT), *Qb = (bf16*)(ws + WS_Q), *VT = (bf16*)(ws + WS_VT);
    bf16 *U = (bf16*)(ws + WS_U), *BG = (bf16*)(ws + WS_BG), *CQ = (bf16*)(ws + WS_CQ), *CKV = (bf16*)(ws + WS_CKV), *ACONV = (bf16*)(ws + WS_ACONV), *OMLA = (bf16*)(ws + WS_OMLA), *OSB = (bf16*)(ws + WS_OSB);
    unsigned char* GATES = ws + WS_GATES; bf16 *MERGED = (bf16*)(ws + WS_MERGED), *H2 = (bf16*)(ws + WS_H2), *ACT = (bf16*)(ws + WS_ACT), *Y = (bf16*)(ws + WS_Y);
    float* SSQ = (float*)(ws + WS_SSQ); float2* CS = (float2*)(ws + WS_CS);
    const int gw = vcu * NWAVES + wave, NGW = G * NWAVES;
    LAS float* scr = (LAS float*)(lds + wave * 16384);

    if (IN(0)) { const int lane = lane_id();
        for (int k = gw; k < WI_EARLY; k += NGW) { WItem s; wdecode(wi_early(k), in, 0, ws, s); tr_item(s, scr, lane); }
        for (int i = gw * 64 + lane; i < DEPTH * 3072; i += NGW * 64) ((float*)(ws + WS_GB))[i] = __builtin_fmaf(in[4][i], -1.4426950408889634f, -7.994353436858858f);
        for (int r8 = gw; r8 < M / 8; r8 += NGW) { rms_rowsN<8>(in[0], in[2], XN, ws + WS_XN8, 8 * r8, lane); cs_rows4((const int*)in[1], CS, 8 * r8, lane); cs_rows4((const int*)in[1], CS, 8 * r8 + 4, lane); }
    }
    SEAM(0);
    for (int l = 0; l < DEPTH; ++l) {
        const int pb = 1 + 9 * l;
        if (IN(pb + 0)) {
            pg8::EpiAdapt<EpiWinA> E{EpiWinA{U, BG, SBQ, SBKT, SBVT, CQ, CKV, KT, SSQ, CS}};
            { pg8::MaskedDense<PH1_F8MASK> S; S.init(ws + WS_XN8, ws + WS_WA, M, 512, G, bx);
              pg8::gemm_phase<pg8::EpiAdapt<EpiWinA>, pg8::MaskedDense<PH1_F8MASK>, false, false, true>(lds, wave, 512, S, E); }
            { constexpr unsigned REST = ((1u << (NA / 256)) - 1u) & ~PH1_F8MASK; pg8::MaskedDense<REST> S; S.init(XN, ws + WS_WA, M, 1024, G, bx);
              pg8::gemm_phase<pg8::EpiAdapt<EpiWinA>, pg8::MaskedDense<REST>, false>(lds, wave, 1024, S, E); }
        }
        SEAM(pb + 0);
        if (IN(pb + 1)) {
            { pg8::DenseOrder S; S.init(CQ, ws + WS_WUQ, M, 768, 256, G, bx); pg8::EpiAdapt<EpiQ> E{EpiQ{Qb, SSQ, CS}};
              pg8::gemm_phase<pg8::EpiAdapt<EpiQ>, pg8::DenseOrder, false, false, false, false>(lds, wave, 256, S, E); }
            { pg8::DenseOrder S; S.init(CKV, ws + WS_WUKV, M, 1024, 128, G, bx); pg8::EpiAdapt<EpiKV> E{EpiKV{KT, VT, SSQ}};
              pg8::gemm_phase<pg8::EpiAdapt<EpiKV>, pg8::DenseOrder, false, false, false, false>(lds, wave, 128, S, E); }
            const float* cw = in[5] + (size_t)l * 3 * 512; const int tid = wave * 64 + lane_id();
            { const int rstep = G * NWAVES; int id = vcu * (NWAVES * 64) + tid;
              for (; id + 3 * rstep * 64 < M * 64; id += 4 * rstep * 64) conv_items4(U, BG, cw, ACONV, id >> 6, rstep, id & 63);
              for (; id < M * 64; id += rstep * 64) conv_item(U, BG, cw, ACONV, id >> 6, id & 63); }
        }
        SEAM(pb + 1);
        if (IN(pb + 2)) {
            ATTN_PHASE_BODY
        }
        SEAM(pb + 2);
        if (IN(pb + 3)) {
            { pg8::BranchOrder<0> S; S.T.init(nullptr, nullptr, M, 1024, 1024, G, bx); S.ws = (const char*)ws;
              pg8::EpiAdapt<EpiGate8> E{EpiGate8{GATES, (const float*)(ws + WS_GB) + (size_t)l * 3072}};
              pg8::gemm_phase<pg8::EpiAdapt<EpiGate8>, pg8::BranchOrder<0>, false, false, true>(lds, wave, 512, S, E); }
            { pg8::BranchOrder<1, 0, 1> S; S.T.init(nullptr, nullptr, M, 1024, 1024, G, bx); S.ws = (const char*)ws;
              pg8::EpiAdapt<EpiY3<false>> E{EpiY3<false>{GATES, MERGED}};
              pg8::gemm_phase<pg8::EpiAdapt<EpiY3<false>>, pg8::BranchOrder<1, 0, 1>, false>(lds, wave, 512, S, E); }
            { pg8::BranchOrder<2, 1, 2> S; S.T.init(nullptr, nullptr, M, 1024, 1024, G, bx); S.ws = (const char*)ws;
              pg8::EpiAdapt<EpiY3<true>> E{EpiY3<true>{GATES, MERGED}};
              pg8::gemm_phase<pg8::EpiAdapt<EpiY3<true>>, pg8::BranchOrder<2, 1, 2>, false, false, true>(lds, wave, 256, S, E); }
        }
        SEAM(pb + 3);
        if (IN(pb + 4)) {
            pg8::DenseOrder S; S.init(MERGED, ws + WS_WO, M, 1024, 1024, G, bx); pg8::EpiAdapt<EpiWo> E{EpiWo{l == 0 ? in[0] : nullptr, XRB, (float*)(ws + WS_SSQ2)}};
            pg8::gemm_phase<pg8::EpiAdapt<EpiWo>, pg8::DenseOrder, false>(lds, wave, 1024, S, E);
        }
        SEAM(pb + 4);
        if (IN(pb + 5)) { const int lane = lane_id();
            for (int g0 = 0; g0 < M / 16; g0 += NGW) t1_group(XRB, in[14] + l * 1024, (const bf16*)(ws + WS_WR), in[16] + l * 4, in[18] + l * 32, ws, l, g0 + gw, g0 + gw < M / 16, lane, wave,
                                                            (LAS int*)(lds + LDSCTL_OFF + 6144), (LAS int*)(lds + LDSCTL_OFF + 6144 + 256));
        }
        SEAM(pb + 5);
        const unsigned* cnt = ctl + CW_CNT + l * 32 * 64;
        if (IN(pb + 6)) {
            pg8::GroupedOrder<true> S{(LAS int*)(lds + LDSCTL_OFF + 1024), (const char*)H2, (const char*)(ws + WS_WGU), (const int*)(ws + WS_LIST), 512, 2, 512, G, bx}; S.init_lanes(cnt, lane_id());
            pg8::EpiAdapt<EpiGU> E{EpiGU{ACT}};
            pg8::gemm_phase<pg8::EpiAdapt<EpiGU>, pg8::GroupedOrder<true>, true, false, true>(lds, wave, 512, S, E);
        }
        SEAM(pb + 6);
        if (IN(pb + 7)) {
            pg8::GroupedOrder<false> S{(LAS int*)(lds + LDSCTL_OFF + 1024), (const char*)ACT, (const char*)(ws + WS_WD), nullptr, 128, 4, 1024, G, bx}; S.init_lanes(cnt, lane_id());
            pg8::EpiAdapt<EpiDown> E{EpiDown{Y}};
            pg8::gemm_phase<pg8::EpiAdapt<EpiDown>, pg8::GroupedOrder<false>, false, false, true>(lds, wave, 128, S, E);
        }
        SEAM(pb + 7);
        if (IN(pb + 8)) { const int lane = lane_id();
            const bool fin = (l + 1 == DEPTH); const float* gnext = fin ? in[22] : in[2] + (l + 1) * 1024;
            const int baseL = moe_base_lanes(cnt, lane);
            for (int r4 = gw; r4 < M / 4; r4 += NGW) t2_rows4(XR, XRB, Y, baseL, (const int4*)(ws + WS_TOKSLOT), (const float2*)(ws + WS_TOKW), gnext, XN, ws + WS_XN8, fin, 4 * r4, lane);
            if (!fin) { for (int k = gw; k < WI_EARLY; k += NGW) { WItem s; wdecode(wi_early(k), in, l + 1, ws, s); tr_item(s, scr, lane); } }
        }
        SEAM(pb + 8);
    }
#undef IN
#undef SEAM
}
template <class T> static T* wsp(void* ws, size_t off) { return (T*)((unsigned char*)ws + off); }
static void launch_mk(Args a, int lo, int hi, int li, int grid, hipStream_t s) { a.ph_lo = lo; a.ph_hi = hi; a.li = li; a.pad = 0; hipLaunchKernelGGL(mk_fwd, dim3(grid), dim3(NWAVES * 64), LDS_BYTES, s, a); }
extern "C" void kernel_launch(void* const* d_in, const int* in_sizes, int n_in, void* d_out, int out_size, void* d_ws, size_t ws_size, hipStream_t stream) {
    static int grid = 0;
    if (grid == 0) {
        if (n_in != 23 || out_size != M * D || ws_size < WS_END) { fprintf(stderr, "kernel_launch: unexpected shapes (n_in %d out %d ws %zu)\n", n_in, out_size, ws_size); grid = -1; return; }
        int dev = 0, cus = 0;
        if (hipGetDevice(&dev) != hipSuccess || hipDeviceGetAttribute(&cus, hipDeviceAttributeMultiprocessorCount, dev) != hipSuccess) { grid = -1; return; }
        if (hipFuncSetAttribute((const void*)mk_fwd, hipFuncAttributeMaxDynamicSharedMemorySize, LDS_BYTES) != hipSuccess) { fprintf(stderr, "kernel_launch: hipFuncSetAttribute failed\n"); grid = -1; return; }
        int per_cu = 0; (void)hipOccupancyMaxActiveBlocksPerMultiprocessor(&per_cu, (const void*)mk_fwd, NWAVES * 64, LDS_BYTES); (void)hipGetLastError();
        grid = cus;
    }
    if (grid < 0) return;
    unsigned char* ws = (unsigned char*)d_ws;
    (void)hipMemsetAsync(ws + WS_CTL, 0, 1 * MiB, stream);
    Args a{}; for (int i = 0; i < 23; ++i) a.in[i] = (const float*)d_in[i]; a.out = (float*)d_out; a.ws = ws;
    launch_mk(a, 0, NPHASE, 0, grid, stream);
}
```

```cpp
#define ATTN_PHASE_BODY { if (wave >= 4) __builtin_amdgcn_s_setprio(1);     \
    for (int u = gw; u < 2048; u += NGW) for (int i = 0; i < 2; ++i) { const int bh = u >> 5, a = u & 31; mla_wave_unit(Qb, KT, VT, OMLA, bh, i == 0 ? 63 - a : a); } \
      \
      \
    { LAS int* ctr_ = (LAS int*)(lds + LDSCTL_OFF + 4096) + 2 * l; \
      for (;;) { int t_ = 0; if (lane_id() == 0) t_ = __atomic_fetch_add(ctr_, 1, __ATOMIC_RELAXED); t_ = __builtin_amdgcn_readfirstlane(t_); \
        const int k_ = vcu + t_ * G; \
        if (k_ < WI_LATE) { WItem s; wdecode(wi_late(k_), in, l, ws, s); tr_item(s, scr, lane_id()); } \
        else if (k_ < WI_LATE + 48) wr_item(in[15] + (size_t)l * 1024 * 4, in[17] + (size_t)l * 1024 * 32, (bf16*)(ws + WS_WR), k_ - WI_LATE, lane_id()); \
        else break; } \
      { LAS int* cc_ = (LAS int*)(lds + LDSCTL_OFF + 4096 + 64) + l; const float* cw_ = in[5] + (size_t)l * 3 * 512; const int nch_ = (M / 4 + G - 1) / G;     \
        for (;;) { int t_ = 0; if (lane_id() == 0) t_ = __atomic_fetch_add(cc_, 1, __ATOMIC_RELAXED); t_ = __builtin_amdgcn_readfirstlane(t_); \
          if (t_ >= nch_ || vcu * nch_ + t_ >= M / 4) break; \
          conv_items4((const bf16*)(ws + WS_U), (const bf16*)(ws + WS_BG), cw_, (bf16*)(ws + WS_ACONV), (vcu * nch_ + t_) * 4, 1, lane_id()); } } \
      for (;;) { int t_ = 0; if (lane_id() == 0) t_ = __atomic_fetch_add(ctr_ + 1, 1, __ATOMIC_RELAXED); t_ = __builtin_amdgcn_readfirstlane(t_); \
        if (t_ >= 16) break; \
        const int u = vcu * 16 + t_; sb_wave_unit(SBQ, SBKT, SBVT, OSB, u >> 6, u & 63); } } \
    __builtin_amdgcn_s_setprio(0); }
#include <hip/hip_runtime.h>
#include <stdint.h>
#include <stdio.h>

#define DI __device__ __forceinline__
typedef unsigned short bf16;
typedef unsigned u32x4 __attribute__((ext_vector_type(4)));
typedef unsigned u32x2 __attribute__((ext_vector_type(2)));
typedef float f32x4 __attribute__((ext_vector_type(4)));
typedef float f32x2 __attribute__((ext_vector_type(2)));
typedef __bf16 bf16x2_t __attribute__((ext_vector_type(2)));

constexpr int D = 1024, NBATCH = 8, SEQ = 4096, M = NBATCH * SEQ, DEPTH = 2;
constexpr int CONVW = 512, QRANK = 256, KVRANK = 128, NH = 8;
constexpr int OFF_CQ = 1536, OFF_CKV = 1792, OFF_KR = 1920, OFF_SB = 1952, OFF_GATE = 3488, IN_COLS = 6560;
constexpr int NEXP = 32, NGRP = 4, EPG = 8, DEXP = 256;
constexpr int NA = 3584;
constexpr int MOE_ROWS = 73728;
constexpr float EPS = 1e-6f;
constexpr int XRP = 2048;
constexpr float LOG2E = 1.4426950408889634f;
constexpr float QSCALE_MLA = 0.10206207261596575f * LOG2E;
constexpr float QSCALE_SB = 0.125f * LOG2E;

constexpr size_t MiB = 1u << 20;
constexpr size_t WS_CTL = 0;
constexpr size_t WS_TOKSLOT = 1 * MiB;
constexpr size_t WS_TOKW = 1 * MiB + 512 * 1024;
constexpr size_t WS_LIST = 2 * MiB;
constexpr size_t WS_CS = 6 * MiB;
constexpr size_t WS_SSQ = 10 * MiB;
constexpr size_t WS_SSQ2 = 12 * MiB;
constexpr size_t WS_GB = 14 * MiB;
constexpr size_t WS_WA = 16 * MiB;
constexpr size_t WS_WG = 23 * MiB;
constexpr size_t WS_WUQ = 29 * MiB;
constexpr size_t WS_WUKV = 29 * MiB + 512 * 1024;
constexpr size_t WS_WOC = 30 * MiB, WS_WOM = 31 * MiB, WS_WOS = 32 * MiB;
constexpr size_t WS_WO = 33 * MiB;
constexpr size_t WS_WR = 35 * MiB;
constexpr size_t WS_WGU = 36 * MiB;
constexpr size_t WS_WD = 68 * MiB;
constexpr size_t WS_XN8 = 84 * MiB;
constexpr size_t WS_XN = 116 * MiB;
constexpr size_t WS_ACONV = 116 * MiB;
constexpr size_t WS_SBQ = 180 * MiB, WS_SBKT = 212 * MiB, WS_SBVT = 244 * MiB;
constexpr size_t WS_KT = 276 * MiB;
constexpr size_t WS_Q = 324 * MiB;
constexpr size_t WS_VT = 372 * MiB;
constexpr size_t WS_U = 404 * MiB, WS_BG = 436 * MiB;
constexpr size_t WS_CQ = 468 * MiB, WS_CKV = 484 * MiB;
constexpr size_t WS_OMLA = 148 * MiB, WS_OSB = 164 * MiB;
constexpr size_t WS_GATES = 180 * MiB;
constexpr size_t WS_MPART = 276 * MiB;
constexpr size_t WS_MERGED = 372 * MiB;
constexpr size_t WS_H2 = 180 * MiB;
constexpr size_t WS_ACT = 244 * MiB;
constexpr size_t WS_Y = 280 * MiB;
constexpr size_t WS_END = 500 * MiB;
constexpr int CW_CNT = 32768;
constexpr int CW_DONE = 65536;

DI float bf2f(unsigned h) { return __uint_as_float(h << 16); }
DI unsigned pk2(float lo, float hi) { f32x2 v = {lo, hi}; bf16x2_t b = __builtin_convertvector(v, bf16x2_t); return __builtin_bit_cast(unsigned, b); }
DI u32x4 pk8(const float (&v)[8]) { u32x4 w; w.x = pk2(v[0], v[1]); w.y = pk2(v[2], v[3]); w.z = pk2(v[4], v[5]); w.w = pk2(v[6], v[7]); return w; }
DI void unpk8(u32x4 w, float (&v)[8]) { v[0] = bf2f(w.x & 0xffffu); v[1] = bf2f(w.x >> 16); v[2] = bf2f(w.y & 0xffffu); v[3] = bf2f(w.y >> 16);
    v[4] = bf2f(w.z & 0xffffu); v[5] = bf2f(w.z >> 16); v[6] = bf2f(w.w & 0xffffu); v[7] = bf2f(w.w >> 16); }
DI int lane_id() { int l; asm volatile("v_mbcnt_lo_u32_b32 %0, -1, 0\n\tv_mbcnt_hi_u32_b32 %0, -1, %0" : "=v"(l)); return l; }
DI float shfl_xor_l(float v, int o, int lane) { return __int_as_float(__builtin_amdgcn_ds_bpermute((lane ^ o) << 2, __float_as_int(v))); }
DI float wave_sum(float v) { const int l = lane_id();
#pragma unroll
    for (int o = 1; o < 64; o <<= 1) v += shfl_xor_l(v, o, l);
    return v;
}
DI size_t vt8_idx(int bh, int key, int d) { const int k = key & 63, k5 = k & 31, hi = (k5 >> 2) & 1, sl = (k >> 5) * 16 + (k5 & 3) + 4 * (k5 >> 3);
    return (((((size_t)bh * (SEQ / 64) + (key >> 6)) * 2 + (d >> 5)) * 32 + (d & 31)) * 2 + hi) * 32 + sl; }
DI size_t kt8_idx(int bh, int key, int d) { return ((((size_t)bh * (SEQ / 64) + (key >> 6)) * 3 + (d >> 5)) * 64 + (key & 63)) * 32 + (d & 31); }
template <int NCH> DI size_t kt_idx(int bh, int key, int chunk) { return ((((size_t)bh * (SEQ / 64) + (key >> 6)) * NCH + chunk) * 64 + (key & 63)) * 8; }
DI size_t vt_idx(int bh, int key, int d) {
    const int k = key & 63;
    return ((size_t)bh * (SEQ / 64) + (key >> 6)) * 4096 + (size_t)((((((k >> 5) * 2 + ((k >> 4) & 1)) * 2 + (d >> 5)) * 32 + (d & 31)) * 2 + ((k >> 2) & 1)) * 8 + ((k >> 3) & 1) * 4 + (k & 3));
}

DI bool moe_locate(const unsigned* cnt, int tile, int& e, int& i, int& rowbase) {
    int acc = 0;
    for (int k = 0; k < NEXP; ++k) { const int n = (int)((cnt[k * 64] + 255u) >> 8); if (tile < acc + n) { e = k; i = tile - acc; rowbase = acc * 256; return true; } acc += n; }
    return false;
}
DI int moe_base(const unsigned* cnt, int e) { int acc = 0; for (int k = 0; k < e; ++k) acc += (int)((cnt[k * 64] + 255u) >> 8); return acc * 256; }

struct WItem { const float* W; int ldw, K, src, perm; const float* gain; bf16* dst; int kb; int f8; };
constexpr unsigned PH1_F8MASK = 0x3fc0u;
constexpr int WI_A = (NA / 32) * 16, WI_G = 96 * 16, WI_UQ = 24 * 4, WI_UKV = 32 * 2, WI_OUT = 32 * 8, WI_O = 32 * 16, WI_GU = NEXP * 16 * 16, WI_D = NEXP * 32 * 4;
constexpr int WI_TOTAL = WI_A + WI_G + WI_UQ + WI_UKV + 3 * WI_OUT + WI_O + WI_GU + WI_D;
constexpr int WI_EARLY = WI_A + WI_UQ + WI_UKV, WI_LATE = WI_TOTAL - WI_EARLY;
DI int wi_early(int k) { return k < WI_A ? k : k + WI_G; }
DI int wi_late(int k) { return k < WI_G ? WI_A + k : k + WI_A + WI_UQ + WI_UKV; }
DI void wdecode(int it, const float* const* in, int l, unsigned char* ws, WItem& s) {
    const float* w_in = in[3] + (size_t)l * 1024 * IN_COLS;
    s.perm = 0; s.gain = nullptr; s.f8 = 0;
    if (it < WI_A) { const int nb = it >> 4; s.kb = it & 15; s.W = w_in; s.ldw = IN_COLS; s.K = 1024; s.dst = (bf16*)(ws + WS_WA) + (size_t)nb * 32 * 1024;
        if ((PH1_F8MASK >> (nb >> 3)) & 1u) { s.f8 = 1; s.dst = (bf16*)(ws + WS_WA + (size_t)(nb >> 3) * 524288 + (size_t)(nb & 7) * 32 * 1024); }
        if (nb < 32) { const int T = nb >> 3, w = nb & 7; s.src = (w < 4) ? 128 * T + 32 * w : 1024 + 128 * T + 32 * (w - 4); }
        else if (nb < 48) s.src = 512 + 32 * (nb - 32);
        else if (nb < 96) s.src = OFF_SB + 32 * (nb - 48);
        else if (nb < 104) s.src = OFF_CQ + 32 * (nb - 96);
        else if (nb < 108) s.src = OFF_CKV + 32 * (nb - 104);
        else if (nb == 108) { s.src = OFF_KR; s.perm = 1; }
        else s.src = -1;
        return; }
    it -= WI_A;
    if (it < WI_G) { const int nb = it >> 4; s.kb = it & 15; s.W = w_in; s.ldw = IN_COLS; s.K = 1024; s.src = OFF_GATE + 32 * nb; s.f8 = 1; s.dst = (bf16*)(ws + WS_WG + (size_t)nb * 32 * 1024); return; }
    it -= WI_G;
    if (it < WI_UQ) { const int nb = it >> 2; s.kb = it & 3; s.W = in[9] + (size_t)l * 256 * 768; s.ldw = 768; s.K = 256; s.gain = in[7] + l * 256; const int h = nb / 3, part = nb % 3;
        s.src = h * 96 + part * 32; s.perm = (part == 2); s.dst = (bf16*)(ws + WS_WUQ) + (size_t)nb * 32 * 256; return; }
    it -= WI_UQ;
    if (it < WI_UKV) { const int nb = it >> 1; s.kb = it & 1; s.W = in[10] + (size_t)l * 128 * 1024; s.ldw = 1024; s.K = 128; s.gain = in[8] + l * 128;
        s.src = (nb < 16) ? (nb >> 1) * 128 + (nb & 1) * 32 : ((nb - 16) >> 1) * 128 + 64 + (nb & 1) * 32; s.dst = (bf16*)(ws + WS_WUKV) + (size_t)nb * 32 * 128; return; }
    it -= WI_UKV;
    for (int j = 0; j < 3; ++j) { if (it < WI_OUT) { const int nb = it >> 3; s.kb = it & 7; s.W = (j == 0 ? in[6] : j == 1 ? in[11] : in[12]) + (size_t)l * 512 * 1024; s.ldw = 1024; s.K = 512; s.src = 32 * nb; s.f8 = 2;
            s.dst = (bf16*)(ws + (j == 0 ? WS_WOC : j == 1 ? WS_WOM : WS_WOS)) + (size_t)nb * 32 * 512;
            if (j) { s.f8 = 1; s.dst = (bf16*)(ws + (j == 1 ? WS_WOM : WS_WOS) + (size_t)nb * 32 * 512); }
            return; } it -= WI_OUT; }
    if (it < WI_O) { const int nb = it >> 4; s.kb = it & 15; s.W = in[13] + (size_t)l * 1024 * 1024; s.ldw = 1024; s.K = 1024; s.src = 32 * nb; s.dst = (bf16*)(ws + WS_WO) + (size_t)nb * 32 * 1024; return; }
    it -= WI_O;
    if (it < WI_GU) { const int e = it >> 8, r = it & 255, nb = r >> 4; s.kb = r & 15; const int pn = nb >> 3, w = nb & 7;
        s.W = (w < 4 ? in[19] : in[20]) + ((size_t)l * NEXP + e) * 1024 * 256; s.ldw = 256; s.K = 1024; s.src = 128 * pn + 32 * (w & 3); s.f8 = 1; s.dst = (bf16*)(ws + WS_WGU + ((size_t)e * 512 + nb * 32) * 1024); return; }
    it -= WI_GU;
    { const int e = it >> 7, r = it & 127, nb = r >> 2; s.kb = r & 3; s.W = in[21] + ((size_t)l * NEXP + e) * 256 * 1024; s.ldw = 1024; s.K = 256; s.src = 32 * nb; s.f8 = 1; s.dst = (bf16*)(ws + WS_WD + ((size_t)e * 1024 + nb * 32) * 256); }
}
DI void wr_item(const float* wrg, const float* wre, bf16* WR, int r, int lane) {
    const int tile = r >> 4, g4 = (r & 15) >> 2, j = r & 3; const float* W = tile == 0 ? wrg + j : wre + 8 * g4 + (tile == 2 ? 4 : 0) + j; const int ld = tile == 0 ? 4 : 32;
    for (int k = lane; k < 1024; k += 64) WR[(size_t)r * 1024 + k] = (bf16)(pk2(W[(size_t)k * ld], 0.f) & 0xffffu);
}
template <class FP> DI void tr_item(const WItem& s, FP scr, int lane) {
    const int k0 = 64 * s.kb, c4 = (lane & 7) * 4;
    f32x4 w[8];
#pragma unroll
    for (int i = 0; i < 8; ++i) { const int kk = 8 * i + (lane >> 3);
        w[i] = (s.src >= 0) ? *(const f32x4*)(s.W + (size_t)(k0 + kk) * s.ldw + s.src + c4) : (f32x4){0.f, 0.f, 0.f, 0.f}; }
#pragma unroll
    for (int i = 0; i < 8; ++i) { const int kk = 8 * i + (lane >> 3); f32x4 x = w[i]; if (s.gain) x = x * s.gain[k0 + kk];
#pragma unroll
        for (int e = 0; e < 4; ++e) { const int sc = c4 + e, c = s.perm ? ((sc & 15) * 2 + (sc >> 4)) : sc; scr[kk * 33 + c] = x[e]; } }
    asm volatile("s_waitcnt lgkmcnt(0)" ::: "memory");
    if (s.f8 == 1) {
        const int n = lane >> 1, kh = lane & 1; unsigned w[8];
#pragma unroll
        for (int q = 0; q < 8; ++q) { const auto* p = scr + (kh * 32 + 4 * q) * 33 + n; unsigned x = 0u;
            x = __builtin_amdgcn_cvt_pk_fp8_f32(p[0] * 64.0f, p[33] * 64.0f, x, false); x = __builtin_amdgcn_cvt_pk_fp8_f32(p[66] * 64.0f, p[99] * 64.0f, x, true); w[q] = x; }
        unsigned char* d = (unsigned char*)s.dst + (size_t)n * s.K + k0 + kh * 32;
        *(u32x4*)d = (u32x4){w[0], w[1], w[2], w[3]}; *(u32x4*)(d + 16) = (u32x4){w[4], w[5], w[6], w[7]};
        asm volatile("s_waitcnt lgkmcnt(0)" ::: "memory"); return;
    }
    const int c8 = lane & 7; const float sc = s.f8 == 2 ? 1.0f / 255.0f : 1.0f;
#pragma unroll
    for (int j = 0; j < 4; ++j) { const int n = (lane >> 3) + 8 * j; const auto* p = scr + (8 * c8) * 33 + n;
        u32x4 o; o.x = pk2(p[0 * 33] * sc, p[1 * 33] * sc); o.y = pk2(p[2 * 33] * sc, p[3 * 33] * sc); o.z = pk2(p[4 * 33] * sc, p[5 * 33] * sc); o.w = pk2(p[6 * 33] * sc, p[7 * 33] * sc);
        *(u32x4*)(s.dst + (size_t)n * s.K + k0 + 8 * c8) = o; }
    asm volatile("s_waitcnt lgkmcnt(0)" ::: "memory");
}
DI void rms_row(const float* xrow, const float* g, bf16* orow, float* fout, int lane) {
    const f32x4* xr = (const f32x4*)xrow + lane; const f32x4* gr = (const f32x4*)g + lane;
    f32x4 v[4]; float s = 0.f;
#pragma unroll
    for (int j = 0; j < 4; ++j) { v[j] = xr[64 * j]; s += (v[j].x * v[j].x + v[j].y * v[j].y) + (v[j].z * v[j].z + v[j].w * v[j].w); }
    const float rstd = 1.0f / sqrtf(wave_sum(s) * (1.f / D) + EPS);
#pragma unroll
    for (int j = 0; j < 4; ++j) { const f32x4 gg = gr[64 * j]; const f32x4 y = v[j] * rstd * gg;
        if (orow) { u32x2 o; o.x = pk2(y.x, y.y); o.y = pk2(y.z, y.w); ((u32x2*)orow)[lane + 64 * j] = o; }
        if (fout) ((f32x4*)fout)[lane + 64 * j] = y; }
}
DI unsigned pk4_fp8(f32x4 y) { unsigned w = 0u; w = __builtin_amdgcn_cvt_pk_fp8_f32(y.x, y.y, w, false); w = __builtin_amdgcn_cvt_pk_fp8_f32(y.z, y.w, w, true); return w; }
template <int NR> DI void rms_rowsN(const float* x, const float* g, bf16* out, unsigned char* out8, int row0, int lane) {
    f32x4 v[NR][4];
#pragma unroll
    for (int i = 0; i < NR; ++i)
#pragma unroll
        for (int j = 0; j < 4; ++j) v[i][j] = ((const f32x4*)(x + (size_t)(row0 + i) * D))[lane + 64 * j];
    f32x4 gg[4];
#pragma unroll
    for (int j = 0; j < 4; ++j) gg[j] = ((const f32x4*)g)[lane + 64 * j];
#pragma unroll
    for (int i = 0; i < NR; ++i) { float s = 0.f;
#pragma unroll
        for (int j = 0; j < 4; ++j) s += (v[i][j].x * v[i][j].x + v[i][j].y * v[i][j].y) + (v[i][j].z * v[i][j].z + v[i][j].w * v[i][j].w);
        const float rstd = 1.0f / sqrtf(wave_sum(s) * (1.f / D) + EPS);
#pragma unroll
        for (int j = 0; j < 4; ++j) { const f32x4 y = v[i][j] * rstd * gg[j]; u32x2 o; o.x = pk2(y.x, y.y); o.y = pk2(y.z, y.w); ((u32x2*)(out + (size_t)(row0 + i) * D))[lane + 64 * j] = o;
            ((unsigned*)(out8 + (size_t)(row0 + i) * D))[lane + 64 * j] = pk4_fp8(y); } }
}
DI void cs_rows4(const int* positions, float2* CS, int row0, int lane) {
    const int row = row0 + (lane >> 4), i = lane & 15; const float freq = powf(10000.0f, -(float)i / 16.0f); const float ang = (float)positions[row] * freq; const double a = (double)ang;
    CS[(size_t)row * 16 + i] = make_float2((float)cos(a), (float)sin(a));
}

struct EpiWinA {
    static constexpr int TAIL = 8;
    bf16 *U, *BG, *SBQ, *SBKT, *SBVT, *CQ, *CKV, *KT; float* SSQ; const float2* CS;
    DI bool is_pair(int pn) const { return pn < 4; }
    DI float rowctx(int) const { return 0.f; }
    DI void pair(int row, int col0, const float (&a)[8], const float (&b)[8], float) const {
        const int T = col0 >> 8, c = col0 & 255; float u[8];
        const float sc = ((PH1_F8MASK >> T) & 1u) ? 1.0f / 4096.0f : 1.0f;
#pragma unroll
        for (int j = 0; j < 8; ++j) u[j] = a[j] * b[j] * sc;
        *(u32x4*)(U + (size_t)row * 512 + 128 * T + c) = pk8(u);
    }
    struct Pre {}; DI Pre pre(int, int, int) const { return Pre{}; }
    static constexpr bool ROWSTAT = true;
    DI bool wants_stat(int pn) const { return pn >= 12; }
    DI void rowstat(int row, int pn, int wc, float tot) const { SSQ[(size_t)row * 8 + (pn == 12 ? 0 : 4) + wc] = tot; }
    DI float operator()(int row, int col0, const float (&v_)[8], float, int, const Pre&) const {
        const int b = row / SEQ, t = row % SEQ; float ret = 0.f; float v[8]; const float sc = ((PH1_F8MASK >> (col0 >> 8)) & 1u) ? 1.0f / 64.0f : 1.0f;
#pragma unroll
        for (int j = 0; j < 8; ++j) v[j] = v_[j] * sc;
        if (col0 < 1536) { *(u32x4*)(BG + (size_t)row * 512 + (col0 - 1024)) = pk8(v); }
        else if (col0 < 2048) { float q[8];
#pragma unroll
            for (int j = 0; j < 8; ++j) q[j] = v[j] * QSCALE_SB;
            *(u32x4*)(SBQ + (size_t)row * 512 + (col0 - 1536)) = pk8(q); }
        else if (col0 < 2560) { const int c = col0 - 2048, h = c >> 6, d = c & 63; *(u32x4*)(SBKT + kt_idx<8>(b * 8 + h, t, d >> 3)) = pk8(v); }
        else if (col0 < 3072) { const int c = col0 - 2560, h = c >> 6, d = c & 63;
#pragma unroll
            for (int j = 0; j < 8; ++j) SBVT[vt_idx(b * 8 + h, t, d + j)] = (bf16)(pk2(v[j], 0.f) & 0xffffu); }
        else if (col0 < 3328) { const int c = col0 - 3072; *(u32x4*)(CQ + (size_t)row * 256 + c) = pk8(v); float s = 0.f;
#pragma unroll
            for (int j = 0; j < 8; ++j) s += v[j] * v[j];
            ret = s; }
        else { const int c = col0 - 3328;
            if (c < 128) { *(u32x4*)(CKV + (size_t)row * 128 + c) = pk8(v); float s = 0.f;
#pragma unroll
                for (int j = 0; j < 8; ++j) s += v[j] * v[j];
                ret = s; }
            else if (c < 160) { const int i0 = (c - 128) >> 1; float r[8];
#pragma unroll
                for (int j = 0; j < 4; ++j) { const float2 cs = CS[(size_t)row * 16 + i0 + j]; const float x1 = v[2 * j], x2 = v[2 * j + 1]; r[2 * j] = x1 * cs.x - x2 * cs.y; r[2 * j + 1] = x2 * cs.x + x1 * cs.y; }
                u32x2 w; w.x = pk4_fp8((f32x4){r[0], r[1], r[2], r[3]}); w.y = pk4_fp8((f32x4){r[4], r[5], r[6], r[7]});
#pragma unroll
                for (int h = 0; h < NH; ++h) *(u32x2*)((unsigned char*)KT + kt8_idx(b * 8 + h, t, 64 + (c - 128))) = w; }
        }
        return ret;
    }
};
struct EpiQ {
    static constexpr int TAIL = 16;
    bf16* Q; const float* SSQ; const float2* CS;
    DI bool is_pair(int) const { return false; }
    DI void pair(int, int, const float (&)[8], const float (&)[8], float) const {}
    static constexpr bool ROWSTAT = false;
    DI bool wants_stat(int) const { return false; }
    DI void rowstat(int, int, int, float) const {}
    DI float rowctx(int row) const { const f32x4 x = *(const f32x4*)(SSQ + (size_t)row * 8); return 1.0f / sqrtf(((x.x + x.y) + (x.z + x.w)) * (1.f / 256.f) + EPS); }
    struct Pre { float2 cs[4]; };
    DI Pre pre(int row, int col0, int) const { Pre p; const int dd = col0 % 96; if (dd >= 64) { const int i0 = (dd - 64) >> 1;
#pragma unroll
            for (int j = 0; j < 4; ++j) p.cs[j] = CS[(size_t)row * 16 + i0 + j]; } else {
#pragma unroll
            for (int j = 0; j < 4; ++j) p.cs[j] = make_float2(1.f, 0.f); }
        return p; }
    DI float operator()(int row, int col0, const float (&v)[8], float rstd, int, const Pre& P) const {
        const int dd = col0 % 96; float r[8];
#pragma unroll
        for (int j = 0; j < 8; ++j) r[j] = v[j] * rstd;
        if (dd >= 64) {
#pragma unroll
            for (int j = 0; j < 4; ++j) { const float2 cs = P.cs[j]; const float x1 = r[2 * j], x2 = r[2 * j + 1]; r[2 * j] = x1 * cs.x - x2 * cs.y; r[2 * j + 1] = x2 * cs.x + x1 * cs.y; } }
#pragma unroll
        for (int j = 0; j < 8; ++j) r[j] *= QSCALE_MLA;
        { u32x2 w; w.x = pk4_fp8((f32x4){r[0], r[1], r[2], r[3]}); w.y = pk4_fp8((f32x4){r[4], r[5], r[6], r[7]}); *(u32x2*)((unsigned char*)Q + (size_t)row * 768 + col0) = w; }
        return 0.f;
    }
};
struct EpiKV {
    static constexpr int TAIL = 16;
    bf16 *KT, *VT; const float* SSQ;
    DI bool is_pair(int) const { return false; }
    DI void pair(int, int, const float (&)[8], const float (&)[8], float) const {}
    static constexpr bool ROWSTAT = false;
    DI bool wants_stat(int) const { return false; }
    DI void rowstat(int, int, int, float) const {}
    DI float rowctx(int row) const { const f32x4 x = *(const f32x4*)(SSQ + (size_t)row * 8 + 4); return 1.0f / sqrtf(((x.x + x.y) + (x.z + x.w)) * (1.f / 128.f) + EPS); }
    struct Pre {}; DI Pre pre(int, int, int) const { return Pre{}; }
    DI float operator()(int row, int col0, const float (&v)[8], float rstd, int, const Pre&) const {
        const int b = row / SEQ, t = row % SEQ; float r[8];
#pragma unroll
        for (int j = 0; j < 8; ++j) r[j] = v[j] * rstd;
        if (col0 < 512) { const int h = col0 >> 6, d = col0 & 63; u32x2 w; w.x = pk4_fp8((f32x4){r[0], r[1], r[2], r[3]}); w.y = pk4_fp8((f32x4){r[4], r[5], r[6], r[7]});
            *(u32x2*)((unsigned char*)KT + kt8_idx(b * 8 + h, t, d)) = w; }
        else { const int c = col0 - 512, h = c >> 6, d = c & 63; const unsigned w0 = pk4_fp8((f32x4){r[0], r[1], r[2], r[3]}), w1 = pk4_fp8((f32x4){r[4], r[5], r[6], r[7]});
#pragma unroll
            for (int j = 0; j < 8; ++j) ((unsigned char*)VT)[vt8_idx(b * 8 + h, t, d + j)] = (unsigned char)(((j < 4 ? w0 : w1) >> (8 * (j & 3))) & 0xffu); }
        return 0.f;
    }
};
DI size_t frag_idx(int row, int col) { const int r = row & 255, c = col & 255;
    const int wv = ((r >> 6) & 1) * 4 + ((c >> 5) & 3), ln = ((c >> 3) & 3) * 16 + (r & 15), it = ((r >> 7) * 4 + ((r >> 4) & 3)) * 2 + (c >> 7);
    return (size_t)((wv * 16 + it) * 64 + ln); }
struct EpiGate8 {
    static constexpr int TAIL = 16;
    unsigned char* GATES; const float* bgate;
    DI bool is_pair(int) const { return false; }
    DI void pair(int, int, const float (&)[8], const float (&)[8], float) const {}
    DI float rowctx(int) const { return 0.f; }
    static constexpr bool ROWSTAT = false;
    DI bool wants_stat(int) const { return false; }
    DI void rowstat(int, int, int, float) const {}
    struct Pre {}; DI Pre pre(int, int, int) const { return Pre{}; }
    DI float operator()(int row, int col0, const float (&v)[8], float, int br, const Pre&) const {
        float r[8]; const float* bg = bgate + br * 1024 + col0;
#pragma unroll
        for (int j = 0; j < 8; ++j) r[j] = __builtin_amdgcn_rcpf(__builtin_amdgcn_exp2f(__builtin_fmaf(v[j], -1.4426950408889634f / 64.0f, bg[j])) + 1.0f / 255.0f);
        u32x2 w; w.x = __builtin_amdgcn_cvt_pk_u8_f32(r[0], 0, 0u); w.x = __builtin_amdgcn_cvt_pk_u8_f32(r[1], 1, w.x); w.x = __builtin_amdgcn_cvt_pk_u8_f32(r[2], 2, w.x); w.x = __builtin_amdgcn_cvt_pk_u8_f32(r[3], 3, w.x);
        w.y = __builtin_amdgcn_cvt_pk_u8_f32(r[4], 0, 0u); w.y = __builtin_amdgcn_cvt_pk_u8_f32(r[5], 1, w.y); w.y = __builtin_amdgcn_cvt_pk_u8_f32(r[6], 2, w.y); w.y = __builtin_amdgcn_cvt_pk_u8_f32(r[7], 3, w.y);
        *(u32x2*)(GATES + ((size_t)(row >> 8) * 12 + br * 4 + (col0 >> 8)) * 65536 + frag_idx(row, col0) * 8) = w; return 0.f; }
};
template <bool F8> struct EpiY3 {
    static constexpr int TAIL = 16;
    const unsigned char* GATES; bf16* MERGED; bf16* MPART;
    DI bool is_pair(int) const { return false; }
    DI void pair(int, int, const float (&)[8], const float (&)[8], float) const {}
    DI float rowctx(int) const { return 0.f; }
    static constexpr bool ROWSTAT = false;
    DI bool wants_stat(int) const { return false; }
    DI void rowstat(int, int, int, float) const {}
    struct Pre { u32x2 g; u32x4 m; };
    DI Pre pre(int row, int col0, int br) const { Pre p; p.g = *(const u32x2*)(GATES + ((size_t)(row >> 8) * 12 + br * 4 + (col0 >> 8)) * 65536 + frag_idx(row, col0) * 8); p.m = (u32x4){0u, 0u, 0u, 0u};
        if (br) p.m = *(const u32x4*)((const unsigned char*)MPART + ((size_t)(row >> 8) * 4 + (col0 >> 8)) * 131072 + frag_idx(row, col0) * 16); return p; }
    DI float operator()(int row, int col0, const float (&v)[8], float, int br, const Pre& P) const {
        float g[8], m[8]; unpk8(P.m, m);
#pragma unroll
        for (int j = 0; j < 4; ++j) { g[j] = (float)((P.g.x >> (8 * j)) & 0xffu); g[4 + j] = (float)((P.g.y >> (8 * j)) & 0xffu); }
#pragma unroll
        for (int j = 0; j < 8; ++j) m[j] += g[j] * (F8 ? v[j] * (1.0f / (1024.0f * 255.0f)) : v[j]);
        if (br == 2) *(u32x4*)(MERGED + (size_t)row * 1024 + col0) = pk8(m);
        else *(u32x4*)((unsigned char*)MPART + ((size_t)(row >> 8) * 4 + (col0 >> 8)) * 131072 + frag_idx(row, col0) * 16) = pk8(m);
        return 0.f; }
};
struct EpiWo {
    static constexpr int TAIL = 16;
    const float* xin; bf16* XRB; float* SSQ2;
    DI bool is_pair(int) const { return false; }
    DI void pair(int, int, const float (&)[8], const float (&)[8], float) const {}
    DI float rowctx(int) const { return 0.f; }
    static constexpr bool ROWSTAT = true;
    DI bool wants_stat(int) const { return true; }
    DI void rowstat(int row, int pn, int wc, float tot) const { SSQ2[(size_t)row * 16 + pn * 4 + wc] = tot; }
    struct Pre { f32x4 a, b; };
    DI Pre pre(int row, int col0, int) const { Pre p;
        if (xin) { p.a = *(const f32x4*)(xin + (size_t)row * 1024 + col0); p.b = *(const f32x4*)(xin + (size_t)row * 1024 + col0 + 4); }
        else { float t[8]; unpk8(*(const u32x4*)(XRB + (size_t)row * XRP + col0), t); p.a = (f32x4){t[0], t[1], t[2], t[3]}; p.b = (f32x4){t[4], t[5], t[6], t[7]}; }
        return p; }
    DI float operator()(int row, int col0, const float (&v)[8], float, int, const Pre& P) const {
        const float r[8] = {P.a.x + v[0], P.a.y + v[1], P.a.z + v[2], P.a.w + v[3], P.b.x + v[4], P.b.y + v[5], P.b.z + v[6], P.b.w + v[7]};
        *(u32x4*)(XRB + (size_t)row * XRP + col0) = pk8(r); float q = 0.f;
#pragma unroll
        for (int j = 0; j < 8; ++j) q += r[j] * r[j];
        return q; }
};
struct EpiGU {
    static constexpr int TAIL = 8;
    bf16* ACT;
    DI bool is_pair(int) const { return true; }
    DI float rowctx(int) const { return 0.f; }
    static constexpr bool ROWSTAT = false;
    DI bool wants_stat(int) const { return false; }
    DI void rowstat(int, int, int, float) const {}
    struct Pre {}; DI Pre pre(int, int, int) const { return Pre{}; }
    DI float operator()(int, int, const float (&)[8], float, int, const Pre&) const { return 0.f; }
    DI void pair(int row, int col0, const float (&a)[8], const float (&b)[8], float) const { const int pn = col0 >> 8, c = col0 & 255; float r[8];
#pragma unroll
        for (int j = 0; j < 8; ++j) { const float g = a[j] * (1.0f / 64.0f), u = b[j] * (1.0f / 64.0f); r[j] = g / (1.0f + __expf(-g)) * u; }
        u32x2 w; w.x = pk4_fp8((f32x4){r[0], r[1], r[2], r[3]} * 16.0f); w.y = pk4_fp8((f32x4){r[4], r[5], r[6], r[7]} * 16.0f);
        __hip_atomic_store((unsigned long long*)((unsigned char*)ACT + (size_t)row * 256 + 128 * pn + c), ((unsigned long long)w.y << 32) | w.x, __ATOMIC_RELAXED, __HIP_MEMORY_SCOPE_AGENT); }
};
struct EpiDown {
    static constexpr int TAIL = 16;
    bf16* Y;
    DI bool is_pair(int) const { return false; }
    DI void pair(int, int, const float (&)[8], const float (&)[8], float) const {}
    DI float rowctx(int) const { return 0.f; }
    static constexpr bool ROWSTAT = false;
    DI bool wants_stat(int) const { return false; }
    DI void rowstat(int, int, int, float) const {}
    struct Pre {}; DI Pre pre(int, int, int) const { return Pre{}; }
    DI float operator()(int row, int col0, const float (&v)[8], float, int, const Pre&) const { float r[8];
#pragma unroll
        for (int j = 0; j < 8; ++j) r[j] = v[j] * (1.0f / 1024.0f);
        *(u32x4*)(Y + (size_t)row * 1024 + col0) = pk8(r); return 0.f; }
};

DI void conv_item(const bf16* U, const bf16* BG, const float* cw, bf16* ACONV, int row, int c8) {
    const int t = row % SEQ, c = c8 * 8; float u0[8], u1[8], u2[8], bg[8], r[8];
    unpk8(*(const u32x4*)(U + (size_t)row * 512 + c), u2);
    if (t >= 1) unpk8(*(const u32x4*)(U + (size_t)(row - 1) * 512 + c), u1); else {
#pragma unroll
        for (int j = 0; j < 8; ++j) u1[j] = 0.f; }
    if (t >= 2) unpk8(*(const u32x4*)(U + (size_t)(row - 2) * 512 + c), u0); else {
#pragma unroll
        for (int j = 0; j < 8; ++j) u0[j] = 0.f; }
    unpk8(*(const u32x4*)(BG + (size_t)row * 512 + c), bg);
#pragma unroll
    for (int j = 0; j < 8; ++j) r[j] = bg[j] * (cw[c + j] * u0[j] + cw[512 + c + j] * u1[j] + cw[1024 + c + j] * u2[j]);
    *(u32x4*)(ACONV + (size_t)row * 512 + c) = pk8(r);
}
DI void conv_items4(const bf16* U, const bf16* BG, const float* cw, bf16* ACONV, int row0, int rstep, int c8) {
    const int c = c8 * 8; u32x4 r2[4], r1[4], r0[4], rb[4];
#pragma unroll
    for (int k = 0; k < 4; ++k) { const int row = row0 + k * rstep, t = row % SEQ;
        r2[k] = *(const u32x4*)(U + (size_t)row * 512 + c); r1[k] = (t >= 1) ? *(const u32x4*)(U + (size_t)(row - 1) * 512 + c) : (u32x4){0u, 0u, 0u, 0u};
        r0[k] = (t >= 2) ? *(const u32x4*)(U + (size_t)(row - 2) * 512 + c) : (u32x4){0u, 0u, 0u, 0u}; rb[k] = *(const u32x4*)(BG + (size_t)row * 512 + c); }
    float w0[8], w1[8], w2[8];
#pragma unroll
    for (int j = 0; j < 8; ++j) { w0[j] = cw[c + j]; w1[j] = cw[512 + c + j]; w2[j] = cw[1024 + c + j]; }
#pragma unroll
    for (int k = 0; k < 4; ++k) { float u0[8], u1[8], u2[8], bg[8], r[8]; unpk8(r0[k], u0); unpk8(r1[k], u1); unpk8(r2[k], u2); unpk8(rb[k], bg);
#pragma unroll
        for (int j = 0; j < 8; ++j) r[j] = bg[j] * (w0[j] * u0[j] + w1[j] * u1[j] + w2[j] * u2[j]);
        *(u32x4*)(ACONV + (size_t)(row0 + k * rstep) * 512 + c) = pk8(r); }
}
DI int moe_base_lanes(const unsigned* cnt, int lane) {
    int v = lane < NEXP ? (int)((cnt[lane * 64] + 255u) >> 8) * 256 : 0; const int own = v;
#pragma unroll
    for (int d = 1; d < 32; d <<= 1) { const int t = __builtin_amdgcn_ds_bpermute((lane - d) << 2, v); if ((lane & 31) >= d) v += t; }
    return v - own;
}
DI void t2_rows4(float* OUT, bf16* XRB, const bf16* Y, int baseL, const int4* TS, const float2* TW, const float* gnext, bf16* XN, unsigned char* XN8, int final_, int row0, int lane) {
    int4 ts[4]; float2 tw[4];
#pragma unroll
    for (int i = 0; i < 4; ++i) { ts[i] = TS[row0 + i]; tw[i] = TW[row0 + i]; }
    f32x4 v[4][4]; u32x2 p[4][4], q[4][4], xb[4][4];
#pragma unroll
    for (int i = 0; i < 4; ++i) {
        const size_t a1 = (size_t)__builtin_amdgcn_readlane(baseL, __builtin_amdgcn_readfirstlane(ts[i].x)) + ts[i].y, a2 = (size_t)__builtin_amdgcn_readlane(baseL, __builtin_amdgcn_readfirstlane(ts[i].z)) + ts[i].w;
        const u32x2* xr = (const u32x2*)(XRB + (size_t)(row0 + i) * XRP) + lane; const u32x2* y1 = (const u32x2*)(Y + a1 * 1024) + lane; const u32x2* y2 = (const u32x2*)(Y + a2 * 1024) + lane;
#pragma unroll
        for (int j = 0; j < 4; ++j) { xb[i][j] = xr[64 * j]; p[i][j] = y1[64 * j]; q[i][j] = y2[64 * j]; }
    }
    const f32x4* gr = (const f32x4*)gnext + lane; f32x4 gg[4];
#pragma unroll
    for (int j = 0; j < 4; ++j) gg[j] = gr[64 * j];
#pragma unroll
    for (int i = 0; i < 4; ++i) { float s = 0.f;
#pragma unroll
        for (int j = 0; j < 4; ++j) { f32x4& x = v[i][j]; const u32x2 pp = p[i][j], qq = q[i][j], xx = xb[i][j]; const float w1 = tw[i].x, w2 = tw[i].y;
            x = (f32x4){bf2f(xx.x & 0xffffu), bf2f(xx.x >> 16), bf2f(xx.y & 0xffffu), bf2f(xx.y >> 16)};
            x.x += w1 * bf2f(pp.x & 0xffffu) + w2 * bf2f(qq.x & 0xffffu); x.y += w1 * bf2f(pp.x >> 16) + w2 * bf2f(qq.x >> 16);
            x.z += w1 * bf2f(pp.y & 0xffffu) + w2 * bf2f(qq.y & 0xffffu); x.w += w1 * bf2f(pp.y >> 16) + w2 * bf2f(qq.y >> 16);
            s += (x.x * x.x + x.y * x.y) + (x.z * x.z + x.w * x.w); }
        const float rstd = 1.0f / sqrtf(wave_sum(s) * (1.f / D) + EPS);
        f32x4* xo = (f32x4*)(OUT + (size_t)(row0 + i) * D) + lane; u32x2* xs = (u32x2*)(XRB + (size_t)(row0 + i) * XRP) + lane; u32x2* xn = (u32x2*)(XN + (size_t)(row0 + i) * D) + lane;
#pragma unroll
        for (int j = 0; j < 4; ++j) { const f32x4 y = v[i][j] * rstd * gg[j];
            if (final_) xo[64 * j] = y; else { { u32x2 o2; o2.x = pk2(v[i][j].x, v[i][j].y); o2.y = pk2(v[i][j].z, v[i][j].w); xs[64 * j] = o2; } u32x2 o; o.x = pk2(y.x, y.y); o.y = pk2(y.z, y.w); xn[64 * j] = o; ((unsigned*)(XN8 + (size_t)(row0 + i) * D))[lane + 64 * j] = pk4_fp8(y); } }
    }
}
typedef float f32x16 __attribute__((ext_vector_type(16)));
typedef short s16x8 __attribute__((ext_vector_type(8)));
typedef short s16x4 __attribute__((ext_vector_type(4)));
DI int crow(int r, int hi) { return (r & 3) + 8 * (r >> 2) + 4 * hi; }
DI float max2f(float a, float b) { float r; asm("v_max_f32_e32 %0, %1, %2" : "=v"(r) : "v"(a), "v"(b)); return r; }
DI float add2f(float a, float b) { float r = a + b; asm("" : "+v"(r)); return r; }
DI float rowmax16(const f32x16& s) { float r;
    asm("s_nop 15\n\ts_nop 7\n\tv_max3_f32 %0, %1, %2, %3\n\tv_max3_f32 %0, %0, %4, %5\n\tv_max3_f32 %0, %0, %6, %7\n\tv_max3_f32 %0, %0, %8, %9\n\tv_max3_f32 %0, %0, %10, %11\n\tv_max3_f32 %0, %0, %12, %13\n\tv_max3_f32 %0, %0, %14, %15\n\tv_max_f32_e32 %0, %0, %16"
        : "=&v"(r) : "v"(s[0]), "v"(s[1]), "v"(s[2]), "v"(s[3]), "v"(s[4]), "v"(s[5]), "v"(s[6]), "v"(s[7]), "v"(s[8]), "v"(s[9]), "v"(s[10]), "v"(s[11]), "v"(s[12]), "v"(s[13]), "v"(s[14]), "v"(s[15]));
    return r; }
DI float xhalf(float x, int hi) {
    auto rr = __builtin_amdgcn_permlane32_swap(__float_as_uint(x), __float_as_uint(x), false, false);
    return __uint_as_float(hi ? rr[0] : rr[1]);
}
template <int NCH> struct KFrag { s16x8 k[NCH / 2]; };
struct VFrag { s16x8 v[2][2]; };
template <int NCH> DI void k_load(KFrag<NCH>& f, const bf16* KT, int bh, int kb, int r32, int hi) {
    const bf16* kp = KT + ((((size_t)bh * (SEQ / 64) + (kb >> 6)) * NCH) * 64 + (kb & 63) + r32) * 8;
#pragma unroll
    for (int d0 = 0; d0 < NCH / 2; ++d0) f.k[d0] = *(const s16x8*)(kp + (size_t)(2 * d0 + hi) * 512);
}
DI void v_load(VFrag& f, const bf16* VT, int bh, int kb, int r32, int hi) {
    const bf16* vp = VT + ((size_t)bh * (SEQ / 64) + (kb >> 6)) * 4096 + ((kb & 63) >> 5) * 2048 + (size_t)r32 * 16 + hi * 8;
#pragma unroll
    for (int s = 0; s < 2; ++s)
#pragma unroll
        for (int dh = 0; dh < 2; ++dh) f.v[s][dh] = *(const s16x8*)(vp + (s * 2 + dh) * 512);
}
typedef int v8i_t __attribute__((ext_vector_type(8))); typedef int v4i_t __attribute__((ext_vector_type(4)));
DI v8i_t ld32(const unsigned char* p) { const v4i_t a = *(const v4i_t*)p, b = *(const v4i_t*)(p + 16); return __builtin_shufflevector(a, b, 0, 1, 2, 3, 4, 5, 6, 7); }
DI void k_load8(v8i_t (&f)[2], const bf16* KT, int bh, int kb, int r32, int hi) {
    const unsigned char* kp = (const unsigned char*)KT + (((size_t)bh * (SEQ / 64) + (kb >> 6)) * 3 * 64 + (kb & 63) + r32) * 32;
    f[0] = ld32(kp + (size_t)hi * 2048); f[1] = ld32(kp + 2 * 2048);
}
DI f32x16 att_qk8(const v8i_t (&k)[2], const v8i_t (&q)[2], const f32x16& c) {
    f32x16 sc = __builtin_amdgcn_mfma_scale_f32_32x32x64_f8f6f4(k[0], q[0], c, 0, 0, 0, 0, 0, 0);
    return __builtin_amdgcn_mfma_scale_f32_32x32x64_f8f6f4(k[1], q[1], sc, 0, 0, 0, 0, 0, 0);
}
template <int ND0> DI f32x16 att_qk(const s16x8 (&k)[ND0], const s16x8 (&q)[ND0]) {
    f32x16 sc;
#pragma unroll
    for (int r = 0; r < 16; ++r) sc[r] = 0.f;
#pragma unroll
    for (int d0 = 0; d0 < ND0; ++d0) sc = __builtin_amdgcn_mfma_f32_32x32x16_bf16(k[d0], q[d0], sc, 0, 0, 0);
    return sc;
}
DI void att_pack(const float (&p)[16], s16x8 (&pf)[2]) {
#pragma unroll
    for (int s = 0; s < 2; ++s) { u32x4 w; w.x = pk2(p[8 * s], p[8 * s + 1]); w.y = pk2(p[8 * s + 2], p[8 * s + 3]); w.z = pk2(p[8 * s + 4], p[8 * s + 5]); w.w = pk2(p[8 * s + 6], p[8 * s + 7]); pf[s] = __builtin_bit_cast(s16x8, w); }
}
DI void att_pv(f32x16& o0, f32x16& o1, const VFrag& vf, const s16x8 (&pf)[2]) {
#pragma unroll
    for (int s = 0; s < 2; ++s) {
        o0 = __builtin_amdgcn_mfma_f32_32x32x16_bf16(vf.v[s][0], pf[s], o0, 0, 0, 0);
        o1 = __builtin_amdgcn_mfma_f32_32x32x16_bf16(vf.v[s][1], pf[s], o1, 0, 0, 0);
    }
}
DI void att_mask_diag(f32x16& s, int q0, int hi) {
    int Ls = 4 * hi - q0; asm volatile("" : "+v"(Ls));
#pragma unroll
    for (int r = 0; r < 16; ++r) if (Ls > -((r & 3) + 8 * (r >> 2))) s[r] = -INFINITY;
}
constexpr float MLA_PMAX8 = 256.0f;
DI void v_load8(v8i_t (&f)[2], const bf16* VT, int bh, int T, int r32, int hi) {
    const unsigned char* vp = (const unsigned char*)VT + ((((size_t)bh * (SEQ / 64) + T) * 2 * 32 + r32) * 2 + hi) * 32;
    f[0] = ld32(vp); f[1] = ld32(vp + 32 * 64);
}
template <bool INIT> DI void att_exps16(const f32x16& sc, v8i_t& w, int wofs, float (&q)[4]) {
#pragma unroll
    for (int r = 0; r < 16; r += 4) { const float a0 = __builtin_amdgcn_exp2f(sc[r]), a1 = __builtin_amdgcn_exp2f(sc[r + 1]), a2 = __builtin_amdgcn_exp2f(sc[r + 2]), a3 = __builtin_amdgcn_exp2f(sc[r + 3]);
        if (INIT && r == 0) { q[0] = a0; q[1] = a1; q[2] = a2; q[3] = a3; } else { q[0] = add2f(q[0], a0); q[1] = add2f(q[1], a1); q[2] = add2f(q[2], a2); q[3] = add2f(q[3], a3); }
        w[wofs + (r >> 2)] = (int)pk4_fp8((f32x4){a0, a1, a2, a3}); }
}
template <int J> DI void mla_sub64(const v8i_t (&kA)[2], const v8i_t (&kB)[2], const v8i_t (&qf)[2], f32x16& nm, float& l, f32x16& o0, f32x16& o1, v8i_t& pw, bool diag, bool first, int r32, int hi) {
    float ps;
    auto halves = [&]() { float q[4];
        { f32x16 sa = att_qk8(kA, qf, nm); if (J == 0 && diag) att_mask_diag(sa, r32, hi); att_exps16<true>(sa, pw, 0, q); }
        if (J == 0 && diag) {
#pragma unroll
            for (int i = 4; i < 8; ++i) pw[i] = 0; }
        else { f32x16 sb = att_qk8(kB, qf, nm); if (J == 1 && diag) att_mask_diag(sb, r32, hi); att_exps16<false>(sb, pw, 4, q); }
        ps = add2f(add2f(q[0], q[1]), add2f(q[2], q[3])); };
    halves();
    if (first || __builtin_amdgcn_ballot_w64(!(ps <= MLA_PMAX8)) != 0ull) {
        float tm;
        { f32x16 sa = att_qk8(kA, qf, nm); if (J == 0 && diag) att_mask_diag(sa, r32, hi); tm = rowmax16(sa); }
        if (!(J == 0 && diag)) { f32x16 sb = att_qk8(kB, qf, nm); if (J == 1 && diag) att_mask_diag(sb, r32, hi); tm = max2f(tm, rowmax16(sb)); }
        tm = max2f(tm, xhalf(tm, hi));
        const float d = first ? tm : max2f(tm, 0.f), alpha = first ? 1.0f : __builtin_amdgcn_exp2f(-d);
        l *= alpha;
#pragma unroll
        for (int r = 0; r < 16; ++r) { o0[r] *= alpha; o1[r] *= alpha; nm[r] -= d; }
        halves();
    }
    l = add2f(l, ps);
}
DI void mla_wave_unit(const bf16* Q, const bf16* KT, const bf16* VT, bf16* O, int bh, int qblk) {
    const int lane = lane_id();
    const int b = bh >> 3, h = bh & 7, r32 = lane & 31, hi = lane >> 5;
    const int t0 = qblk * 64; const size_t row0 = (size_t)b * SEQ + t0 + r32;
    v8i_t qf[2][2];
#pragma unroll
    for (int j = 0; j < 2; ++j) { const unsigned char* qp = (const unsigned char*)Q + (row0 + 32 * j) * 768 + h * 96;
        qf[j][0] = ld32(qp + 32 * hi); const v8i_t t = ld32(qp + 64);
#pragma unroll
        for (int i = 0; i < 8; ++i) qf[j][1][i] = hi ? 0 : t[i]; }
    f32x16 o0[2], o1[2], nm[2]; float l[2];
#pragma unroll
    for (int j = 0; j < 2; ++j) { l[j] = 0.f;
#pragma unroll
        for (int r = 0; r < 16; ++r) { o0[j][r] = 0.f; o1[j][r] = 0.f; nm[j][r] = 0.f; } }
    v8i_t kA[2], kB[2], vf[2], pw;
    k_load8(kA, KT, bh, 0, r32, hi); k_load8(kB, KT, bh, 32, r32, hi); v_load8(vf, VT, bh, 0, r32, hi);
    for (int T = 0; T <= qblk; ++T) {
        const bool diag = T == qblk; const int Tn = T < SEQ / 64 - 1 ? T + 1 : T;
        mla_sub64<0>(kA, kB, qf[0], nm[0], l[0], o0[0], o1[0], pw, diag, T == 0, r32, hi);
        o0[0] = __builtin_amdgcn_mfma_scale_f32_32x32x64_f8f6f4(vf[0], pw, o0[0], 0, 0, 0, 0, 0, 0); o1[0] = __builtin_amdgcn_mfma_scale_f32_32x32x64_f8f6f4(vf[1], pw, o1[0], 0, 0, 0, 0, 0, 0);
        mla_sub64<1>(kA, kB, qf[1], nm[1], l[1], o0[1], o1[1], pw, diag, T == 0, r32, hi);
        k_load8(kA, KT, bh, 64 * Tn, r32, hi); k_load8(kB, KT, bh, 64 * Tn + 32, r32, hi);
        o0[1] = __builtin_amdgcn_mfma_scale_f32_32x32x64_f8f6f4(vf[0], pw, o0[1], 0, 0, 0, 0, 0, 0); o1[1] = __builtin_amdgcn_mfma_scale_f32_32x32x64_f8f6f4(vf[1], pw, o1[1], 0, 0, 0, 0, 0, 0);
        v_load8(vf, VT, bh, Tn, r32, hi);
    }
    int r32e = r32; asm volatile("" : "+v"(r32e));
    const size_t rowe = (size_t)b * SEQ + t0 + r32e;
#pragma unroll
    for (int j = 0; j < 2; ++j) {
        l[j] += xhalf(l[j], hi); const float inv = 16.0f / l[j];
        unsigned char* op = (unsigned char*)O + (rowe + 32 * j) * 512 + h * 64 + 4 * hi;
#pragma unroll
        for (int a = 0; a < 4; ++a) {
            *(unsigned*)(op + 8 * a) = pk4_fp8((f32x4){o0[j][4 * a], o0[j][4 * a + 1], o0[j][4 * a + 2], o0[j][4 * a + 3]} * inv);
            *(unsigned*)(op + 32 + 8 * a) = pk4_fp8((f32x4){o1[j][4 * a], o1[j][4 * a + 1], o1[j][4 * a + 2], o1[j][4 * a + 3]} * inv);
        }
    }
}
DI void sb_step(const f32x16& sc, float& R, s16x8 (&pf)[2], bool diag, int L, int d, int hi) {
    float p[16], z[16], sp[16];
#pragma unroll
    for (int r = 0; r < 16; ++r) { z[r] = sc[r]; sp[r] = __builtin_amdgcn_fmed3f(z[r], 0.f, INFINITY) + __builtin_amdgcn_logf(1.0f + __builtin_amdgcn_exp2f(-fabsf(z[r]))); }
    if (diag) { int Ls = L; asm volatile("" : "+v"(Ls));
#pragma unroll
        for (int r = 0; r < 16; ++r) if (!(Ls < d - ((r & 3) + 8 * (r >> 2)))) { sp[r] = 0.f; z[r] = -INFINITY; } }
    float g[4], og[4];
#pragma unroll
    for (int a = 0; a < 4; ++a) { g[a] = add2f(add2f(sp[4 * a], sp[4 * a + 1]), add2f(sp[4 * a + 2], sp[4 * a + 3])); og[a] = xhalf(g[a], hi); }
    float SA[4]; float run = 0.f;
#pragma unroll
    for (int a = 3; a >= 0; --a) { SA[a] = run + (hi ? 0.f : og[a]); run += g[a] + og[a]; }
#pragma unroll
    for (int a = 0; a < 4; ++a) { float suf = R - SA[a];
#pragma unroll
        for (int i = 3; i >= 0; --i) { const int r = 4 * a + i; suf -= sp[r]; p[r] = __builtin_amdgcn_exp2f(z[r] + suf); } }
    R -= run;
    att_pack(p, pf);
}
DI void sb_wave_unit(const bf16* Q, const bf16* KT, const bf16* VT, bf16* O, int bh, int qblk) {
    constexpr int NCH = 8, ND0 = 4; const int lane = lane_id();
    const int b = bh >> 3, h = bh & 7, r32 = lane & 31, hi = lane >> 5;
    const int t0 = qblk * 64; const size_t row0 = (size_t)b * SEQ + t0 + r32; const int L = 4 * hi - r32;
    s16x8 qf[2][ND0];
#pragma unroll
    for (int j = 0; j < 2; ++j)
#pragma unroll
        for (int d0 = 0; d0 < ND0; ++d0) qf[j][d0] = *(const s16x8*)(Q + (row0 + 32 * j) * 512 + h * 64 + d0 * 16 + hi * 8);
    f32x16 o0[2], o1[2]; float R[2] = {0.f, 0.f};
#pragma unroll
    for (int j = 0; j < 2; ++j)
#pragma unroll
        for (int r = 0; r < 16; ++r) { o0[j][r] = 0.f; o1[j][r] = 0.f; }
    KFrag<NCH> cur, nxt; VFrag vf; s16x8 pf[2];
    bool done0 = false, done1 = false;
    k_load<NCH>(cur, KT, bh, t0 + 32, r32, hi);
    for (int kb = t0 + 32; kb >= 0; kb -= 32) {
        v_load(vf, VT, bh, kb, r32, hi);
        k_load<NCH>(nxt, KT, bh, kb >= 32 ? kb - 32 : 0, r32, hi);
        f32x16 s0, s1;
        if (kb <= t0 && !done0) s0 = att_qk<ND0>(cur.k, qf[0]);
        if (!done1) s1 = att_qk<ND0>(cur.k, qf[1]);
        if (kb <= t0 && !done0) { sb_step(s0, R[0], pf, kb == t0, L, t0 - kb, hi); att_pv(o0[0], o1[0], vf, pf); done0 = __builtin_amdgcn_ballot_w64(R[0] >= -150.0f) == 0ull; }
        if (!done1) { sb_step(s1, R[1], pf, kb == t0 + 32, L, t0 + 32 - kb, hi); att_pv(o0[1], o1[1], vf, pf); done1 = __builtin_amdgcn_ballot_w64(R[1] >= -150.0f) == 0ull; }
        if (done0 && done1) break;
        cur = nxt;
    }
    int r32e = r32; asm volatile("" : "+v"(r32e));
    const size_t rowe = (size_t)b * SEQ + t0 + r32e;
#pragma unroll
    for (int j = 0; j < 2; ++j) {
        unsigned char* op = (unsigned char*)O + (rowe + 32 * j) * 512 + h * 64 + 4 * hi;
#pragma unroll
        for (int a = 0; a < 4; ++a) {
            *(unsigned*)(op + 8 * a) = pk4_fp8((f32x4){o0[j][4 * a], o0[j][4 * a + 1], o0[j][4 * a + 2], o0[j][4 * a + 3]} * 16.0f);
            *(unsigned*)(op + 32 + 8 * a) = pk4_fp8((f32x4){o1[j][4 * a], o1[j][4 * a + 1], o1[j][4 * a + 2], o1[j][4 * a + 3]} * 16.0f);
        }
    }
}
#define LAS __attribute__((address_space(3)))
namespace pg8 {
typedef short bf16x8 __attribute__((ext_vector_type(8)));
constexpr int BM = 256, BK = 64, HALF = 128, HTB = HALF * BK * 2, STAGE_BYTES = 8 * HTB, NXCD = 8, WGM = 8;
DI int lds_byte(int r, int c) { const int st = (r >> 4) * 2 + (c >> 5), rr = r & 15, cc = c & 31, ob = rr * 64 + cc * 2; return st * 1024 + (ob ^ (((ob >> 9) & 1) << 5)); }
DI void stage_rc(int b, int& R, int& C) { const int st = b / 1024, sb = b % 1024, swz = sb ^ (((sb >> 9) & 1) << 5); R = (st >> 1) * 16 + swz / 64; C = (st & 1) * 32 + (swz % 64) / 2; }
typedef int pg8_v8i __attribute__((ext_vector_type(8))); typedef int pg8_v4i __attribute__((ext_vector_type(4)));
DI pg8_v8i pg8_cat(bf16x8 lo, bf16x8 hi) { const pg8_v4i a = __builtin_bit_cast(pg8_v4i, lo), b = __builtin_bit_cast(pg8_v4i, hi); return __builtin_shufflevector(a, b, 0, 1, 2, 3, 4, 5, 6, 7); }
DI int perm32(int rho) { const int n = rho >> 4, i = rho & 15; return 8 * (i >> 2) + 4 * n + (i & 3); }
struct Unit { const char* a; const char* b; const int* gl; int row0, col0, pn, nvalid, K, aux; };
struct DenseOrder {
    const char *A, *B; int nM, nN, nwg, G, c, K;
    DI void init(const void* A_, const void* B_, int Mrows, int N, int K_, int G_, int c_) { A = (const char*)A_; B = (const char*)B_; nM = Mrows / BM; nN = N / BM; nwg = nM * nN; G = G_; c = c_; K = K_; }
    DI bool next(int i, Unit& u) const {
        const long L = (long)i * G + c; if (L >= nwg) return false;
        int wgid = (int)L; { const int q = nwg / NXCD, r = nwg % NXCD, xcd = wgid % NXCD, off = wgid / NXCD; wgid = (xcd < r ? xcd * (q + 1) : r * (q + 1) + (xcd - r) * q) + off; }
        const int nig = WGM * nN, gid = wgid / nig, fm = gid * WGM, gsz = (nM - fm) < WGM ? (nM - fm) : WGM;
        const int pm = fm + ((wgid % nig) % gsz), pn = (wgid % nig) / gsz;
        u.a = A + (size_t)pm * BM * K * 2; u.b = B + (size_t)pn * BM * K * 2; u.gl = nullptr; u.row0 = pm * BM; u.col0 = pn * BM; u.pn = pn; u.nvalid = 256; u.K = K; u.aux = 0; return true;
    }
    DI void unit_done(const Unit&, int) const {}
};
template <unsigned MASK> struct MaskedDense {
    DenseOrder T;
    DI void init(const void* A_, const void* B_, int Mrows, int K_, int G_, int c_) { asm volatile("" : "+s"(c_));
        T.init(A_, B_, Mrows, __builtin_popcount(MASK) * BM, K_, G_, c_); }
    DI bool next(int i, Unit& u) const {
        if (!T.next(i, u)) return false;
        unsigned m = MASK; for (int j = 0; j < u.pn; ++j) m &= m - 1u;
        const int p = __builtin_ctz(m); u.b = T.B + (size_t)p * 524288; u.col0 = p * BM; u.pn = p; return true;
    }
    DI void unit_done(const Unit&, int) const {}
};
template <bool GATHER> struct GroupedOrder {
    LAS int* tbl;
    const char* A; const char* B; const int* LIST; int K, NCT, brows, G, c; unsigned* done;
    DI void init_lanes(const unsigned* cnt, int lane) {
        const int n = lane < NEXP ? (int)cnt[lane * 64] : 0; int v = (n + 255) >> 8; const int own = v;
#pragma unroll
        for (int d = 1; d < 32; d <<= 1) { const int t = __builtin_amdgcn_ds_bpermute((lane - d) << 2, v); if ((lane & 31) >= d) v += t; }
        tbl[lane] = lane < NEXP ? v - own : 0x7fffffff; tbl[64 + lane] = n; asm volatile("s_waitcnt lgkmcnt(0)" ::: "memory");
    }
    DI bool next(int i, Unit& u) const {
        const int L = i * G + c, rt = L / NCT, pn = L % NCT;
        const int ln = lane_id(), startL = tbl[ln], cntL = tbl[64 + ln];
        const unsigned long long mk = __builtin_amdgcn_ballot_w64(startL <= rt); const int e = 63 - __builtin_clzll(mk | 1ull);
        const int st = __builtin_amdgcn_readlane(startL, e), ne = __builtin_amdgcn_readlane(cntL, e), ti = rt - st;
        if (ti * BM >= ne) return false;
        u.row0 = rt * BM; u.col0 = pn * BM; u.pn = pn; u.K = K; u.aux = 0; u.b = B + ((size_t)e * brows + pn * BM) * K * 2;
        if (GATHER) { u.a = A; u.gl = LIST + (size_t)e * M + ti * BM; const int rem = ne - ti * BM; u.nvalid = rem < BM ? rem : BM; }
        else { u.a = A + (size_t)rt * BM * K * 2; u.gl = nullptr; u.nvalid = 256;
            unsigned sp = 0; while (__hip_atomic_load(done + rt, __ATOMIC_RELAXED, __HIP_MEMORY_SCOPE_AGENT) < 2u) { __builtin_amdgcn_s_sleep(2); if (++sp > (1u << 22)) break; }
            __builtin_amdgcn_fence(__ATOMIC_ACQUIRE, "wavefront"); }
        return true;
    }
    DI void unit_done(const Unit& u, int wid) const {
        if (GATHER) { asm volatile("s_waitcnt vmcnt(0)" ::: "memory"); __syncthreads();
            if (wid == 0 && lane_id() == 0) (void)__hip_atomic_fetch_add(done + u.row0 / BM, 1u, __ATOMIC_RELAXED, __HIP_MEMORY_SCOPE_AGENT); }
    }
};
template <int KIND, int BR0 = 0, int NBR = 3> struct BranchOrder {
    DenseOrder T; const char* ws;
    DI bool next(int i, Unit& u) const {
        Unit t; if (!T.next(i / NBR, t)) return false; const int br = BR0 + i % NBR; const int pm = t.row0 / BM, pn = t.pn;
        u = t; u.aux = br; u.K = KIND == 2 ? 256 : 512;
        if (KIND == 0) { u.a = ws + WS_XN8 + (size_t)pm * BM * 1024; u.b = ws + WS_WG + ((size_t)br * 1024 + pn * BM) * 1024; }
        else if (KIND == 2) { u.a = ws + (br == 1 ? WS_OMLA : WS_OSB) + (size_t)pm * BM * 512; u.b = ws + (br == 1 ? WS_WOM : WS_WOS) + (size_t)pn * BM * 512; }
        else { const size_t ao = br == 0 ? WS_ACONV : br == 1 ? WS_OMLA : WS_OSB, wo = br == 0 ? WS_WOC : br == 1 ? WS_WOM : WS_WOS;
            u.a = ws + ao + (size_t)pm * BM * 512 * 2; u.b = ws + wo + (size_t)pn * BM * 512 * 2; }
        return true;
    }
    DI void unit_done(const Unit&, int) const {}
};
template <class E> struct EpiAdapt {
    static constexpr int TAIL = E::TAIL;
    E e;
    DI void operator()(const f32x4 (&acc)[2][2][4][2], const Unit& u, int wid) const {
        const int ln_ = lane_id(), fr = ln_ & 15, fq = ln_ >> 4, wr = wid >> 2, wc = wid & 3;
        const bool pr = e.is_pair(u.pn);
#pragma unroll
        for (int ai = 0; ai < 2; ++ai) {
            if (pr) {
#pragma unroll
                for (int m = 0; m < 4; ++m) {
                    int row = u.row0 + ai * HALF + wr * 64 + m * 16 + fr; asm volatile("" : "+v"(row));
                    float a[8], b[8];
#pragma unroll
                    for (int j = 0; j < 4; ++j) { a[j] = acc[ai][0][m][0][j]; a[4 + j] = acc[ai][0][m][1][j]; b[j] = acc[ai][1][m][0][j]; b[4 + j] = acc[ai][1][m][1][j]; }
                    e.pair(row, u.col0 + wc * 32 + 8 * fq, a, b, 0.f);
                }
            } else {
                typename E::Pre P[4][2]; float ctx[4]; int rows[4];
#pragma unroll
                for (int m = 0; m < 4; ++m) {
                    int row = u.row0 + ai * HALF + wr * 64 + m * 16 + fr; asm volatile("" : "+v"(row)); rows[m] = row; ctx[m] = e.rowctx(row);
#pragma unroll
                    for (int bj = 0; bj < 2; ++bj) P[m][bj] = e.pre(row, u.col0 + bj * HALF + wc * 32 + 8 * fq, u.aux);
                }
#pragma unroll
                for (int m = 0; m < 4; ++m) { float part = 0.f;
#pragma unroll
                    for (int bj = 0; bj < 2; ++bj) { float v[8];
#pragma unroll
                        for (int j = 0; j < 4; ++j) { v[j] = acc[ai][bj][m][0][j]; v[4 + j] = acc[ai][bj][m][1][j]; }
                        part += e(rows[m], u.col0 + bj * HALF + wc * 32 + 8 * fq, v, ctx[m], u.aux, P[m][bj]); }
                    if (E::ROWSTAT && e.wants_stat(u.pn)) { const int ln = fr | (fq << 4); part += shfl_xor_l(part, 16, ln); part += shfl_xor_l(part, 32, ln); if (fq == 0) e.rowstat(rows[m], u.pn, wc, part); }
                }
            }
            asm volatile("" ::: "memory");
        }
    }
};
template <class Epi, class Sched, bool GATHER, bool VARK = false, bool FP8 = false, bool RELAX = true, int AUXA = 0>
DI void gemm_phase(LAS unsigned char* lds, const int wid_in, const int K0, const Sched& S, const Epi& E) {
    int wid = wid_in; asm volatile("" : "+s"(wid));
    const int lane = lane_id(), tid = wid * 64 + lane, wr = wid >> 2, wc = wid & 3, fr = lane & 15, fq = lane >> 4;
    const size_t kstep = (size_t)(BK * 2);
    const unsigned ldsw = (unsigned)wid * 1024u;
    const int aoff = FP8 ? lds_byte(wr * 64 + fr, fq * 16) : lds_byte(wr * 64 + fr, fq * 8), boff = FP8 ? lds_byte(wc * 32 + fr, fq * 16) : lds_byte(wc * 32 + fr, fq * 8);
    LAS unsigned char* pa_ = lds + aoff; LAS unsigned char* pb_ = lds + 4 * HTB + boff; asm volatile("" : "+v"(pa_), "+v"(pb_));
#define PG8_SA(b, h) (((b) * 2 + (h)) * HTB)
#define PG8_SB(b, h) ((4 + (b) * 2 + (h)) * HTB)
#define PG8_STAGE_B(bufoff, gbase, vb) do { _Pragma("unroll") for (int _i = 0; _i < 2; ++_i) { unsigned _o = (vb)[_i]; asm volatile("" : "+v"(_o));   \
        __builtin_amdgcn_global_load_lds((const unsigned*)((const char*)(gbase) + _o), (LAS unsigned*)(lds + (bufoff) + ldsw + _i * 8192), 16, 0, 0); } } while (0)
#define PG8_STAGE_A(bufoff, gbase, vo, h, hs) do { _Pragma("unroll") for (int _i = 0; _i < 2; ++_i) { unsigned _o = (vo)[GATHER ? (h) : 0][_i]; asm volatile("" : "+v"(_o)); \
        __builtin_amdgcn_global_load_lds((const unsigned*)((const char*)(gbase) + (GATHER ? (size_t)0 : (size_t)(h) * (hs)) + _o), (LAS unsigned*)(lds + (bufoff) + ldsw + _i * 8192), 16, 0, AUXA); } } while (0)
#define PG8_SETVO(vo, vb, u, KK) do { int RA[2], CA[2]; { const int _t = wid * 64 + lane_id();     \
        _Pragma("unroll") for (int _i = 0; _i < 2; ++_i) { int _R, _C; stage_rc(_t * 16 + _i * 8192, _R, _C); RA[_i] = _R; CA[_i] = _C; vb[_i] = (unsigned)(((_R & ~31) + perm32(_R & 31)) * (KK) + _C) * 2u; } } \
        _Pragma("unroll") for (int _h = 0; _h < (GATHER ? 2 : 1); ++_h) _Pragma("unroll") for (int _i = 0; _i < 2; ++_i) { const int _r = _h * HALF + RA[_i]; \
        if (GATHER) { const int _tok = (_r < (u).nvalid) ? (u).gl[_r] : 0; vo[_h][_i] = (unsigned)(_tok * (KK) + CA[_i]) * 2u; } else vo[_h][_i] = (unsigned)(_r * (KK) + CA[_i]) * 2u; } } while (0)
#define PG8_LDA(dst, b, h) do { if (FP8) { _Pragma("unroll") for (int m = 0; m < 4; ++m) dst##8[m] = pg8_cat(*(const LAS bf16x8*)(pa_ + PG8_SA(b, h) + m * 2048), *(const LAS bf16x8*)(pa_ + PG8_SA(b, h) + m * 2048 + 16)); } \
        else { _Pragma("unroll") for (int m = 0; m < 4; ++m) _Pragma("unroll") for (int k = 0; k < 2; ++k) dst[m][k] = *(const LAS bf16x8*)(pa_ + PG8_SA(b, h) + m * 2048 + k * 1024); } } while (0)
#define PG8_LDB(dst, b, h) do { if (FP8) { _Pragma("unroll") for (int n = 0; n < 2; ++n) dst##8[n] = pg8_cat(*(const LAS bf16x8*)(pb_ + PG8_SA(b, h) + n * 2048), *(const LAS bf16x8*)(pb_ + PG8_SA(b, h) + n * 2048 + 16)); } \
        else { _Pragma("unroll") for (int n = 0; n < 2; ++n) _Pragma("unroll") for (int k = 0; k < 2; ++k) dst[n][k] = *(const LAS bf16x8*)(pb_ + PG8_SA(b, h) + n * 2048 + k * 1024); } } while (0)
#define PG8_MMA(ai, bj, At, Bt) do { __builtin_amdgcn_s_setprio(1); _Pragma("unroll") for (int m = 0; m < 4; ++m) _Pragma("unroll") for (int n = 0; n < 2; ++n) { \
        if (FP8) acc[ai][bj][m][n] = __builtin_amdgcn_mfma_scale_f32_16x16x128_f8f6f4(Bt##8[n], At##8[m], acc[ai][bj][m][n], 0, 0, 0, 0, 0, 0); \
        else { _Pragma("unroll") for (int k = 0; k < 2; ++k) acc[ai][bj][m][n] = __builtin_amdgcn_mfma_f32_16x16x32_bf16(Bt[n][k], At[m][k], acc[ai][bj][m][n], 0, 0, 0); } } \
        __builtin_amdgcn_s_setprio(0); } while (0)
#define PG8_WAIT_V(n) asm volatile("s_waitcnt vmcnt(" #n ")" ::: "memory")
#define PG8_WAIT_R() do { if (rel) asm volatile("s_waitcnt vmcnt(%0)" :: "n"(8 + Epi::TAIL) : "memory"); else asm volatile("s_waitcnt vmcnt(8)" ::: "memory"); } while (0)
#define PG8_WAIT_L(n) asm volatile("s_waitcnt lgkmcnt(" #n ")" ::: "memory")
#define PG8_BAR __builtin_amdgcn_s_barrier()
#define PG8_SCHED __builtin_amdgcn_sched_barrier(0)
    Unit cur, nxt; int ui = 0;
    if (!S.next(0, cur)) return;
    f32x4 acc[2][2][4][2];
#pragma unroll
    for (int a = 0; a < 2; ++a)
#pragma unroll
        for (int b = 0; b < 2; ++b)
#pragma unroll
            for (int m = 0; m < 4; ++m)
#pragma unroll
                for (int n = 0; n < 2; ++n) acc[a][b][m][n] = (f32x4){0.f, 0.f, 0.f, 0.f};
    bf16x8 At[4][2], B0[2][2], B1[2][2]; pg8_v8i At8[4], B08[2], B18[2];
    unsigned voffA[GATHER ? 2 : 1][2], voffN[GATHER ? 2 : 1][2], voffB[2], voffBn[2];
    int kC = VARK ? cur.K : K0;
    PG8_SETVO(voffA, voffB, cur, kC);
    size_t hstep = (size_t)HALF * kC * 2;
    const char* cA = cur.a; const char* cB = cur.b;
    PG8_STAGE_B(PG8_SB(0, 0), cB, voffB); PG8_STAGE_B(PG8_SB(0, 1), cB + hstep, voffB); PG8_STAGE_A(PG8_SA(0, 0), cA, voffA, 0, hstep); PG8_STAGE_A(PG8_SA(0, 1), cA, voffA, 1, hstep);
    if (wr == 1) PG8_BAR;
    PG8_WAIT_V(2); PG8_BAR;
    PG8_STAGE_B(PG8_SB(1, 0), cB + kstep, voffB); PG8_STAGE_A(PG8_SA(1, 0), cA + kstep, voffA, 0, hstep); PG8_STAGE_B(PG8_SB(1, 1), cB + hstep + kstep, voffB); PG8_STAGE_A(PG8_SA(1, 1), cA + kstep, voffA, 1, hstep);
    PG8_WAIT_V(8); PG8_BAR;
    for (;;) {
        const bool has_next = S.next(ui + 1, nxt);
        const char* nA = has_next ? nxt.a : cA; const char* nB = has_next ? nxt.b : cB;
        const int kN = (VARK && has_next) ? nxt.K : kC; const size_t hstepN = (size_t)HALF * kN * 2;
        if (GATHER || VARK) { if (has_next) { PG8_SETVO(voffN, voffBn, nxt, kN); } else {
#pragma unroll
            for (int i = 0; i < 2; ++i) voffBn[i] = voffB[i];
#pragma unroll
            for (int h = 0; h < (GATHER ? 2 : 1); ++h)
#pragma unroll
                for (int i = 0; i < 2; ++i) voffN[h][i] = voffA[h][i]; } }
        const int nt = kC / BK;
#pragma unroll 1
        for (int t = 0; t < nt; t += 2) {
            const bool last = (t == nt - 2); const bool rel = RELAX && !GATHER && (ui > 0) && (t == 0);
            const char* a1 = cA + (size_t)(t + 1) * kstep;
            const char* a2 = last ? nA : cA + (size_t)(t + 2) * kstep; const char* b2 = last ? nB : cB + (size_t)(t + 2) * kstep;
            const char* a3 = a2 + kstep; const char* b3 = b2 + kstep;
            unsigned v2[GATHER ? 2 : 1][2], vb2[2]; const size_t h2 = (VARK && last) ? hstepN : hstep;
#pragma unroll
            for (int i = 0; i < 2; ++i) vb2[i] = (VARK && last) ? voffBn[i] : voffB[i];
#pragma unroll
            for (int h = 0; h < (GATHER ? 2 : 1); ++h)
#pragma unroll
                for (int i = 0; i < 2; ++i) v2[h][i] = ((GATHER || VARK) && last) ? voffN[h][i] : voffA[h][i];
            PG8_LDB(B0, 0, 0); PG8_LDB(B1, 0, 1); PG8_SCHED; PG8_LDA(At, 0, 0); if (t != 0) PG8_STAGE_A(PG8_SA(1, 1), a1, voffA, 1, hstep);
            PG8_WAIT_R(); PG8_WAIT_L(0); PG8_BAR; PG8_MMA(0, 0, At, B0); PG8_MMA(0, 1, At, B1); PG8_BAR; PG8_SCHED;
            PG8_LDA(At, 0, 1); PG8_STAGE_B(PG8_SB(0, 0), b2, vb2); PG8_STAGE_B(PG8_SB(0, 1), b2 + h2, vb2); PG8_STAGE_A(PG8_SA(0, 0), a2, v2, 0, h2);
            PG8_WAIT_R(); PG8_WAIT_L(0); PG8_BAR; PG8_MMA(1, 0, At, B0); PG8_MMA(1, 1, At, B1); PG8_BAR; PG8_SCHED;
            PG8_LDB(B0, 1, 0); PG8_LDB(B1, 1, 1); PG8_SCHED; PG8_LDA(At, 1, 0); PG8_STAGE_A(PG8_SA(0, 1), a2, v2, 1, h2);
            PG8_WAIT_R(); PG8_WAIT_L(0); PG8_BAR; PG8_MMA(0, 0, At, B0); PG8_MMA(0, 1, At, B1); PG8_BAR; PG8_SCHED;
            PG8_LDA(At, 1, 1); PG8_STAGE_B(PG8_SB(1, 0), b3, vb2); PG8_STAGE_B(PG8_SB(1, 1), b3 + h2, vb2); PG8_STAGE_A(PG8_SA(1, 0), a3, v2, 0, h2);
            PG8_WAIT_V(8); PG8_WAIT_L(0); PG8_BAR; PG8_MMA(1, 0, At, B0); PG8_MMA(1, 1, At, B1); PG8_BAR; PG8_SCHED;
        }
        if (has_next) { if (GATHER || VARK) PG8_STAGE_A(PG8_SA(1, 1), nA + kstep, voffN, 1, hstepN); else PG8_STAGE_A(PG8_SA(1, 1), nA + kstep, voffA, 1, hstep); }
        if (wr == 0) PG8_BAR;
        E(acc, cur, wid);
        S.unit_done(cur, wid);
        if (!has_next) break;
#pragma unroll
        for (int a = 0; a < 2; ++a)
#pragma unroll
            for (int b = 0; b < 2; ++b)
#pragma unroll
                for (int m = 0; m < 4; ++m)
#pragma unroll
                    for (int n = 0; n < 2; ++n) acc[a][b][m][n] = (f32x4){0.f, 0.f, 0.f, 0.f};
        cur = nxt; cA = nA; cB = nB; ++ui;
        if (GATHER || VARK) {
#pragma unroll
        for (int i = 0; i < 2; ++i) voffB[i] = voffBn[i];
#pragma unroll
        for (int h = 0; h < (GATHER ? 2 : 1); ++h)
#pragma unroll
            for (int i = 0; i < 2; ++i) voffA[h][i] = voffN[h][i]; kC = kN; hstep = hstepN; }
        if (wr == 1) PG8_BAR;
    }
    PG8_WAIT_V(0);
    PG8_BAR;
#undef PG8_SA
#undef PG8_SB
#undef PG8_STAGE_A
#undef PG8_STAGE_B
#undef PG8_SETVO
#undef PG8_LDA
#undef PG8_LDB
#undef PG8_MMA
#undef PG8_WAIT_V
#undef PG8_WAIT_R
#undef PG8_WAIT_L
#undef PG8_BAR
#undef PG8_SCHED
}
}

#define XB_TMO      128
#define XB_XCNT(j)  (256  + 64 * (j))
#define XB_XSUB(j)  (1280 + 64 * (j))
#define XB_XGEN(j)  (2304 + 64 * (j))
#define XB_TOP      3328
#define XB_TOPGEN   3392
#define XCD_BAR_WORDS 3456
#define XB_SPIN_CAP (1u << 18)

__device__ __forceinline__ unsigned xb_ld(unsigned* p)              { return __hip_atomic_load(p, __ATOMIC_RELAXED, __HIP_MEMORY_SCOPE_AGENT); }
__device__ __forceinline__ unsigned xb_add(unsigned* p, unsigned v) { return __hip_atomic_fetch_add(p, v, __ATOMIC_RELAXED, __HIP_MEMORY_SCOPE_AGENT); }
__device__ __forceinline__ unsigned xb_xcc_id() { return (unsigned)__builtin_amdgcn_s_getreg((3 << 11) | 20) & 0xFu; }
#define XB_SPIN(cond, bar) do { unsigned _sp = 0; while (cond) { __builtin_amdgcn_s_sleep(1); \
    if ((++_sp & 255u) == 0u) { if (xb_ld(&(bar)[XB_TMO])) break; if (_sp > XB_SPIN_CAP) { atomicAdd(&(bar)[XB_TMO], 1u); break; } } } } while (0)

struct XcdBarrier {
    unsigned* bar; unsigned x;
    volatile LAS unsigned* st;
    int wave;
};

__device__ __forceinline__ XcdBarrier xcd_barrier_post(unsigned* bar, volatile LAS unsigned* st) {
    XcdBarrier b; b.bar = bar; b.x = xb_xcc_id(); b.st = st;
    if (threadIdx.x == 0) (void)xb_add(&bar[XB_XCNT(b.x)], 1u);
    return b;
}
__device__ __forceinline__ void xcd_barrier_complete(unsigned* bar, unsigned x, unsigned& nloc, unsigned& nx) {
    const unsigned G = gridDim.x * gridDim.y * gridDim.z;
    unsigned sum, cnt, mine, sp = 0u;
    for (;;) {
        sum = 0u; cnt = 0u; mine = 0u;
#pragma unroll
        for (unsigned j = 0; j < 16; ++j) { const unsigned c = xb_ld(&bar[XB_XCNT(j)]); sum += c; cnt += (c > 0u) ? 1u : 0u; }
        if (sum == G) { mine = xb_ld(&bar[XB_XCNT(x)]); break; }
        __builtin_amdgcn_s_sleep(1);
        if ((++sp & 255u) == 0u) { if (xb_ld(&bar[XB_TMO])) break; if (sp > XB_SPIN_CAP) { atomicAdd(&bar[XB_TMO], 1u); break; } }
    }
    nloc = mine > 0u ? mine : 1u; nx = cnt > 0u ? cnt : 1u;
}

template <bool LOCAL = false> __device__ __forceinline__ void xcd_barrier(const XcdBarrier& b) {
    asm volatile("s_waitcnt vmcnt(0)" ::: "memory");
    __syncthreads();
    if (b.wave == 0 && lane_id() == 0) {
        unsigned* bar = b.bar;
        __builtin_amdgcn_s_waitcnt(0);
        unsigned nloc = b.st[0], nx = b.st[1];
        if (nloc == 0u) { xcd_barrier_complete(bar, b.x, nloc, nx); b.st[0] = nloc; b.st[1] = nx; }
        const unsigned old = xb_add(&bar[XB_XSUB(b.x)], 1u);
        const unsigned gen = old / nloc;
        const bool loc = LOCAL && b.st[3] != 0u;
        if (old + 1u == (gen + 1u) * nloc && loc) {
            xb_add(&bar[XB_XGEN(b.x)], 1u); __builtin_amdgcn_fence(__ATOMIC_ACQUIRE, "agent"); asm volatile("s_waitcnt vmcnt(0)" ::: "memory");
        } else if (old + 1u == (gen + 1u) * nloc) {
            __builtin_amdgcn_fence(__ATOMIC_RELEASE, "agent");
            asm volatile("s_waitcnt vmcnt(0)" ::: "memory");
            const unsigned og = xb_add(&bar[XB_TOP], 1u);
            const unsigned tg = og / nx;
            if (og + 1u == (tg + 1u) * nx) xb_add(&bar[XB_TOPGEN], 1u);
            else XB_SPIN(xb_ld(&bar[XB_TOPGEN]) == tg, bar);
            __builtin_amdgcn_fence(__ATOMIC_ACQUIRE, "agent");
            xb_add(&bar[XB_XGEN(b.x)], 1u);
            asm volatile("s_waitcnt vmcnt(0)" ::: "memory");
        } else {
            XB_SPIN(xb_ld(&bar[XB_XGEN(b.x)]) == gen, bar);
            __builtin_amdgcn_fence(__ATOMIC_ACQUIRE, "agent");
            asm volatile("s_waitcnt vmcnt(0)" ::: "memory");
        }
    }
    __syncthreads();
}

constexpr int NWAVES = 8, RING_BYTES = 131072, LDSCTL_OFF = RING_BYTES, MISC_OFF = LDSCTL_OFF + 320, LDS_BYTES = 147456;
constexpr int CW_BAR = 4096;
constexpr int NPHASE = 1 + 9 * DEPTH;
struct Args { const float* in[23]; float* out; unsigned char* ws; int ph_lo, ph_hi, li, pad; };

typedef short s16x8r __attribute__((ext_vector_type(8)));
DI void t1_group(const bf16* __restrict__ XRB, const float* __restrict__ g, const bf16* __restrict__ WR, const float* brg, const float* bre, unsigned char* ws, unsigned char* __restrict__ H2out, int layer, int grp_, bool valid, int lane, int wave, LAS int* lcnt, LAS int* lbase, const LAS unsigned char* wl) {
    const int grp = valid ? grp_ : 0;
    const int tok = lane & 15, kg = lane >> 4, row = grp * 16 + tok;
    const bf16* xr = XRB + (size_t)row * XRP + 8 * kg; float ss;
    { const f32x4 q = *(const f32x4*)((const float*)(ws + WS_SSQ2) + (size_t)row * 16 + 4 * kg); ss = (q.x + q.y) + (q.z + q.w); }
    ss += shfl_xor_l(ss, 16, lane); ss += shfl_xor_l(ss, 32, lane);
    const float rstd = 1.0f / sqrtf(ss * (1.f / D) + EPS);
    unsigned char* __restrict__ hrow = H2out + (size_t)row * D + 8 * kg;
    const bf16* wa = WR + (size_t)tok * 1024 + 8 * kg;
    f32x4 acc0 = {0.f, 0.f, 0.f, 0.f}, acc1 = acc0, acc2 = acc0;
#define T1_LOAD(S, ks0) _Pragma("unroll") for (int i = 0; i < 4; ++i) { const int ks = (ks0) + i; x##S[i] = *(const u32x4*)(xr + 32 * ks); ga##S[i] = *(const LAS f32x4*)(wl + 98304 + (size_t)(32 * ks + 8 * kg) * 4); gb##S[i] = *(const LAS f32x4*)(wl + 98304 + (size_t)(32 * ks + 8 * kg + 4) * 4); }
#define T1_STEP(S, ks0) _Pragma("unroll") for (int i = 0; i < 4; ++i) { const int ks = (ks0) + i; float xt[8]; unpk8(x##S[i], xt); const f32x4 a = {xt[0], xt[1], xt[2], xt[3]}, b = {xt[4], xt[5], xt[6], xt[7]}, ga = ga##S[i], gb = gb##S[i]; \
        u32x4 w; w.x = pk2(a.x * rstd * ga.x, a.y * rstd * ga.y); w.y = pk2(a.z * rstd * ga.z, a.w * rstd * ga.w); w.z = pk2(b.x * rstd * gb.x, b.y * rstd * gb.y); w.w = pk2(b.z * rstd * gb.z, b.w * rstd * gb.w); \
        { u32x2 h8; h8.x = pk4_fp8((f32x4){a.x * rstd * ga.x, a.y * rstd * ga.y, a.z * rstd * ga.z, a.w * rstd * ga.w}); h8.y = pk4_fp8((f32x4){b.x * rstd * gb.x, b.y * rstd * gb.y, b.z * rstd * gb.z, b.w * rstd * gb.w}); \
          if (valid) *(u32x2*)(hrow + 32 * ks) = h8; } \
        const s16x8r hf = __builtin_bit_cast(s16x8r, w); \
        const s16x8r w0_ = *(const LAS s16x8r*)(wl + (size_t)((0 * 32 + ks) * 64 + lane) * 16), w1_ = *(const LAS s16x8r*)(wl + (size_t)((1 * 32 + ks) * 64 + lane) * 16), w2_ = *(const LAS s16x8r*)(wl + (size_t)((2 * 32 + ks) * 64 + lane) * 16); \
        acc0 = __builtin_amdgcn_mfma_f32_16x16x32_bf16(w0_, hf, acc0, 0, 0, 0); acc1 = __builtin_amdgcn_mfma_f32_16x16x32_bf16(w1_, hf, acc1, 0, 0, 0); acc2 = __builtin_amdgcn_mfma_f32_16x16x32_bf16(w2_, hf, acc2, 0, 0, 0); }
    u32x4 xA[4]; f32x4 gaA[4], gbA[4];
#pragma unroll 1
    for (int kb = 0; kb < 32; kb += 4) {
        T1_LOAD(A, kb)
        T1_STEP(A, kb)
    }
#undef T1_LOAD
#undef T1_STEP
    float gl[4]; int gi = 0;
#pragma unroll
    for (int e = 0; e < 4; ++e) gl[e] = acc0[e] + brg[e];
    float gm = gl[0];
#pragma unroll
    for (int e = 1; e < 4; ++e) if (gl[e] > gm) { gm = gl[e]; gi = e; }
    const bool pick = valid && kg == gi; int e1 = 0, e2 = 0, r1 = 0, r2 = 0; float w1 = 0.f, w2 = 0.f;
    if (pick) {
        float gs = 0.f;
#pragma unroll
        for (int e = 0; e < 4; ++e) gs += __expf(gl[e] - gm);
        const float gw = 1.0f / gs;
        float sel[8];
#pragma unroll
        for (int e = 0; e < 4; ++e) { sel[e] = acc1[e] + bre[8 * kg + e]; sel[4 + e] = acc2[e] + bre[8 * kg + 4 + e]; }
        int i1 = 0; float m1 = sel[0];
#pragma unroll
        for (int e = 1; e < 8; ++e) if (sel[e] > m1) { m1 = sel[e]; i1 = e; }
        int i2 = -1; float m2 = -INFINITY;
#pragma unroll
        for (int e = 0; e < 8; ++e) if (e != i1 && sel[e] > m2) { m2 = sel[e]; i2 = e; }
        const float r = __expf(m2 - m1); w1 = gw / (1.0f + r); w2 = gw * r / (1.0f + r);
        e1 = gi * 8 + i1; e2 = gi * 8 + i2;
        r1 = __atomic_fetch_add(lcnt + e1, 1, __ATOMIC_RELAXED); r2 = __atomic_fetch_add(lcnt + e2, 1, __ATOMIC_RELAXED);
    }
    __syncthreads();
    if (wave == 0 && lane < NEXP) { const int c = lcnt[lane]; unsigned* cnt = (unsigned*)(ws + WS_CTL) + CW_CNT + layer * 32 * 64;
        lbase[lane] = c ? (int)atomicAdd(cnt + lane * 64, (unsigned)c) : 0; lcnt[lane] = 0; }
    __syncthreads();
    if (pick) { const int s1 = lbase[e1] + r1, s2 = lbase[e2] + r2;
        int* LIST = (int*)(ws + WS_LIST); LIST[(size_t)e1 * M + s1] = row; LIST[(size_t)e2 * M + s2] = row;
        ((int4*)(ws + WS_TOKSLOT))[row] = make_int4(e1, s1, e2, s2); ((float2*)(ws + WS_TOKW))[row] = make_float2(w1, w2); }
}

DI int lds_word_uniform(LAS unsigned char* lds, int off) { asm volatile("" : "+s"(off)); return __builtin_amdgcn_readfirstlane((int)*(volatile LAS unsigned*)(lds + off)); }
#define bx (lds_word_uniform(lds, MISC_OFF + 32 + 8))
#define vcu ((G % 8 == 0) ? (bx % 8) * (G / 8) + bx / 8 : bx)
__global__ void __launch_bounds__(NWAVES * 64, 2) mk_fwd(Args args) {
    extern __shared__ __attribute__((aligned(16))) unsigned char lds_raw[];
    LAS unsigned char* lds = (LAS unsigned char*)lds_raw;
    const int wave = __builtin_amdgcn_readfirstlane(threadIdx.x >> 6);
    const int G = gridDim.x;
    unsigned char* ws = args.ws; const float* const* in = args.in; float* XR = args.out; bf16* XRB = (bf16*)args.out + 1024;
    for (int u = threadIdx.x; u < (LDS_BYTES - LDSCTL_OFF) / 4; u += NWAVES * 64) ((LAS unsigned*)(lds + LDSCTL_OFF))[u] = 0u;
    __syncthreads();
    unsigned* ctl = (unsigned*)(ws + WS_CTL);
    XcdBarrier bar; bar.bar = ctl + CW_BAR + args.li * XCD_BAR_WORDS; bar.x = xb_xcc_id(); bar.st = (volatile LAS unsigned*)(lds + MISC_OFF) + 8; bar.wave = wave;
    if (wave == 0 && lane_id() == 0) {
        const unsigned rank = xb_add(&bar.bar[XB_XCNT(bar.x)], 1u); unsigned nloc, nx; xcd_barrier_complete(bar.bar, bar.x, nloc, nx);
        unsigned idx = 0u; bool uni = (G % 8 == 0) && nx == 8u;
#pragma unroll
        for (unsigned j = 0; j < 16; ++j) { const unsigned c = xb_ld(&bar.bar[XB_XCNT(j)]); if (c != 0u && j < bar.x) ++idx; if (c != 0u && c != (unsigned)(G / 8)) uni = false; }
        bar.st[0] = nloc; bar.st[1] = nx; bar.st[2] = uni ? rank * 8u + idx : (unsigned)blockIdx.x; bar.st[3] = uni ? 1u : 0u;
    }
    __syncthreads();
#define IN(k) true
#define SEAM(k) do { if ((k) + 1 < NPHASE) xcd_barrier(bar); } while (0)
#define SEAM_L(k) do { if ((k) + 1 < NPHASE) xcd_barrier<true>(bar); } while (0)
    bf16 *XN = (bf16*)(ws + WS_XN), *SBQ = (bf16*)(ws + WS_SBQ), *SBKT = (bf16*)(ws + WS_SBKT), *SBVT = (bf16*)(ws + WS_SBVT), *KT = (bf16*)(ws + WS_KT), *Qb = (bf16*)(ws + WS_Q), *VT = (bf16*)(ws + WS_VT);
    bf16 *U = (bf16*)(ws + WS_U), *BG = (bf16*)(ws + WS_BG), *CQ = (bf16*)(ws + WS_CQ), *CKV = (bf16*)(ws + WS_CKV), *ACONV = (bf16*)(ws + WS_ACONV), *OMLA = (bf16*)(ws + WS_OMLA), *OSB = (bf16*)(ws + WS_OSB);
    unsigned char* GATES = ws + WS_GATES; bf16 *MERGED = (bf16*)(ws + WS_MERGED), *H2 = (bf16*)(ws + WS_H2), *ACT = (bf16*)(ws + WS_ACT), *Y = (bf16*)(ws + WS_Y);
    float* SSQ = (float*)(ws + WS_SSQ); float2* CS = (float2*)(ws + WS_CS);
    const int gw = vcu * NWAVES + wave, NGW = G * NWAVES;
    LAS float* scr = (LAS float*)(lds + wave * 16384);

    if (IN(0)) { const int lane = lane_id();
        for (int k = gw; k < WI_EARLY; k += NGW) { WItem s; wdecode(wi_early(k), in, 0, ws, s); tr_item(s, scr, lane); }
        for (int i = gw * 64 + lane; i < DEPTH * 3072; i += NGW * 64) ((float*)(ws + WS_GB))[i] = __builtin_fmaf(in[4][i], -1.4426950408889634f, -7.994353436858858f);
        for (int r8 = gw; r8 < M / 8; r8 += NGW) { rms_rowsN<8>(in[0], in[2], XN, ws + WS_XN8, 8 * r8, lane); cs_rows4((const int*)in[1], CS, 8 * r8, lane); cs_rows4((const int*)in[1], CS, 8 * r8 + 4, lane); }
    }
    SEAM(0);
    for (int l = 0; l < DEPTH; ++l) {
        const int pb = 1 + 9 * l;
        if (IN(pb + 0)) {
            pg8::EpiAdapt<EpiWinA> E{EpiWinA{U, BG, SBQ, SBKT, SBVT, CQ, CKV, KT, SSQ, CS}};
            { pg8::MaskedDense<PH1_F8MASK> S; S.init(ws + WS_XN8, ws + WS_WA, M, 512, G, bx);
              pg8::gemm_phase<pg8::EpiAdapt<EpiWinA>, pg8::MaskedDense<PH1_F8MASK>, false, false, true>(lds, wave, 512, S, E); }
            { constexpr unsigned REST = ((1u << (NA / 256)) - 1u) & ~PH1_F8MASK; pg8::MaskedDense<REST> S; S.init(XN, ws + WS_WA, M, 1024, G, bx);
              pg8::gemm_phase<pg8::EpiAdapt<EpiWinA>, pg8::MaskedDense<REST>, false>(lds, wave, 1024, S, E); }
        }
        SEAM_L(pb + 0);
        if (IN(pb + 1)) {
            { pg8::DenseOrder S; S.init(CQ, ws + WS_WUQ, M, 768, 256, G, bx); pg8::EpiAdapt<EpiQ> E{EpiQ{Qb, SSQ, CS}};
              pg8::gemm_phase<pg8::EpiAdapt<EpiQ>, pg8::DenseOrder, false, false, false, false>(lds, wave, 256, S, E); }
            { pg8::DenseOrder S; S.init(CKV, ws + WS_WUKV, M, 1024, 128, G, bx); pg8::EpiAdapt<EpiKV> E{EpiKV{KT, VT, SSQ}};
              pg8::gemm_phase<pg8::EpiAdapt<EpiKV>, pg8::DenseOrder, false, false, false, false>(lds, wave, 128, S, E); }
        }
        SEAM_L(pb + 1);
        if (IN(pb + 2)) {
            ATTN_PHASE_BODY
        }
        SEAM(pb + 2);
        if (IN(pb + 3)) {
            { pg8::BranchOrder<0> S; S.T.init(nullptr, nullptr, M, 1024, 1024, G, bx); S.ws = (const char*)ws;
              pg8::EpiAdapt<EpiGate8> E{EpiGate8{GATES, (const float*)(ws + WS_GB) + (size_t)l * 3072}};
              pg8::gemm_phase<pg8::EpiAdapt<EpiGate8>, pg8::BranchOrder<0>, false, false, true>(lds, wave, 512, S, E); }
            { pg8::BranchOrder<1, 0, 1> S; S.T.init(nullptr, nullptr, M, 1024, 1024, G, bx); S.ws = (const char*)ws;
              pg8::EpiAdapt<EpiY3<false>> E{EpiY3<false>{GATES, MERGED, (bf16*)(ws + WS_MPART)}};
              pg8::gemm_phase<pg8::EpiAdapt<EpiY3<false>>, pg8::BranchOrder<1, 0, 1>, false>(lds, wave, 512, S, E); }
            { pg8::BranchOrder<2, 1, 2> S; S.T.init(nullptr, nullptr, M, 1024, 1024, G, bx); S.ws = (const char*)ws;
              pg8::EpiAdapt<EpiY3<true>> E{EpiY3<true>{GATES, MERGED, (bf16*)(ws + WS_MPART)}};
              pg8::gemm_phase<pg8::EpiAdapt<EpiY3<true>>, pg8::BranchOrder<2, 1, 2>, false, false, true>(lds, wave, 256, S, E); }
        }
        SEAM_L(pb + 3);
        if (IN(pb + 4)) {
            pg8::DenseOrder S; S.init(MERGED, ws + WS_WO, M, 1024, 1024, G, bx); pg8::EpiAdapt<EpiWo> E{EpiWo{l == 0 ? in[0] : nullptr, XRB, (float*)(ws + WS_SSQ2)}};
            pg8::gemm_phase<pg8::EpiAdapt<EpiWo>, pg8::DenseOrder, false>(lds, wave, 1024, S, E);
        }
        SEAM_L(pb + 4);
        if (IN(pb + 5)) { const int lane = lane_id();
            { const bf16* WRg = (const bf16*)(ws + WS_WR);
              for (int f = wave * 64 + lane; f < 3 * 32 * 64; f += NWAVES * 64) { const int tile = f >> 11, ks = (f >> 6) & 31, ln = f & 63;
                  *(LAS u32x4*)(lds + (size_t)f * 16) = *(const u32x4*)(WRg + (size_t)(tile * 16 + (ln & 15)) * 1024 + 32 * ks + 8 * (ln >> 4)); }
              { const float* gg_ = in[14] + l * 1024; for (int f = wave * 64 + lane; f < 256; f += NWAVES * 64) *(LAS f32x4*)(lds + 98304 + (size_t)f * 16) = *(const f32x4*)(gg_ + 4 * f); }
              asm volatile("s_waitcnt vmcnt(0) lgkmcnt(0)" ::: "memory"); __syncthreads(); }
            for (int g0 = 0; g0 < M / 16; g0 += NGW) t1_group(XRB, in[14] + l * 1024, (const bf16*)(ws + WS_WR), in[16] + l * 4, in[18] + l * 32, ws, ws + WS_H2, l, g0 + gw, g0 + gw < M / 16, lane, wave,
                                                            (LAS int*)(lds + LDSCTL_OFF + 6144), (LAS int*)(lds + LDSCTL_OFF + 6144 + 256), lds);
        }
        SEAM(pb + 5);
        const unsigned* cnt = ctl + CW_CNT + l * 32 * 64;
        if (IN(pb + 6)) {
            pg8::GroupedOrder<true> S{(LAS int*)(lds + LDSCTL_OFF + 1024), (const char*)H2, (const char*)(ws + WS_WGU), (const int*)(ws + WS_LIST), 512, 2, 512, G, bx, ctl + CW_DONE + l * 1024}; S.init_lanes(cnt, lane_id());
            pg8::EpiAdapt<EpiGU> E{EpiGU{ACT}};
            pg8::gemm_phase<pg8::EpiAdapt<EpiGU>, pg8::GroupedOrder<true>, true, false, true>(lds, wave, 512, S, E);
        }
        if (IN(pb + 7)) {
            pg8::GroupedOrder<false> S{(LAS int*)(lds + LDSCTL_OFF + 1024), (const char*)ACT, (const char*)(ws + WS_WD), nullptr, 128, 4, 1024, G, (bx + G / 2) % G, ctl + CW_DONE + l * 1024}; S.init_lanes(cnt, lane_id());
            pg8::EpiAdapt<EpiDown> E{EpiDown{Y}};
            pg8::gemm_phase<pg8::EpiAdapt<EpiDown>, pg8::GroupedOrder<false>, false, false, true, true, 16>(lds, wave, 128, S, E);
        }
        SEAM(pb + 7);
        if (IN(pb + 8)) { const int lane = lane_id();
            const bool fin = (l + 1 == DEPTH); const float* gnext = fin ? in[22] : in[2] + (l + 1) * 1024;
            const int baseL = moe_base_lanes(cnt, lane);
            for (int r4 = gw; r4 < M / 4; r4 += NGW) t2_rows4(XR, XRB, Y, baseL, (const int4*)(ws + WS_TOKSLOT), (const float2*)(ws + WS_TOKW), gnext, XN, ws + WS_XN8, fin, 4 * r4, lane);
            if (!fin) { for (int k = gw; k < WI_EARLY; k += NGW) { WItem s; wdecode(wi_early(k), in, l + 1, ws, s); tr_item(s, scr, lane); } }
        }
        SEAM(pb + 8);
    }
#undef IN
#undef SEAM
#undef bx
#undef vcu
}
template <class T> static T* wsp(void* ws, size_t off) { return (T*)((unsigned char*)ws + off); }
static void launch_mk(Args a, int lo, int hi, int li, int grid, hipStream_t s) { a.ph_lo = lo; a.ph_hi = hi; a.li = li; a.pad = 0; hipLaunchKernelGGL(mk_fwd, dim3(grid), dim3(NWAVES * 64), LDS_BYTES, s, a); }
extern "C" void kernel_launch(void* const* d_in, const int* in_sizes, int n_in, void* d_out, int out_size, void* d_ws, size_t ws_size, hipStream_t stream) {
    static int grid = 0;
    if (grid == 0) {
        if (n_in != 23 || out_size != M * D || ws_size < WS_END) { fprintf(stderr, "kernel_launch: unexpected shapes (n_in %d out %d ws %zu)\n", n_in, out_size, ws_size); grid = -1; return; }
        int dev = 0, cus = 0;
        if (hipGetDevice(&dev) != hipSuccess || hipDeviceGetAttribute(&cus, hipDeviceAttributeMultiprocessorCount, dev) != hipSuccess) { grid = -1; return; }
        if (hipFuncSetAttribute((const void*)mk_fwd, hipFuncAttributeMaxDynamicSharedMemorySize, LDS_BYTES) != hipSuccess) { fprintf(stderr, "kernel_launch: hipFuncSetAttribute failed\n"); grid = -1; return; }
        int per_cu = 0; (void)hipOccupancyMaxActiveBlocksPerMultiprocessor(&per_cu, (const void*)mk_fwd, NWAVES * 64, LDS_BYTES); (void)hipGetLastError();
        grid = cus;
    }
    if (grid < 0) return;
    unsigned char* ws = (unsigned char*)d_ws;
    (void)hipMemsetAsync(ws + WS_CTL, 0, 1 * MiB, stream);
    Args a{}; for (int i = 0; i < 23; ++i) a.in[i] = (const float*)d_in[i]; a.out = (float*)d_out; a.ws = ws;
    launch_mk(a, 0, NPHASE, 0, grid, stream);
}
```
